# Optimizing an MI355X kernel written in HIP

```python
import math
import jax
import jax.numpy as jnp
from jax import lax
import numpy as np

D_MODEL = 1024
BATCH = 16
SEQ = 2048
DEPTH = 2
DEC_BATCH = 32
DEC_SEQ = 16
PAST_LEN = 2048

CHUNK = 64
Q_BLOCK = 128
MLA_HEADS = 8
MLA_NOPE = 64
MLA_ROPE = 32
MLA_V = 64
MLA_Q_RANK = 384
MLA_KV_RANK = 256
ROPE_BASE = 10000.0
MLA_SCALE = (MLA_NOPE + MLA_ROPE) ** -0.5
GDN_HEADS = 4
GDN_DK = 64
GDN_DV = 64
GDN_CONV = 4
QKV_DIM = 2 * GDN_HEADS * GDN_DK + GDN_HEADS * GDN_DV
CONV_CH = 256
CONV_WIDTH = 31
D_MIX = MLA_HEADS * MLA_V + GDN_HEADS * GDN_DV + CONV_CH
D_FF = ((8 * D_MODEL // 3 + 255) // 256) * 256
DN_ALPHA = (2 * DEPTH) ** 0.25
DN_BETA = (8 * DEPTH) ** -0.25
IN_SIZES = (MLA_Q_RANK, MLA_KV_RANK, MLA_ROPE, QKV_DIM, GDN_HEADS, GDN_HEADS, GDN_HEADS * GDN_DV, 2 * CONV_CH)
D_IN = sum(IN_SIZES)
IN_SPLITS = tuple(int(s) for s in np.cumsum(IN_SIZES)[:-1])

kernel_name = 'hybrid_streaming_encoder_step'


def _rmsnorm(x, g, eps=1e-6):
    xf = x.astype(jnp.float32)
    y = xf * lax.rsqrt(jnp.mean(xf * xf, -1, keepdims=True) + eps)
    return (y * g.astype(jnp.float32)).astype(x.dtype)


def _layernorm(x, g, b, eps=1e-5):
    xf = x.astype(jnp.float32)
    mu = jnp.mean(xf, -1, keepdims=True)
    var = jnp.mean(jnp.square(xf - mu), -1, keepdims=True)
    y = (xf - mu) * lax.rsqrt(var + eps) * g.astype(jnp.float32) + b.astype(jnp.float32)
    return y.astype(x.dtype)


def _l2norm(x, eps=1e-6):
    xf = x.astype(jnp.float32)
    return xf * lax.rsqrt(jnp.sum(xf * xf, -1, keepdims=True) + eps)


def _rope(x, pos):
    half = x.shape[-1] // 2
    inv = jnp.exp(-math.log(ROPE_BASE) * jnp.arange(half, dtype=jnp.float32) / half)
    ang = pos.astype(jnp.float32)[:, None, None] * inv
    cos, sin = jnp.cos(ang), jnp.sin(ang)
    xf = x.astype(jnp.float32)
    x1, x2 = xf[..., :half], xf[..., half:]
    return jnp.concatenate([x1 * cos - x2 * sin, x1 * sin + x2 * cos], -1).astype(x.dtype)


def _causal_dwconv(x, buf, w):
    xp = jnp.concatenate([buf.astype(x.dtype), x], axis=1)
    y = lax.conv_general_dilated(xp, w[:, None, :].astype(x.dtype), window_strides=(1,), padding='VALID',
                                 dimension_numbers=('NWC', 'WIO', 'NWC'), feature_group_count=x.shape[-1])
    return y, xp[:, -(w.shape[0] - 1):]


def _latent_attend(q_lat, q_pe, ckv, kpe, visible):
    s = (jnp.einsum('bqhc,bsc->bhqs', q_lat, ckv) + jnp.einsum('bqhr,bsr->bhqs', q_pe, kpe)).astype(jnp.float32) * MLA_SCALE
    if visible is not None:
        s = jnp.where(visible, s, -jnp.inf)
    p = jax.nn.softmax(s, axis=-1).astype(ckv.dtype)
    return jnp.einsum('bhqs,bsc->bqhc', p, ckv)


def _mla_prompt(q_lat, q_pe, ckv, kpe):
    B, S, H, C = q_lat.shape
    nb = S // Q_BLOCK
    key_pos = jnp.arange(S)

    def blk(args):
        ql, qp, i = args
        qpos = i * Q_BLOCK + jnp.arange(Q_BLOCK)
        visible = key_pos[None, :] < (qpos[:, None] // CHUNK + 1) * CHUNK
        return _latent_attend(ql, qp, ckv, kpe, visible)

    qb = jnp.moveaxis(q_lat.reshape(B, nb, Q_BLOCK, H, C), 1, 0)
    pb = jnp.moveaxis(q_pe.reshape(B, nb, Q_BLOCK, H, MLA_ROPE), 1, 0)
    o = lax.map(blk, (qb, pb, jnp.arange(nb)))
    return jnp.moveaxis(o, 0, 1).reshape(B, S, H, C)


def _gdn_chunk(S0, inp):
    q, k, v, g, beta = inp
    L = q.shape[2]
    G = jnp.cumsum(g, axis=-1)
    idx = jnp.arange(L)
    lower = idx[:, None] >= idx[None, :]
    strict = idx[:, None] > idx[None, :]
    decay = jnp.exp(jnp.where(lower, G[..., :, None] - G[..., None, :], -jnp.inf))
    A = jnp.where(strict, beta[..., :, None] * jnp.einsum('bhid,bhjd->bhij', k, k) * decay, 0.0)
    gam = jnp.exp(G)
    rhs = jnp.concatenate([(beta * gam)[..., None] * k, beta[..., None] * v], axis=-1)

    def sub(i, X):
        row = rhs[:, :, i] - jnp.einsum('bhj,bhjd->bhd', A[:, :, i], X)
        return X.at[:, :, i].set(row)

    X = lax.fori_loop(0, L, sub, rhs)
    W, Uv = X[..., :GDN_DK], X[..., GDN_DK:]
    U = Uv - jnp.einsum('bhld,bhde->bhle', W, S0)
    o = jnp.einsum('bhld,bhde->bhle', gam[..., None] * q, S0) + jnp.einsum(
        'bhij,bhje->bhie', jnp.einsum('bhid,bhjd->bhij', q, k) * decay, U)
    S_new = gam[..., -1][..., None, None] * S0 + jnp.einsum(
        'bhld,bhle->bhde', k * jnp.exp(G[..., -1:] - G)[..., None], U)
    return S_new, o


def _gated_delta(q, k, v, g, beta, S0):
    B, T, H, _ = q.shape
    L = CHUNK if T % CHUNK == 0 else T
    n = T // L

    def to_chunks(a):
        a = a.astype(jnp.float32).reshape((B, n, L, H) + a.shape[3:])
        return jnp.moveaxis(a, (1, 3), (0, 2))

    S_T, o = lax.scan(_gdn_chunk, S0.astype(jnp.float32),
                      (to_chunks(q), to_chunks(k), to_chunks(v), to_chunks(g), to_chunks(beta)))
    o = jnp.moveaxis(o, (0, 2), (1, 3)).reshape(B, T, H, GDN_DV)
    return o, S_T


def _mixer(u, p, ckv_past, kpe_past, S0, gbuf, cbuf, start_pos):
    B, T, _ = u.shape
    h = jnp.einsum('btd,de->bte', u, p['w_in'])
    cq, ckv_raw, kpe_raw, qkv, b_raw, a_raw, z, glu_in = jnp.split(h, IN_SPLITS, axis=-1)
    pos = start_pos + jnp.arange(T)

    q = jnp.einsum('btr,rf->btf', _rmsnorm(cq, p['mla_q_norm']), p['w_uq']).reshape(B, T, MLA_HEADS, MLA_NOPE + MLA_ROPE)
    q_nope, q_pe = q[..., :MLA_NOPE], _rope(q[..., MLA_NOPE:], pos)
    ckv_new = _rmsnorm(ckv_raw, p['mla_kv_norm'])
    kpe_new = _rope(kpe_raw[:, :, None, :], pos)[:, :, 0]
    q_lat = jnp.einsum('bthd,chd->bthc', q_nope, p['w_uk'])
    if ckv_past is None:
        o_lat = _mla_prompt(q_lat, q_pe, ckv_new, kpe_new)
    else:
        ckv_all = jnp.concatenate([ckv_past.astype(ckv_new.dtype), ckv_new], axis=1)
        kpe_all = jnp.concatenate([kpe_past.astype(kpe_new.dtype), kpe_new], axis=1)
        o_lat = _latent_attend(q_lat, q_pe, ckv_all, kpe_all, None)
    o_mla = jnp.einsum('bthc,chd->bthd', o_lat, p['w_uv']).reshape(B, T, MLA_HEADS * MLA_V)

    qkv, gbuf_new = _causal_dwconv(qkv, gbuf, p['gdn_conv_w'])
    qkv = jax.nn.silu(qkv)
    gq, gk, gv = jnp.split(qkv, [GDN_HEADS * GDN_DK, 2 * GDN_HEADS * GDN_DK], axis=-1)
    gq = _l2norm(gq.reshape(B, T, GDN_HEADS, GDN_DK)) * (GDN_DK ** -0.5)
    gk = _l2norm(gk.reshape(B, T, GDN_HEADS, GDN_DK))
    gv = gv.reshape(B, T, GDN_HEADS, GDN_DV)
    beta = jax.nn.sigmoid(b_raw.astype(jnp.float32))
    g = -jnp.exp(p['gdn_a_log'].astype(jnp.float32)) * jax.nn.softplus(
        a_raw.astype(jnp.float32) + p['gdn_dt_bias'].astype(jnp.float32))
    o, S_new = _gated_delta(gq, gk, gv, g, beta, S0)
    o_gdn = (_rmsnorm(o, p['gdn_norm']) * jax.nn.silu(z.reshape(B, T, GDN_HEADS, GDN_DV))).astype(u.dtype)
    o_gdn = o_gdn.reshape(B, T, GDN_HEADS * GDN_DV)

    a, gate = jnp.split(glu_in, 2, axis=-1)
    c = a * jax.nn.sigmoid(gate)
    c, cbuf_new = _causal_dwconv(c, cbuf, p['conv_w'])
    c = c + p['conv_b']
    o_conv = jax.nn.silu(_layernorm(c, p['conv_ln_g'], p['conv_ln_b']))

    y = jnp.einsum('bte,ed->btd', jnp.concatenate([o_mla, o_gdn, o_conv], axis=-1), p['w_out'])
    return y, (ckv_new, kpe_new, S_new.astype(u.dtype), gbuf_new, cbuf_new)


def _layer(x, p, ckv_past, kpe_past, S0, gbuf, cbuf, start_pos):
    y, st = _mixer(x, p, ckv_past, kpe_past, S0, gbuf, cbuf, start_pos)
    x = _layernorm(DN_ALPHA * x + y, p['ln1_g'], p['ln1_b'])
    f = jax.nn.silu(jnp.einsum('btd,df->btf', x, p['w_gate'])) * jnp.einsum('btd,df->btf', x, p['w_up'])
    f = jnp.einsum('btf,fd->btd', f, p['w_down'])
    x = _layernorm(DN_ALPHA * x + f, p['ln2_g'], p['ln2_b'])
    return x, st


def setup_inputs(seed: int = 0) -> dict:
    key = jax.random.key(seed)
    ks = iter(jax.random.split(key, 40))

    def nrm(shape, scale):
        return jax.random.normal(next(ks), shape, jnp.float32) * scale

    def gain(shape):
        return 1.0 + nrm(shape, 0.01)

    dt = jnp.exp(jax.random.uniform(next(ks), (DEPTH, GDN_HEADS), jnp.float32,
                                    minval=math.log(1e-3), maxval=math.log(1e-1)))
    return {
        'x_prompt': nrm((BATCH, SEQ, D_MODEL), 1.0),
        'x_sample': nrm((DEC_BATCH, DEC_SEQ, D_MODEL), 1.0),
        'cache_mla_ckv': nrm((DEPTH, DEC_BATCH, PAST_LEN, MLA_KV_RANK), 1.0),
        'cache_mla_kpe': nrm((DEPTH, DEC_BATCH, PAST_LEN, MLA_ROPE), 1.0),
        'state_gdn': nrm((DEPTH, DEC_BATCH, GDN_HEADS, GDN_DK, GDN_DV), 0.1),
        'state_gdn_conv': nrm((DEPTH, DEC_BATCH, GDN_CONV - 1, QKV_DIM), 1.0),
        'state_conv': nrm((DEPTH, DEC_BATCH, CONV_WIDTH - 1, CONV_CH), 0.5),
        'w_in': nrm((DEPTH, D_MODEL, D_IN), D_MODEL ** -0.5),
        'mla_q_norm': gain((DEPTH, MLA_Q_RANK)),
        'w_uq': nrm((DEPTH, MLA_Q_RANK, MLA_HEADS * (MLA_NOPE + MLA_ROPE)), MLA_Q_RANK ** -0.5),
        'mla_kv_norm': gain((DEPTH, MLA_KV_RANK)),
        'w_uk': nrm((DEPTH, MLA_KV_RANK, MLA_HEADS, MLA_NOPE), MLA_KV_RANK ** -0.5),
        'w_uv': nrm((DEPTH, MLA_KV_RANK, MLA_HEADS, MLA_V), DN_BETA * MLA_KV_RANK ** -0.5),
        'gdn_conv_w': nrm((DEPTH, GDN_CONV, QKV_DIM), GDN_CONV ** -0.5),
        'gdn_a_log': jnp.log(jax.random.uniform(next(ks), (DEPTH, GDN_HEADS), jnp.float32, minval=1.0, maxval=16.0)),
        'gdn_dt_bias': dt + jnp.log(-jnp.expm1(-dt)),
        'gdn_norm': gain((DEPTH, GDN_DV)),
        'conv_w': nrm((DEPTH, CONV_WIDTH, CONV_CH), CONV_WIDTH ** -0.5),
        'conv_b': nrm((DEPTH, CONV_CH), 0.01),
        'conv_ln_g': gain((DEPTH, CONV_CH)),
        'conv_ln_b': nrm((DEPTH, CONV_CH), 0.01),
        'w_out': nrm((DEPTH, D_MIX, D_MODEL), DN_BETA * D_MIX ** -0.5),
        'ln1_g': gain((DEPTH, D_MODEL)),
        'ln1_b': nrm((DEPTH, D_MODEL), 0.01),
        'w_gate': nrm((DEPTH, D_MODEL, D_FF), D_MODEL ** -0.5),
        'w_up': nrm((DEPTH, D_MODEL, D_FF), DN_BETA * D_MODEL ** -0.5),
        'w_down': nrm((DEPTH, D_FF, D_MODEL), DN_BETA * D_FF ** -0.5),
        'ln2_g': gain((DEPTH, D_MODEL)),
        'ln2_b': nrm((DEPTH, D_MODEL), 0.01),
    }


def reference(x_prompt, x_sample, cache_mla_ckv, cache_mla_kpe, state_gdn, state_gdn_conv, state_conv,
              w_in, mla_q_norm, w_uq, mla_kv_norm, w_uk, w_uv, gdn_conv_w, gdn_a_log, gdn_dt_bias, gdn_norm,
              conv_w, conv_b, conv_ln_g, conv_ln_b, w_out, ln1_g, ln1_b, w_gate, w_up, w_down, ln2_g, ln2_b):
    B = x_prompt.shape[0]
    xp, xs = x_prompt, x_sample
    st_p = [[], [], [], [], []]
    st_s = [[], [], [], [], []]
    for l in range(DEPTH):
        p = {'w_in': w_in[l], 'mla_q_norm': mla_q_norm[l], 'w_uq': w_uq[l], 'mla_kv_norm': mla_kv_norm[l],
             'w_uk': w_uk[l], 'w_uv': w_uv[l], 'gdn_conv_w': gdn_conv_w[l], 'gdn_a_log': gdn_a_log[l],
             'gdn_dt_bias': gdn_dt_bias[l], 'gdn_norm': gdn_norm[l], 'conv_w': conv_w[l], 'conv_b': conv_b[l],
             'conv_ln_g': conv_ln_g[l], 'conv_ln_b': conv_ln_b[l], 'w_out': w_out[l], 'ln1_g': ln1_g[l],
             'ln1_b': ln1_b[l], 'w_gate': w_gate[l], 'w_up': w_up[l], 'w_down': w_down[l],
             'ln2_g': ln2_g[l], 'ln2_b': ln2_b[l]}
        zS = jnp.zeros((B, GDN_HEADS, GDN_DK, GDN_DV), jnp.float32)
        zg = jnp.zeros((B, GDN_CONV - 1, QKV_DIM), xp.dtype)
        zc = jnp.zeros((B, CONV_WIDTH - 1, CONV_CH), xp.dtype)
        xp, sp = _layer(xp, p, None, None, zS, zg, zc, 0)
        xs, ss = _layer(xs, p, cache_mla_ckv[l], cache_mla_kpe[l], state_gdn[l], state_gdn_conv[l],
                        state_conv[l], PAST_LEN)
        for i in range(5):
            st_p[i].append(sp[i])
            st_s[i].append(ss[i])
    ckv_p, kpe_p, gdn_p, gconv_p, conv_p = [jnp.stack(o) for o in st_p]
    ckv_s, kpe_s, gdn_s, gconv_s, conv_s = [jnp.stack(o) for o in st_s]
    return (xp, xs, ckv_p, kpe_p, gdn_p, gconv_p, conv_p, ckv_s, kpe_s, gdn_s, gconv_s, conv_s)
```

```cpp
#include <hip/hip_runtime.h>
#include <hip/hip_cooperative_groups.h>
#include <cstdio>
#include <cstdint>
namespace cg = cooperative_groups;
namespace pg8 {
#define PG8_LAS __attribute__((address_space(3)))
typedef unsigned short bf16_t;
typedef short bf16x8 __attribute__((ext_vector_type(8)));
typedef float f32x4 __attribute__((ext_vector_type(4)));
typedef unsigned u32x4 __attribute__((ext_vector_type(4)));
constexpr int BM = 256, BK = 64, HALF = 128, HTB = HALF * BK * 2  , STAGE_BYTES = 8 * HTB, NXCD = 8, WGM = 8;

__host__ __device__ __forceinline__ int lds_byte(int r, int c) { const int st = (r >> 4) * 2 + (c >> 5), rr = r & 15, cc = c & 31, ob = rr * 64 + cc * 2; return st * 1024 + (ob ^ (((ob >> 9) & 1) << 5)); }
__host__ __device__ __forceinline__ void stage_rc(int b, int& R, int& C) { const int st = b / 1024, sb = b % 1024, swz = sb ^ (((sb >> 9) & 1) << 5); R = (st >> 1) * 16 + swz / 64; C = (st & 1) * 32 + (swz % 64) / 2; }
__host__ __device__ __forceinline__ int perm32(int rho) { const int n = rho >> 4, i = rho & 15; return 8 * (i >> 2) + 4 * n + (i & 3); }

struct Unit { int pm, pn; };
struct Gemm { const bf16_t* A; const bf16_t* Bt; int M, N, K; };

struct StaticOrder {
    int nM, nN, nwg, G, c;
    __host__ __device__ void init(int M, int N, int G_, int c_) { nM = M / BM; nN = N / BM; nwg = nM * nN; G = G_; c = c_; }
    __host__ __device__ bool next(int i, Unit& u) const {
        const long L = (long)i * G + c; if (L >= nwg) return false;
        int wgid = (int)L; { const int q = nwg / NXCD, r = nwg % NXCD, xcd = wgid % NXCD, off = wgid / NXCD; wgid = (xcd < r ? xcd * (q + 1) : r * (q + 1) + (xcd - r) * q) + off; }
        const int nig = WGM * nN, gid = wgid / nig, fm = gid * WGM, gsz = (nM - fm) < WGM ? (nM - fm) : WGM;
        u.pm = fm + ((wgid % nig) % gsz); u.pn = (wgid % nig) / gsz; return true;
    }
    __device__ __forceinline__ void a_ready(const Unit&) const {}
    __device__ __forceinline__ void done(const Unit&) const {}
};
__device__ __forceinline__ unsigned cvt_pk_bf16(float lo, float hi) { unsigned r; asm volatile("v_cvt_pk_bf16_f32 %0, %1, %2" : "=v"(r) : "v"(lo), "v"(hi)); return r; }
template <class Epi, class Sched, bool ALIGN_EPI = false, bool SP2 = false>
__device__ __forceinline__ void gemm_phase(PG8_LAS unsigned char* lds, const Gemm g, const Sched& S, const Epi& E, const int tid) {
    const int  wid = __builtin_amdgcn_readfirstlane(tid >> 6), lane = tid & 63, wr = wid >> 2, wc = wid & 3, fr = lane & 15, fq = lane >> 4;
    const int K = g.K, nt = K / BK;
    unsigned voffA[2], voffB[2];
#pragma unroll
    for (int i = 0; i < 2; ++i) { int R, C; stage_rc(tid * 16 + i * 8192, R, C); const int Rb = Epi::PERM ? ((R & ~31) + perm32(R & 31)) : R;
        voffA[i] = (unsigned)(R * K + C) * 2u; voffB[i] = (unsigned)(Rb * K + C) * 2u; }
    const size_t kstep = (size_t)(BK * 2);
    const size_t hstep = (size_t)HALF * K * 2;
    const size_t tstep = 2 * hstep;
    const unsigned ldsw = (unsigned)wid * 1024u;
    const int aoff = lds_byte(wr * 64 + fr, fq * 8), boff = lds_byte(wc * 32 + fr, fq * 8);
#define PG8_SA(b, h) (((b) * 2 + (h)) * HTB)
#define PG8_SB(b, h) ((4 + (b) * 2 + (h)) * HTB)
#define PG8_STAGE(bufoff, gbase, voff) do { _Pragma("unroll") for (int _i = 0; _i < 2; ++_i) \
        __builtin_amdgcn_global_load_lds((const unsigned*)((const char*)(gbase) + (voff)[_i]), (PG8_LAS unsigned*)(lds + (bufoff) + ldsw + _i * 8192), 16, 0, 0); } while (0)
#define PG8_LDA(dst, b, h) do { _Pragma("unroll") for (int m = 0; m < 4; ++m) _Pragma("unroll") for (int k = 0; k < 2; ++k) dst[m][k] = *(const PG8_LAS bf16x8*)(lds + PG8_SA(b, h) + aoff + m * 2048 + k * 1024); } while (0)
#define PG8_LDB(dst, b, h) do { _Pragma("unroll") for (int n = 0; n < 2; ++n) _Pragma("unroll") for (int k = 0; k < 2; ++k) dst[n][k] = *(const PG8_LAS bf16x8*)(lds + PG8_SB(b, h) + boff + n * 2048 + k * 1024); } while (0)
#define PG8_MMA(ai, bj, At, Bt) do { __builtin_amdgcn_s_setprio(1); _Pragma("unroll") for (int m = 0; m < 4; ++m) _Pragma("unroll") for (int n = 0; n < 2; ++n) _Pragma("unroll") for (int k = 0; k < 2; ++k) \
        acc[ai][bj][m][n] = __builtin_amdgcn_mfma_f32_16x16x32_bf16(Bt[n][k], At[m][k], acc[ai][bj][m][n], 0, 0, 0); __builtin_amdgcn_s_setprio(0); } while (0)
#define PG8_WAIT_V(n) asm volatile("s_waitcnt vmcnt(" #n ")" ::: "memory")
#define PG8_WAIT_L(n) asm volatile("s_waitcnt lgkmcnt(" #n ")" ::: "memory")
#define PG8_BAR __builtin_amdgcn_s_barrier()
#define PG8_SCHED __builtin_amdgcn_sched_barrier(0)
    Unit cur, nxt; int ui = 0;
    if (!S.next(0, cur)) return;
    f32x4 acc[2][2][4][2];
#pragma unroll
    for (int a = 0; a < 2; ++a)
#pragma unroll
        for (int b = 0; b < 2; ++b)
#pragma unroll
            for (int m = 0; m < 4; ++m)
#pragma unroll
                for (int n = 0; n < 2; ++n) acc[a][b][m][n] = (f32x4){0.f, 0.f, 0.f, 0.f};
    bf16x8 At[4][2], B0[2][2], B1[2][2];
    const char* cA = (const char*)g.A + (size_t)cur.pm * tstep; const char* cB = (const char*)g.Bt + (size_t)cur.pn * tstep;
    S.a_ready(cur);
    if constexpr (SP2) {
        PG8_STAGE(PG8_SB(0, 0), cB, voffB); PG8_STAGE(PG8_SB(0, 1), cB + hstep, voffB); PG8_STAGE(PG8_SA(0, 0), cA, voffA); PG8_STAGE(PG8_SA(0, 1), cA + hstep, voffA);
        if (wr == 1) PG8_BAR;
        PG8_WAIT_V(2); PG8_BAR;
        PG8_STAGE(PG8_SB(1, 0), cB + kstep, voffB); PG8_STAGE(PG8_SA(1, 0), cA + kstep, voffA); PG8_STAGE(PG8_SB(1, 1), cB + hstep + kstep, voffB);
        PG8_WAIT_V(6); PG8_BAR;
    } else {
        PG8_STAGE(PG8_SB(0, 0), cB, voffB); PG8_STAGE(PG8_SA(0, 0), cA, voffA); PG8_STAGE(PG8_SB(0, 1), cB + hstep, voffB); PG8_STAGE(PG8_SA(0, 1), cA + hstep, voffA);
        if (wr == 1) PG8_BAR;
        PG8_WAIT_V(4); PG8_BAR;
        PG8_STAGE(PG8_SB(1, 0), cB + kstep, voffB); PG8_STAGE(PG8_SA(1, 0), cA + kstep, voffA); PG8_STAGE(PG8_SB(1, 1), cB + hstep + kstep, voffB);
        PG8_WAIT_V(6); PG8_BAR;
    }
    for (;;) {
        const bool has_next = S.next(ui + 1, nxt);
        const char* nA = has_next ? (const char*)g.A + (size_t)nxt.pm * tstep : cA; const char* nB = has_next ? (const char*)g.Bt + (size_t)nxt.pn * tstep : cB;
        for (int t = 0; t < nt; t += 2) {
            const bool last = (t == nt - 2);
            const char* a1 = cA + (size_t)(t + 1) * kstep;
            const char* a2 = last ? nA : cA + (size_t)(t + 2) * kstep; const char* b2 = last ? nB : cB + (size_t)(t + 2) * kstep;
            const char* a3 = a2 + kstep; const char* b3 = b2 + kstep;
            if (last && has_next) S.a_ready(nxt);
            if constexpr (SP2) {
            PG8_LDB(B0, 0, 0); PG8_LDB(B1, 0, 1); PG8_SCHED; PG8_LDA(At, 0, 0); PG8_STAGE(PG8_SA(1, 1), a1 + hstep, voffA);
            PG8_WAIT_V(8); PG8_WAIT_L(0); PG8_BAR; PG8_MMA(0, 0, At, B0); PG8_MMA(0, 1, At, B1); PG8_BAR; PG8_SCHED;
            PG8_LDA(At, 0, 1); PG8_STAGE(PG8_SB(0, 0), b2, voffB); PG8_STAGE(PG8_SB(0, 1), b2 + hstep, voffB); PG8_STAGE(PG8_SA(0, 0), a2, voffA);
            PG8_WAIT_V(8); PG8_WAIT_L(0); PG8_BAR; PG8_MMA(1, 0, At, B0); PG8_MMA(1, 1, At, B1); PG8_BAR; PG8_SCHED;
            PG8_LDB(B0, 1, 0); PG8_LDB(B1, 1, 1); PG8_SCHED; PG8_LDA(At, 1, 0); PG8_STAGE(PG8_SA(0, 1), a2 + hstep, voffA);
            PG8_WAIT_V(8); PG8_WAIT_L(0); PG8_BAR; PG8_MMA(0, 0, At, B0); PG8_MMA(0, 1, At, B1); PG8_BAR; PG8_SCHED;
            PG8_LDA(At, 1, 1); PG8_STAGE(PG8_SB(1, 0), b3, voffB); PG8_STAGE(PG8_SB(1, 1), b3 + hstep, voffB); PG8_STAGE(PG8_SA(1, 0), a3, voffA);
            PG8_WAIT_V(8); PG8_WAIT_L(0); PG8_BAR; PG8_MMA(1, 0, At, B0); PG8_MMA(1, 1, At, B1); PG8_BAR; PG8_SCHED;
            } else {
            PG8_LDB(B0, 0, 0); PG8_SCHED; PG8_LDA(At, 0, 0); PG8_STAGE(PG8_SA(1, 1), a1 + hstep, voffA);
            PG8_WAIT_L(8); PG8_BAR; PG8_WAIT_L(0); PG8_MMA(0, 0, At, B0); PG8_BAR; PG8_SCHED;
            PG8_LDB(B1, 0, 1); PG8_STAGE(PG8_SB(0, 0), b2, voffB);
            PG8_BAR; PG8_WAIT_L(0); PG8_MMA(0, 1, At, B1); PG8_BAR;
            PG8_LDA(At, 0, 1); PG8_STAGE(PG8_SA(0, 0), a2, voffA);
            PG8_BAR; PG8_WAIT_L(0); PG8_MMA(1, 0, At, B0); PG8_BAR; PG8_SCHED;
            PG8_STAGE(PG8_SB(0, 1), b2 + hstep, voffB);
            PG8_WAIT_V(6); PG8_BAR; PG8_MMA(1, 1, At, B1); PG8_BAR;
            PG8_LDB(B0, 1, 0); PG8_SCHED; PG8_LDA(At, 1, 0); PG8_STAGE(PG8_SA(0, 1), a2 + hstep, voffA);
            PG8_WAIT_L(8); PG8_BAR; PG8_WAIT_L(0); PG8_MMA(0, 0, At, B0); PG8_BAR; PG8_SCHED;
            PG8_LDB(B1, 1, 1); PG8_STAGE(PG8_SB(1, 0), b3, voffB);
            PG8_BAR; PG8_WAIT_L(0); PG8_MMA(0, 1, At, B1); PG8_BAR;
            PG8_LDA(At, 1, 1); PG8_STAGE(PG8_SA(1, 0), a3, voffA);
            PG8_BAR; PG8_WAIT_L(0); PG8_MMA(1, 0, At, B0); PG8_BAR; PG8_SCHED;
            PG8_STAGE(PG8_SB(1, 1), b3 + hstep, voffB);
            PG8_WAIT_V(6); PG8_BAR; PG8_MMA(1, 1, At, B1); PG8_BAR;
            }
        }
        if constexpr (ALIGN_EPI) { if (wr == 0) PG8_BAR; }
        if constexpr (!Epi::AFTER_DRAIN) { E(acc, cur, wr, wc, fr, fq); S.done(cur); }
        if (!has_next) break;
#pragma unroll
        for (int a = 0; a < 2; ++a)
#pragma unroll
            for (int b = 0; b < 2; ++b)
#pragma unroll
                for (int m = 0; m < 4; ++m)
#pragma unroll
                    for (int n = 0; n < 2; ++n) acc[a][b][m][n] = (f32x4){0.f, 0.f, 0.f, 0.f};
        cur = nxt; cA = nA; cB = nB; ++ui;
        if constexpr (ALIGN_EPI) { if (wr == 1) PG8_BAR; }
    }
    PG8_WAIT_V(0);
    if constexpr (!ALIGN_EPI) { if (wr == 0) PG8_BAR; }
    PG8_BAR;
    if constexpr (Epi::AFTER_DRAIN) { E.fused(acc, cur, wr, wc, fr, fq, lds, wid, lane); S.done(cur); }
#undef PG8_SA
#undef PG8_SB
#undef PG8_STAGE
#undef PG8_LDA
#undef PG8_LDB
#undef PG8_MMA
#undef PG8_WAIT_V
#undef PG8_WAIT_L
#undef PG8_BAR
#undef PG8_SCHED
}
}

#define LAS __attribute__((address_space(3)))
typedef unsigned short bf16;
typedef short bf16x8 __attribute__((ext_vector_type(8)));
typedef short s16x4 __attribute__((ext_vector_type(4)));
typedef float f32x4 __attribute__((ext_vector_type(4)));
typedef unsigned u32x4 __attribute__((ext_vector_type(4)));
typedef unsigned u32x2 __attribute__((ext_vector_type(2)));

#ifndef COOP
#define COOP 1
#endif
#ifndef REPK
#define REPK 0
#endif
#ifndef REPG1
#define REPG1 0
#endif
#ifndef REP2
#define REP2 0
#endif
#ifndef GDN_SPLIT
#define GDN_SPLIT 0
#endif

constexpr int MP = 32768, MS = 512, MT = MP + MS;
constexpr int SKS = 2064;
constexpr int NK = MP + 32 * SKS;
constexpr int NKM = MP + 65536;
constexpr int HLD = 2304;
constexpr int C_CKV = 384, C_KPE = 640, C_QKV = 672, C_B = 1440, C_A = 1444, C_Z = 1448, C_GA = 1704, C_GG = 1960;
constexpr int DFF = 2816;
constexpr float DN_ALPHA = 1.41421356237f;
constexpr float QSCALE = 0.10206207261596577f * 1.4426950408889634f;

constexpr size_t O_YP = 0, O_YS = 33554432, O_CKVP = 34078720, O_KPEP = 50855936, O_GDNP = 52953088, O_GCP = 53477376,
                 O_CVP = 53551104, O_CKVS = 53796864, O_KPES = 54059008, O_GDNS = 54091776, O_GCS = 55140352, O_CVS = 55287808;

constexpr size_t W_IN = 0, W_UQ = W_IN + 2304 * 1024, W_UK = W_UQ + 768 * 384, W_UVT = W_UK + 512 * 256, W_OUT = W_UVT + 512 * 256,
                 W_GU = W_OUT + 1024 * 1024, W_DN = W_GU + 5632 * 1024, W_LAYER = W_DN + 1024 * 2816;
constexpr size_t WS_W = 0, WS_ROPE = WS_W + 2 * W_LAYER * 2, WS_XB = WS_ROPE + 2064 * 16 * 8, WS_MIX = WS_XB + (size_t)MT * 1024 * 2,
                 WS_CQN = WS_MIX + (size_t)MT * 1024 * 2, WS_CKVB = WS_CQN + (size_t)MT * 384 * 2, WS_KPEB = WS_CKVB + (size_t)NK * 256 * 2,
                 WS_BIG = WS_KPEB + (size_t)NK * 32 * 2;
constexpr size_t GUNIT = 49408;
constexpr int NGU = 2176;
constexpr size_t WS_H = WS_BIG, WS_GSCR = WS_H + (size_t)MT * HLD * 2, BIG1 = (size_t)MT * HLD * 2 + (size_t)NGU * GUNIT;
constexpr size_t WS_Q = WS_BIG, WS_KN = WS_Q + (size_t)MT * 768 * 2, WS_VT = WS_KN + (size_t)NK * 512 * 2, BIG2 = (size_t)MT * 768 * 2 + 2 * (size_t)NK * 512 * 2;
constexpr size_t WS_F = WS_BIG, BIG3 = (size_t)MT * DFF * 2;
constexpr size_t BIGSZ = BIG1 > BIG2 ? (BIG1 > BIG3 ? BIG1 : BIG3) : (BIG2 > BIG3 ? BIG2 : BIG3);
constexpr size_t WS_BAR = WS_BIG + BIGSZ;
constexpr size_t WS_TOTAL = WS_BAR + 8192;
static_assert(WS_TOTAL <= 536870912ull, "workspace map exceeds 512 MiB");
static_assert(WS_XB % 256 == 0 && WS_BIG % 256 == 0 && WS_GSCR % 256 == 0 && WS_KN % 256 == 0 && WS_VT % 256 == 0, "alignment");

constexpr int LDS_BYTES = 139264;
constexpr int G1_GRP = 67584;

struct Params { const float* in[29]; float* out; unsigned char* ws; int lo, hi; };
template <int OFF> __device__ __forceinline__ unsigned long long karg_u64() {
    unsigned long long v; const unsigned long long kp = (unsigned long long)__builtin_amdgcn_kernarg_segment_ptr();
    asm volatile("s_load_dwordx2 %0, %1, %2\n\ts_waitcnt lgkmcnt(0)" : "=s"(v) : "s"(kp), "n"(OFF));
    return v;
}
#define GAS1 __attribute__((address_space(1)))
#define KIN(i) ((const float*)(const GAS1 float*)karg_u64<8 * (i)>())
#define KOUT() ((float*)(GAS1 float*)karg_u64<232>())
#define KWS() ((unsigned char*)(GAS1 unsigned char*)karg_u64<240>())
struct PP { unsigned char* ws; float* out; int tid, bid, G; };

__device__ __forceinline__ unsigned f2bf(float f) { unsigned u = __builtin_bit_cast(unsigned, f); return (u + 0x7fffu + ((u >> 16) & 1u)) >> 16; }
__device__ __forceinline__ float bf2f(unsigned b) { return __builtin_bit_cast(float, b << 16); }
__device__ __forceinline__ unsigned pk2(float lo, float hi) { return pg8::cvt_pk_bf16(lo, hi); }
__device__ __forceinline__ float sigmoidf_(float x) { return 1.0f / (1.0f + __expf(-x)); }
__device__ __forceinline__ float siluf_(float x) { return x * sigmoidf_(x); }

template <int CTRL> __device__ __forceinline__ float dpp_f(float v) { return __builtin_bit_cast(float, __builtin_amdgcn_update_dpp(0, __builtin_bit_cast(int, v), CTRL, 0xf, 0xf, false)); }
__device__ __forceinline__ float row16_sum(float v) { v += dpp_f<0xB1>(v); v += dpp_f<0x4E>(v); v += dpp_f<0x141>(v); v += dpp_f<0x140>(v); return v; }
__device__ __forceinline__ float xor16_get(float v) { return __builtin_bit_cast(float, __builtin_amdgcn_ds_swizzle(__builtin_bit_cast(int, v), 0x401F)); }
__device__ __forceinline__ float xor32_max(float v) { const unsigned u = __builtin_bit_cast(unsigned, v); auto r = __builtin_amdgcn_permlane32_swap(u, u, false, false); return fmaxf(__builtin_bit_cast(float, (unsigned)r[0]), __builtin_bit_cast(float, (unsigned)r[1])); }
__device__ __forceinline__ float xor32_sum(float v) { const unsigned u = __builtin_bit_cast(unsigned, v); auto r = __builtin_amdgcn_permlane32_swap(u, u, false, false); return __builtin_bit_cast(float, (unsigned)r[0]) + __builtin_bit_cast(float, (unsigned)r[1]); }
__device__ __forceinline__ float wave_sum(float v) {
    v = row16_sum(v); const int iv = __builtin_bit_cast(int, v);
    const float s0 = __builtin_bit_cast(float, __builtin_amdgcn_readlane(iv, 0)), s1 = __builtin_bit_cast(float, __builtin_amdgcn_readlane(iv, 16));
    const float s2 = __builtin_bit_cast(float, __builtin_amdgcn_readlane(iv, 32)), s3 = __builtin_bit_cast(float, __builtin_amdgcn_readlane(iv, 48));
    return (s0 + s1) + (s2 + s3);
}
#define LBAR() asm volatile("s_waitcnt lgkmcnt(0)\n\ts_barrier" ::: "memory")
__device__ __forceinline__ f32x4 mfma16(bf16x8 a, bf16x8 b, f32x4 c) { return __builtin_amdgcn_mfma_f32_16x16x32_bf16(a, b, c, 0, 0, 0); }

template <bool P> struct EpiT {
    static constexpr bool PERM = P, AFTER_DRAIN = false;
    int mode;
    bf16* O; size_t ldc;
    const float* xp; const float* xs; float* X;
    const float2* rope;
    __device__ __forceinline__ void operator()(const f32x4 (&acc)[2][2][4][2], const pg8::Unit& u, int wr, int wc, int fr, int fq) const {
        const int row0 = u.pm * 256 + wr * 64 + fr;
        if constexpr (P) {
            if (mode == 0) {
                const int col0 = u.pn * 256 + wc * 32 + 8 * fq;
#pragma unroll
                for (int ai = 0; ai < 2; ++ai)
#pragma unroll
                    for (int m = 0; m < 4; ++m) { bf16* rowp = O + (size_t)(row0 + ai * 128 + m * 16) * ldc + col0;
#pragma unroll
                        for (int bj = 0; bj < 2; ++bj) { const f32x4 v0 = acc[ai][bj][m][0], v1 = acc[ai][bj][m][1]; u32x4 w;
                            w.x = pk2(v0[0], v0[1]); w.y = pk2(v0[2], v0[3]); w.z = pk2(v1[0], v1[1]); w.w = pk2(v1[2], v1[3]);
                            *(u32x4*)(rowp + bj * 128) = w; } }
            } else {
                const int col0 = u.pn * 128 + wc * 32 + 8 * fq;
#pragma unroll
                for (int ai = 0; ai < 2; ++ai)
#pragma unroll
                    for (int m = 0; m < 4; ++m) { bf16* rowp = O + (size_t)(row0 + ai * 128 + m * 16) * ldc + col0;
                        float f[8];
#pragma unroll
                        for (int n = 0; n < 2; ++n)
#pragma unroll
                            for (int j = 0; j < 4; ++j) { const float g = acc[ai][0][m][n][j], up = acc[ai][1][m][n][j]; f[n * 4 + j] = siluf_(g) * up; }
                        u32x4 w; w.x = pk2(f[0], f[1]); w.y = pk2(f[2], f[3]); w.z = pk2(f[4], f[5]); w.w = pk2(f[6], f[7]);
                        *(u32x4*)rowp = w; }
            }
        } else {
            if (mode == 3) {
#pragma unroll
                for (int ai = 0; ai < 2; ++ai)
#pragma unroll
                    for (int m = 0; m < 4; ++m) { const int row = row0 + ai * 128 + m * 16;
                        const float* src = (row < MP) ? xp + (size_t)row * 1024 : xs + (size_t)(row - MP) * 1024;
                        float* dst = X + (size_t)row * 1024;
#pragma unroll
                        for (int bj = 0; bj < 2; ++bj)
#pragma unroll
                            for (int n = 0; n < 2; ++n) { const int col = u.pn * 256 + bj * 128 + wc * 32 + n * 16 + 4 * fq;
                                const f32x4 xi = *(const f32x4*)(src + col); f32x4 o = xi * DN_ALPHA + acc[ai][bj][m][n];
                                *(f32x4*)(dst + col) = o; }
                        __builtin_amdgcn_sched_barrier(0); }
            } else {
#pragma unroll
                for (int ai = 0; ai < 2; ++ai)
#pragma unroll
                    for (int m = 0; m < 4; ++m) { const int row = row0 + ai * 128 + m * 16;
                        const int pos = (row < MP) ? (row & 2047) : (2048 + ((row - MP) & 15));
                        bf16* rowp = O + (size_t)row * 768;
#pragma unroll
                        for (int bj = 0; bj < 2; ++bj) { const int g32 = u.pn * 256 + bj * 128 + wc * 32;
                            f32x4 a = acc[ai][bj][m][0], b = acc[ai][bj][m][1];
                            if ((g32 % 96) == 64) {
                                const float2* rp = rope + pos * 16 + 4 * fq;
#pragma unroll
                                for (int j = 0; j < 4; ++j) { const float2 cs = rp[j]; const float x1 = a[j], x2 = b[j]; a[j] = x1 * cs.x - x2 * cs.y; b[j] = x1 * cs.y + x2 * cs.x; }
                            }
                            a = a * QSCALE; b = b * QSCALE;
                            u32x2 w0, w1; w0.x = pk2(a[0], a[1]); w0.y = pk2(a[2], a[3]); w1.x = pk2(b[0], b[1]); w1.y = pk2(b[2], b[3]);
                            *(u32x2*)(rowp + g32 + 4 * fq) = w0; *(u32x2*)(rowp + g32 + 16 + 4 * fq) = w1; }
                        __builtin_amdgcn_sched_barrier(0); }
            }
        }
    }
};

__device__ __forceinline__ void prep_phase(const PP P, LAS unsigned char* lds, const int wl, const bool do_rest) {
    const int tid = P.tid, G = P.G;
    LAS float* tile = (LAS float*)lds;
    bf16* WB = (bf16*)(P.ws + WS_W);
    const int tx = tid & 63, ty = tid >> 6;
    for (int it = P.bid; it < 3080; it += G) {
        const int l = wl, r = it;
        const float* src; int ld, K, kt_n, tt; bf16* dst; int kind;
        if (r < 576)       { kind = 0; tt = r;        src = KIN(7) + (size_t)l * 1024 * 2216;  ld = 2216; K = 1024; kt_n = 16; dst = WB + l * W_LAYER + W_IN; }
        else if (r < 648)  { kind = 1; tt = r - 576;  src = KIN(9) + (size_t)l * 384 * 768;    ld = 768;  K = 384;  kt_n = 6;  dst = WB + l * W_LAYER + W_UQ; }
        else if (r < 680)  { kind = 1; tt = r - 648;  src = KIN(11) + (size_t)l * 256 * 512;   ld = 512;  K = 256;  kt_n = 4;  dst = WB + l * W_LAYER + W_UK; }
        else if (r < 712)  { kind = 1; tt = r - 680;  src = KIN(12) + (size_t)l * 256 * 512;   ld = 512;  K = 256;  kt_n = 4;  dst = WB + l * W_LAYER + W_UVT; }
        else if (r < 968)  { kind = 1; tt = r - 712;  src = KIN(21) + (size_t)l * 1024 * 1024; ld = 1024; K = 1024; kt_n = 16; dst = WB + l * W_LAYER + W_OUT; }
        else if (r < 2376) { kind = 2; tt = r - 968;  src = nullptr;                            ld = 2816; K = 1024; kt_n = 16; dst = WB + l * W_LAYER + W_GU; }
        else               { kind = 1; tt = r - 2376; src = KIN(26) + (size_t)l * 2816 * 1024; ld = 1024; K = 2816; kt_n = 44; dst = WB + l * W_LAYER + W_DN; }
        const int n0 = (tt / kt_n) * 64, k0 = (tt % kt_n) * 64;
        int col0 = n0; bool valid = true;
        if (kind == 0) valid = (n0 + tx) < 2216;
        if (kind == 2) { src = (((n0 >> 7) & 1) ? KIN(25) : KIN(24)) + (size_t)l * 1024 * 2816; col0 = (n0 >> 8) * 128 + (n0 & 127); }
#pragma unroll
        for (int kk = ty; kk < 64; kk += 8) tile[kk * 65 + tx] = valid ? src[(size_t)(k0 + kk) * ld + col0 + tx] : 0.f;
        __syncthreads();
#pragma unroll
        for (int nn = ty; nn < 64; nn += 8) dst[(size_t)(n0 + nn) * K + k0 + tx] = (bf16)f2bf(tile[tx * 65 + nn]);
        __syncthreads();
    }
    if (!do_rest) return;
    bf16* XB = (bf16*)(P.ws + WS_XB);
    for (int g = P.bid * 512 + tid; g < MT * 128; g += G * 512) {
        const int row = g >> 7, c8 = g & 127;
        const float* s = (row < MP) ? KIN(0) + (size_t)row * 1024 + c8 * 8 : KIN(1) + (size_t)(row - MP) * 1024 + c8 * 8;
        const f32x4 a = *(const f32x4*)s, b = *(const f32x4*)(s + 4);
        u32x4 w; w.x = pk2(a[0], a[1]); w.y = pk2(a[2], a[3]); w.z = pk2(b[0], b[1]); w.w = pk2(b[2], b[3]);
        *(u32x4*)(XB + (size_t)g * 8) = w;
    }
    float2* rope = (float2*)(P.ws + WS_ROPE);
    for (int idx = P.bid * 512 + tid; idx < 2064 * 16; idx += G * 512) {
        const int pos = idx >> 4, i = idx & 15;
        const float inv = __expf(-9.210340371976184f * (float)i / 16.0f);
        const float ang = (float)pos * inv;
        const float k = rintf(ang * 0.15915494309189535f);
        float rr = fmaf(-k, 6.2831854820251465f, ang); rr = fmaf(k, 1.7484555e-7f, rr);
        rope[idx] = make_float2(__cosf(rr), __sinf(rr));
    }
}

__device__ __forceinline__ void tok_phase(const PP P, int l) {
    const int tid = P.tid, lane = tid & 63, wave = tid >> 6, G = P.G;
    const bf16* H = (const bf16*)(P.ws + WS_H);
    bf16* CQN = (bf16*)(P.ws + WS_CQN); bf16* CKVB = (bf16*)(P.ws + WS_CKVB); bf16* KPEB = (bf16*)(P.ws + WS_KPEB);
    const float2* rope = (const float2*)(P.ws + WS_ROPE);
    const float* qn = KIN(8) + l * 384; const float* kvn = KIN(10) + l * 256;
    float* out = P.out;
    for (int row = P.bid * 8 + wave; row < MT; row += G * 8) {
        const bf16* hr = H + (size_t)row * HLD;
        const bool smp = row >= MP; int b, t, pos;
        if (!smp) { b = row >> 11; t = row & 2047; pos = t; } else { const int rr = row - MP; b = rr >> 4; t = rr & 15; pos = 2048 + t; }
        const size_t krow = smp ? (size_t)MP + 65536 + (size_t)b * 16 + t : (size_t)row;
        { float v[6]; float ss = 0.f;
#pragma unroll
          for (int i = 0; i < 3; ++i) { const unsigned w = *(const unsigned*)(hr + 128 * i + lane * 2); v[2 * i] = bf2f(w & 0xffffu); v[2 * i + 1] = bf2f(w >> 16); ss += v[2 * i] * v[2 * i] + v[2 * i + 1] * v[2 * i + 1]; }
          ss = wave_sum(ss); const float rinv = rsqrtf(ss * (1.0f / 384.0f) + 1e-6f);
#pragma unroll
          for (int i = 0; i < 3; ++i) { const int col = 128 * i + lane * 2; *(unsigned*)(CQN + (size_t)row * 384 + col) = pk2(v[2 * i] * rinv * qn[col], v[2 * i + 1] * rinv * qn[col + 1]); } }
        { const u32x2 w = *(const u32x2*)(hr + C_CKV + lane * 4);
          float v0 = bf2f(w.x & 0xffffu), v1 = bf2f(w.x >> 16), v2 = bf2f(w.y & 0xffffu), v3 = bf2f(w.y >> 16);
          float ss = wave_sum(v0 * v0 + v1 * v1 + v2 * v2 + v3 * v3); const float rinv = rsqrtf(ss * (1.0f / 256.0f) + 1e-6f);
          const f32x4 gn = *(const f32x4*)(kvn + lane * 4);
          f32x4 o; o[0] = v0 * rinv * gn[0]; o[1] = v1 * rinv * gn[1]; o[2] = v2 * rinv * gn[2]; o[3] = v3 * rinv * gn[3];
          float* op = smp ? out + O_CKVS + ((size_t)(l * 32 + b) * 16 + t) * 256 : out + O_CKVP + ((size_t)(l * 16 + b) * 2048 + t) * 256;
          *(f32x4*)(op + lane * 4) = o;
          u32x2 pw; pw.x = pk2(o[0], o[1]); pw.y = pk2(o[2], o[3]); *(u32x2*)(CKVB + krow * 256 + lane * 4) = pw; }
        if (lane < 16) { const float x1 = bf2f(hr[C_KPE + lane]), x2 = bf2f(hr[C_KPE + 16 + lane]); const float2 cs = rope[pos * 16 + lane];
          const float o1 = x1 * cs.x - x2 * cs.y, o2 = x1 * cs.y + x2 * cs.x;
          float* op = smp ? out + O_KPES + ((size_t)(l * 32 + b) * 16 + t) * 32 : out + O_KPEP + ((size_t)(l * 16 + b) * 2048 + t) * 32;
          op[lane] = o1; op[16 + lane] = o2; KPEB[krow * 32 + lane] = (bf16)f2bf(o1); KPEB[krow * 32 + 16 + lane] = (bf16)f2bf(o2); }
        { const int T = smp ? 16 : 2048;
          if (t >= T - 3) { const int j = t - (T - 3);
            float* op = smp ? out + O_GCS + ((size_t)(l * 32 + b) * 3 + j) * 768 : out + O_GCP + ((size_t)(l * 16 + b) * 3 + j) * 768;
#pragma unroll
            for (int i = 0; i < 12; ++i) op[lane + 64 * i] = bf2f(hr[C_QKV + lane + 64 * i]); } }
        if (smp || t >= 2018) {
            float* op = smp ? out + O_CVS + ((size_t)(l * 32 + b) * 30 + 14 + t) * 256 : out + O_CVP + ((size_t)(l * 16 + b) * 30 + (t - 2018)) * 256;
#pragma unroll
            for (int i = 0; i < 4; ++i) { const int ch = lane + 64 * i; op[ch] = bf2f(hr[C_GA + ch]) * sigmoidf_(bf2f(hr[C_GG + ch])); }
            if (smp && t == 0) {
                const float* sc = KIN(6) + ((size_t)(l * 32 + b) * 30 + 16) * 256; float* o2 = out + O_CVS + (size_t)(l * 32 + b) * 30 * 256;
                for (int e = lane; e < 14 * 256; e += 64) o2[e] = sc[e];
            }
        }
    }
}

__device__ __forceinline__ void cache_phase(const PP P, int l) {
    const int tid = P.tid, G = P.G;
    bf16* CKVB = (bf16*)(P.ws + WS_CKVB); bf16* KPEB = (bf16*)(P.ws + WS_KPEB);
    const float* cckv = KIN(2) + (size_t)l * 32 * 2048 * 256; const float* ckpe = KIN(3) + (size_t)l * 32 * 2048 * 32;
    for (int g = P.bid * 512 + tid; g < 65536 * 32; g += G * 512) {
        const int prow = g >> 5, c8 = g & 31, b = prow >> 11, s = prow & 2047;
        const float* sp = cckv + (size_t)prow * 256 + c8 * 8; const f32x4 a = *(const f32x4*)sp, c = *(const f32x4*)(sp + 4);
        u32x4 w; w.x = pk2(a[0], a[1]); w.y = pk2(a[2], a[3]); w.z = pk2(c[0], c[1]); w.w = pk2(c[2], c[3]);
        *(u32x4*)(CKVB + ((size_t)MP + (size_t)b * 2048 + s) * 256 + c8 * 8) = w;
    }
    for (int g = P.bid * 512 + tid; g < 65536 * 4; g += G * 512) {
        const int prow = g >> 2, c8 = g & 3, b = prow >> 11, s = prow & 2047;
        const float* sp = ckpe + (size_t)prow * 32 + c8 * 8; const f32x4 a = *(const f32x4*)sp, c = *(const f32x4*)(sp + 4);
        u32x4 w; w.x = pk2(a[0], a[1]); w.y = pk2(a[2], a[3]); w.z = pk2(c[0], c[1]); w.w = pk2(c[2], c[3]);
        *(u32x4*)(KPEB + ((size_t)MP + (size_t)b * 2048 + s) * 32 + c8 * 8) = w;
    }
}

__device__ __forceinline__ void conv_phase(const PP P, int l, LAS unsigned char* lds) {
    const int tid = P.tid, lane = tid & 63, wave = tid >> 6, G = P.G;
    const bf16* H = (const bf16*)(P.ws + WS_H); bf16* MIX = (bf16*)(P.ws + WS_MIX);
    LAS bf16* cs = (LAS bf16*)lds;
    LAS float* os = (LAS float*)(lds + 48128);
    const float* cw = KIN(17) + (size_t)l * 31 * 256; const float* cb = KIN(18) + l * 256;
    const float* lg = KIN(19) + l * 256; const float* lb = KIN(20) + l * 256; const float* sc = KIN(6);
    for (int u = P.bid; u < 544; u += G) {
        const bool smp = u < 32; int b, t0, ntok; size_t row0;
        if (!smp) { const int v = u - 32; b = v >> 5; t0 = (v & 31) * 64; ntok = 64; row0 = (size_t)b * 2048 + t0; } else { b = u; t0 = 0; ntok = 16; row0 = (size_t)MP + b * 16; }
        { const int ch2 = (tid & 127) * 2, rg = tid >> 7; const int nrow = 30 + ntok;
          const GAS1 bf16* hb = (const GAS1 bf16*)(H + ((long long)row0 - 30 + rg) * HLD + ch2);
          for (int k0 = 0; k0 < 24; k0 += 12) {
          unsigned ra[12], rgt[12];
#pragma unroll
          for (int k = 0; k < 12; ++k) { const int i = rg + 4 * (k0 + k), tt = t0 - 30 + i; ra[k] = 0u; rgt[k] = 0u;
              if (i < nrow && tt >= 0) { ra[k] = *(const GAS1 unsigned*)(hb + C_GA); rgt[k] = *(const GAS1 unsigned*)(hb + C_GG); }
              hb += 4 * HLD; asm volatile("" : "+v"(hb)); }
#pragma unroll
          for (int k = 0; k < 12; ++k) { const int i = rg + 4 * (k0 + k), tt = t0 - 30 + i;
              if (i < nrow) { float v0, v1;
                  if (tt >= 0 || !smp) { v0 = bf2f(ra[k] & 0xffffu) * sigmoidf_(bf2f(rgt[k] & 0xffffu)); v1 = bf2f(ra[k] >> 16) * sigmoidf_(bf2f(rgt[k] >> 16)); }
                  else { const float* sp = sc + ((size_t)(l * 32 + b) * 30 + (30 + tt)) * 256 + ch2; v0 = sp[0]; v1 = sp[1]; }
                  *(LAS unsigned*)(cs + i * 256 + ch2) = pk2(v0, v1); } } } }
        LBAR();
        { const int ch = tid & 255, gsel = tid >> 8; float w[31]; const GAS1 float* cwp = (const GAS1 float*)(cw + ch); asm volatile("" : "+v"(cwp));
#pragma unroll
          for (int j = 0; j < 31; ++j) w[j] = cwp[j * 256];
          const float bias = cb[ch];
          for (int g = gsel; g < (ntok >> 3); g += 2) { float win[38];
#pragma unroll
              for (int i = 0; i < 38; ++i) win[i] = bf2f(cs[(8 * g + i) * 256 + ch]);
#pragma unroll
              for (int t = 0; t < 8; ++t) { float acc = bias;
#pragma unroll
                  for (int j = 0; j < 31; ++j) acc += w[j] * win[t + j];
                  os[(8 * g + t) * 256 + ch] = acc; } } }
        LBAR();
        for (int t = wave; t < ntok; t += 8) {
            float v[4]; float sm = 0.f;
#pragma unroll
            for (int i = 0; i < 4; ++i) { v[i] = os[t * 256 + lane + 64 * i]; sm += v[i]; }
            const float mu = wave_sum(sm) * (1.0f / 256.0f); float q = 0.f;
#pragma unroll
            for (int i = 0; i < 4; ++i) { const float d = v[i] - mu; q += d * d; }
            const float rstd = rsqrtf(wave_sum(q) * (1.0f / 256.0f) + 1e-5f);
#pragma unroll
            for (int i = 0; i < 4; ++i) { const int ch = lane + 64 * i; const float y = (v[i] - mu) * rstd * lg[ch] + lb[ch]; MIX[(row0 + t) * 1024 + 768 + ch] = (bf16)f2bf(siluf_(y)); }
        }
        LBAR();
    }
}

__device__ __forceinline__ void g1_phase(const PP P, int l, LAS unsigned char* lds) {
    const int tid = P.tid, grp = tid >> 8, gt = tid & 255, G = P.G;
    const bf16* H = (const bf16*)(P.ws + WS_H);
    LAS float* qs = (LAS float*)(lds + grp * G1_GRP); LAS float* ks = qs + 64 * 65; LAS float* vs = ks + 64 * 65; LAS float* As = vs + 64 * 65;
    LAS float* Gs = As + 64 * 64; LAS float* bs = Gs + 64; LAS float* gs = bs + 64;
    const float* gcw = KIN(13) + (size_t)l * 4 * 768;
    const int rounds = (NGU + 2 * G - 1) / (2 * G);
    for (int it = 0; it < rounds; ++it) {
        const int u = (it * G + P.bid) * 2 + grp; const bool act = u < NGU;
        int b, h, ch, L; bool smp; size_t seq0;
        if (u < 2048) { const int bh = u >> 5; ch = u & 31; b = bh >> 2; h = bh & 3; L = 64; smp = false; seq0 = (size_t)b * 2048; }
        else { const int bh = u - 2048; b = bh >> 2; h = bh & 3; L = 16; smp = true; ch = 0; seq0 = (size_t)MP + b * 16; }
        unsigned char* ub = P.ws + WS_GSCR + (size_t)(act ? u : 0) * GUNIT;
        bf16* Wd = (bf16*)ub; bf16* QKd = (bf16*)(ub + 8192); bf16* KdT = (bf16*)(ub + 16384); bf16* QG = (bf16*)(ub + 24576); float* Uv = (float*)(ub + 32768);
#ifdef PROBE_SOLVE
        for (int pass_ = 0; pass_ < 2; ++pass_) {
#endif
        if (act) {
            if (gt < 192) { const int part = gt >> 6, cc = gt & 63, qcol = part * 256 + h * 64 + cc;
                const float w0 = gcw[qcol], w1 = gcw[768 + qcol], w2 = gcw[2 * 768 + qcol], w3 = gcw[3 * 768 + qcol];
                LAS float* dst = (part == 0 ? qs : (part == 1 ? ks : vs)) + cc;
                const bf16* hp = H + (seq0 + (size_t)ch * 64) * HLD + C_QKV + qcol;
                float x0 = 0.f, x1 = 0.f, x2 = 0.f;
                if (ch > 0) { x0 = bf2f(*(hp - 3 * HLD)); x1 = bf2f(*(hp - 2 * HLD)); x2 = bf2f(*(hp - HLD)); }
                else if (smp) { const float* sp = KIN(5) + (size_t)(l * 32 + b) * 3 * 768 + qcol; x0 = sp[0]; x1 = sp[768]; x2 = sp[2 * 768]; }
                const GAS1 bf16* pr = (const GAS1 bf16*)hp;
                if (L == 64) {
                  for (int tb = 0; tb < 64; tb += 32) { float xv[32];
#pragma unroll
                    for (int i = 0; i < 32; ++i) { xv[i] = bf2f(*pr); pr += HLD; asm volatile("" : "+v"(pr)); }
#pragma unroll
                    for (int i = 0; i < 32; ++i) { const float y = w0 * x0 + w1 * x1 + w2 * x2 + w3 * xv[i]; dst[(tb + i) * 65] = siluf_(y); x0 = x1; x1 = x2; x2 = xv[i]; } }
                } else { float xv[16];
#pragma unroll
                    for (int i = 0; i < 16; ++i) { xv[i] = bf2f(*pr); pr += HLD; asm volatile("" : "+v"(pr)); }
#pragma unroll
                    for (int i = 0; i < 16; ++i) { const float y = w0 * x0 + w1 * x1 + w2 * x2 + w3 * xv[i]; dst[i * 65] = siluf_(y); x0 = x1; x1 = x2; x2 = xv[i]; } }
                for (int t = L; t < 64; ++t) dst[t * 65] = 0.f;
            }
        }
        LBAR();
        if (act) {
            { const int rowid = gt >> 1, t = rowid & 63, part = rowid >> 6, half = gt & 1; LAS float* base = (part == 0 ? qs : ks) + t * 65 + half * 32; float ss = 0.f;
#pragma unroll
              for (int i = 0; i < 32; ++i) ss += base[i] * base[i];
              ss += dpp_f<0xB1>(ss); const float rinv = rsqrtf(ss + 1e-6f) * (part == 0 ? 0.125f : 1.0f);
#pragma unroll
              for (int i = 0; i < 32; ++i) base[i] *= rinv; }
            if (gt < 64) { const int t = gt; float beta = 0.f, g = 0.f;
                if (t < L) { const bf16* hr = H + (seq0 + (size_t)ch * 64 + t) * HLD; const float braw = bf2f(hr[C_B + h]), araw = bf2f(hr[C_A + h]);
                    beta = sigmoidf_(braw); const float x = araw + KIN(15)[l * 4 + h]; const float sp = x > 20.f ? x : __logf(1.0f + __expf(x)); g = -__expf(KIN(14)[l * 4 + h]) * sp; }
                bs[t] = beta; gs[t] = g; }
        }
        LBAR();
#ifdef PROBE_SOLVE
        if (pass_ == 0) {
#endif
        if (act && gt == 0) { float gg[64];
#pragma unroll
            for (int t = 0; t < 64; ++t) gg[t] = gs[t];
            float run = 0.f;
#pragma unroll
            for (int t = 0; t < 64; ++t) { run += gg[t]; Gs[t] = run; } }
        LBAR();
        if (act) {
            { const int mi = gt >> 6, ln = gt & 63, fr = ln & 15, fq = ln >> 4;
              bf16x8 ak[2], aq[2];
#pragma unroll
              for (int kk = 0; kk < 2; ++kk) { const LAS float* pk = ks + (16 * mi + fr) * 65 + 32 * kk + fq * 8; const LAS float* pq = qs + (16 * mi + fr) * 65 + 32 * kk + fq * 8;
                  u32x4 wk, wq; wk.x = pk2(pk[0], pk[1]); wk.y = pk2(pk[2], pk[3]); wk.z = pk2(pk[4], pk[5]); wk.w = pk2(pk[6], pk[7]);
                  wq.x = pk2(pq[0], pq[1]); wq.y = pk2(pq[2], pq[3]); wq.z = pk2(pq[4], pq[5]); wq.w = pk2(pq[6], pq[7]);
                  ak[kk] = __builtin_bit_cast(bf16x8, wk); aq[kk] = __builtin_bit_cast(bf16x8, wq); }
#pragma unroll
              for (int nj = 0; nj < 4; ++nj) { f32x4 ckk = {0.f, 0.f, 0.f, 0.f}, cqk = {0.f, 0.f, 0.f, 0.f};
                  if (nj <= mi && 16 * mi < L) {
#pragma unroll
                      for (int kk = 0; kk < 2; ++kk) { const LAS float* pb = ks + (16 * nj + fr) * 65 + 32 * kk + fq * 8;
                          u32x4 wb; wb.x = pk2(pb[0], pb[1]); wb.y = pk2(pb[2], pb[3]); wb.z = pk2(pb[4], pb[5]); wb.w = pk2(pb[6], pb[7]);
                          const bf16x8 bfr = __builtin_bit_cast(bf16x8, wb); ckk = mfma16(ak[kk], bfr, ckk); cqk = mfma16(aq[kk], bfr, cqk); } }
                  const int jc = 16 * nj + fr; const float gj = Gs[jc];
#pragma unroll
                  for (int j = 0; j < 4; ++j) { const int i = 16 * mi + fq * 4 + j; const float dec = (i >= jc) ? __expf(Gs[i] - gj) : 0.f;
                      As[i * 64 + jc] = (i > jc) ? bs[i] * ckk[j] * dec : 0.f; QKd[i * 64 + jc] = (bf16)f2bf(cqk[j] * dec); } } }
        }
        LBAR();
        if (act) {
            const float glast = Gs[63];
            for (int e = gt; e < 4096; e += 256) { const int hi = e >> 6, lo = e & 63;
                KdT[e] = (bf16)f2bf(ks[lo * 65 + hi] * __expf(glast - Gs[lo]));
                QG[e] = (bf16)f2bf(qs[hi * 65 + lo] * __expf(Gs[hi])); }
            if (gt == 0) *(float*)(ub + 49152) = __expf(glast);
        }
        LBAR();
#ifdef PROBE_SOLVE
        }
#endif
        if (act) {
            for (int e = gt; e < 8192; e += 256) { const int i = e >> 7, c = e & 127; LAS float* p = ((c < 64) ? ks : vs) + i * 65 + (c & 63);
                *p = *p * bs[i] * ((c < 64) ? __expf(Gs[i]) : 1.0f); }
        }
        LBAR();
#pragma unroll 1
        for (int R = 0; R < 4; ++R) {
            if (act && R > 0 && 16 * R < L) {
                const int wv = gt >> 6, ln = gt & 63, fr = ln & 15, fq = ln >> 4, nkk = (16 * R + 31) >> 5;
                bf16x8 af[2];
#pragma unroll
                for (int kk = 0; kk < 2; ++kk) { u32x4 w = {0u, 0u, 0u, 0u};
                    if (kk < nkk && 32 * kk + fq * 8 < 16 * R) { const LAS float* pa = As + (16 * R + fr) * 64 + 32 * kk + fq * 8; const f32x4 a0 = *(const LAS f32x4*)pa, a1 = *(const LAS f32x4*)(pa + 4);
                        w.x = pk2(a0[0], a0[1]); w.y = pk2(a0[2], a0[3]); w.z = pk2(a1[0], a1[1]); w.w = pk2(a1[2], a1[3]); }
                    af[kk] = __builtin_bit_cast(bf16x8, w); }
#pragma unroll
                for (int t = 0; t < 2; ++t) { const int nt = 2 * wv + t; LAS float* xb = ((nt < 4) ? ks : vs) + 16 * (nt & 3) + fr;
                    f32x4 acc = {0.f, 0.f, 0.f, 0.f};
#pragma unroll
                    for (int kk = 0; kk < 2; ++kk) if (kk < nkk) { const LAS float* pb = xb + (32 * kk + fq * 8) * 65;
                        u32x4 w; w.x = pk2(pb[0], pb[65]); w.y = pk2(pb[130], pb[195]); w.z = pk2(pb[260], pb[325]); w.w = pk2(pb[390], pb[455]);
                        acc = mfma16(af[kk], __builtin_bit_cast(bf16x8, w), acc); }
#pragma unroll
                    for (int j = 0; j < 4; ++j) xb[(16 * R + fq * 4 + j) * 65] -= acc[j]; }
            }
            LBAR();
            if (act && gt < 128) { const int c = gt; LAS float* col = ((c < 64) ? ks : vs) + (c & 63) + (16 * R) * 65; const LAS float* Dg = As + (16 * R) * 64 + 16 * R;
                float x[16];
                if (16 * R >= L) {
#pragma unroll
                    for (int a = 0; a < 16; ++a) x[a] = 0.f;
                } else {
#pragma unroll
                for (int a = 0; a < 16; ++a) { float v = col[a * 65];
                    f32x4 d[4];
#pragma unroll
                    for (int q4 = 0; q4 < 4; ++q4) if (4 * q4 < a) d[q4] = *(const LAS f32x4*)(Dg + a * 64 + 4 * q4);
#pragma unroll
                    for (int q = 0; q < a; ++q) v -= d[q >> 2][q & 3] * x[q];
                    x[a] = v; if ((a & 3) == 3) __builtin_amdgcn_sched_barrier(0); } }
#pragma unroll
                for (int a = 0; a < 16; ++a) { col[a * 65] = x[a];
                    if (c < 64) Wd[(16 * R + a) * 64 + c] = (bf16)f2bf(x[a]); else Uv[(16 * R + a) * 64 + (c - 64)] = x[a]; }
            }
            LBAR();
        }
#ifdef PROBE_SOLVE
        }
#endif
    }
}

__device__ __forceinline__ bf16x8 ldA2(const bf16* Mx, int row, int kk, int fq) {
    const bf16* p = Mx + row * 64 + 32 * kk + fq * 4; const s16x4 a = *(const s16x4*)p, b = *(const s16x4*)(p + 16);
    bf16x8 r; r[0] = a[0]; r[1] = a[1]; r[2] = a[2]; r[3] = a[3]; r[4] = b[0]; r[5] = b[1]; r[6] = b[2]; r[7] = b[3]; return r;
}
__device__ __forceinline__ void split8(const f32x4& lo4, const f32x4& hi4, bf16x8& h, bf16x8& lw) {
    u32x4 hw; hw.x = pk2(lo4[0], lo4[1]); hw.y = pk2(lo4[2], lo4[3]); hw.z = pk2(hi4[0], hi4[1]); hw.w = pk2(hi4[2], hi4[3]);
    h = __builtin_bit_cast(bf16x8, hw);
    if (GDN_SPLIT) {
        u32x4 lo; lo.x = pk2(lo4[0] - bf2f(hw.x & 0xffffu), lo4[1] - __builtin_bit_cast(float, hw.x & 0xffff0000u)); lo.y = pk2(lo4[2] - bf2f(hw.y & 0xffffu), lo4[3] - __builtin_bit_cast(float, hw.y & 0xffff0000u));
        lo.z = pk2(hi4[0] - bf2f(hw.z & 0xffffu), hi4[1] - __builtin_bit_cast(float, hw.z & 0xffff0000u)); lo.w = pk2(hi4[2] - bf2f(hw.w & 0xffffu), hi4[3] - __builtin_bit_cast(float, hw.w & 0xffff0000u));
        lw = __builtin_bit_cast(bf16x8, lo);
    } else lw = h;
}
constexpr int G2_MAT = 9216, G2_UV = 4 * G2_MAT, G2_Z = G2_UV + 64 * 272, G2_GAM = G2_Z + 9216, G2_BUF = G2_GAM + 16, G2_RED = 2 * G2_BUF;
static_assert(G2_RED + 2048 <= LDS_BYTES, "g2 lds");
__device__ __forceinline__ bf16x8 ldA2s(const LAS unsigned char* mat, int row, int kk, int fq) {
    const LAS unsigned char* p = mat + row * 144 + 64 * kk + fq * 8; const s16x4 a = *(const LAS s16x4*)p, b = *(const LAS s16x4*)(p + 32);
    bf16x8 r; r[0] = a[0]; r[1] = a[1]; r[2] = a[2]; r[3] = a[3]; r[4] = b[0]; r[5] = b[1]; r[6] = b[2]; r[7] = b[3]; return r;
}
__device__ __forceinline__ void g2_stage(LAS unsigned char* buf, const unsigned char* ub, const bf16* zsrc  , int ht, int nthr) {
    for (int c = ht; c < 2048; c += nthr) { const int mat = c >> 9, w = c & 511, row = w >> 3, seg = w & 7;
        *(LAS u32x4*)(buf + mat * G2_MAT + row * 144 + seg * 16) = *(const u32x4*)(ub + mat * 8192 + row * 128 + seg * 16); }
    for (int c = ht; c < 1024; c += nthr) { const int row = c >> 4, seg = c & 15;
        *(LAS u32x4*)(buf + G2_UV + row * 272 + seg * 16) = *(const u32x4*)(ub + 32768 + row * 256 + seg * 16); }
    for (int c = ht; c < 512; c += nthr) { const int row = c >> 3, seg = c & 7;
        *(LAS u32x4*)(buf + G2_Z + row * 144 + seg * 16) = *(const u32x4*)((const unsigned char*)(zsrc + (size_t)row * HLD) + seg * 16); }
    if (ht == 0) *(LAS float*)(buf + G2_GAM) = *(const float*)(ub + 49152);
}
__device__ __forceinline__ void g2_load(u32x4 (&r)[14], float& gam, const unsigned char* ub, const bf16* zsrc, int ht) {
    const unsigned go = 16u * ht, gz = (ht >> 3) * (HLD * 2) + (ht & 7) * 16;
#pragma unroll
    for (int i = 0; i < 8; ++i) r[i] = *(const u32x4*)(ub + i * 4096 + go);
#pragma unroll
    for (int i = 0; i < 4; ++i) r[8 + i] = *(const u32x4*)(ub + 32768 + i * 4096 + go);
#pragma unroll
    for (int i = 0; i < 2; ++i) r[12 + i] = *(const u32x4*)((const unsigned char*)zsrc + (size_t)i * 32 * HLD * 2 + gz);
    gam = *(const float*)(ub + 49152);
}
__device__ __forceinline__ void g2_store(LAS unsigned char* buf, const u32x4 (&r)[14], float gam, int ht) {
    LAS unsigned char* lm = buf + (ht >> 3) * 144 + (ht & 7) * 16; LAS unsigned char* lu = buf + G2_UV + (ht >> 4) * 272 + (ht & 15) * 16;
#pragma unroll
    for (int i = 0; i < 8; ++i) *(LAS u32x4*)(lm + (i >> 1) * G2_MAT + (i & 1) * 32 * 144) = r[i];
#pragma unroll
    for (int i = 0; i < 4; ++i) *(LAS u32x4*)(lu + i * 16 * 272) = r[8 + i];
#pragma unroll
    for (int i = 0; i < 2; ++i) *(LAS u32x4*)(lm + G2_Z + i * 32 * 144) = r[12 + i];
    if (ht == 0) *(LAS float*)(buf + G2_GAM) = gam;
}
#define G2_BAR() asm volatile("s_waitcnt lgkmcnt(0)\n\ts_barrier" ::: "memory")
__device__ __forceinline__ void g2_phase(const PP P, int l, LAS unsigned char* lds) {
    const int tid = P.tid, lane = tid & 63, wave = tid >> 6, fr = lane & 15, fq = lane >> 4, G = P.G;
    LAS float* red = (LAS float*)(lds + G2_RED);
    const bf16* H = (const bf16*)(P.ws + WS_H); bf16* MIX = (bf16*)(P.ws + WS_MIX);
    for (int u = P.bid; u < 192; u += G) {
        const bool smp = u >= 64; const int bh = smp ? u - 64 : u, b = bh >> 2, h = bh & 3, nch = smp ? 1 : 32, L = smp ? 16 : 64;
        const size_t seq0 = smp ? (size_t)MP + b * 16 : (size_t)b * 2048; const int gu0 = smp ? 2048 + bh : bh * 32;
        const bool act = wave < 4; const int dv = 16 * (wave & 3) + fr;
        const unsigned char* gs0 = P.ws + WS_GSCR + (size_t)gu0 * GUNIT; const bf16* z0 = H + seq0 * HLD + C_Z + h * 64;
        f32x4 S[4];
#pragma unroll
        for (int m = 0; m < 4; ++m)
#pragma unroll
            for (int j = 0; j < 4; ++j) S[m][j] = (smp && act) ? KIN(4)[(((size_t)(l * 32 + b) * 4 + h) * 64 + (16 * m + fq * 4 + j)) * 64 + dv] : 0.f;
        const float gnw = KIN(16)[l * 64 + dv];
        g2_stage(lds, gs0, z0, tid, 512);
        u32x4 hr_[14]; float hgam = 0.f;
#pragma unroll
        for (int i = 0; i < 14; ++i) hr_[i] = (u32x4){0u, 0u, 0u, 0u};
        if (!act && nch > 1) g2_load(hr_, hgam, gs0 + GUNIT, z0 + (size_t)64 * HLD, tid - 256);
        G2_BAR();
        for (int n = 0; n < nch; ++n) {
            LAS unsigned char* buf = lds + (n & 1) * G2_BUF;
            f32x4 O[4]; float zr[4][4];
            if (!act) {
                if (n + 1 < nch) g2_store(lds + ((n + 1) & 1) * G2_BUF, hr_, hgam, tid - 256);
                if (n + 2 < nch) g2_load(hr_, hgam, gs0 + (size_t)(n + 2) * GUNIT, z0 + (size_t)(n + 2) * 64 * HLD, tid - 256);
            } else {
                bf16x8 Sh[2], Sl[2]; split8(S[0], S[1], Sh[0], Sl[0]); split8(S[2], S[3], Sh[1], Sl[1]);
                f32x4 U[4];
#pragma unroll
                for (int mi = 0; mi < 4; ++mi) { f32x4 acc = {0.f, 0.f, 0.f, 0.f};
#pragma unroll
                    for (int kk = 0; kk < 2; ++kk) { const bf16x8 a = ldA2s(buf, 16 * mi + fr, kk, fq); acc = mfma16(a, Sh[kk], acc); if (GDN_SPLIT) acc = mfma16(a, Sl[kk], acc); }
#pragma unroll
                    for (int j = 0; j < 4; ++j) { const int i = 16 * mi + fq * 4 + j; U[mi][j] = *(const LAS float*)(buf + G2_UV + i * 272 + dv * 4) - acc[j];
                        zr[mi][j] = bf2f(*(const LAS bf16*)(buf + G2_Z + i * 144 + dv * 2)); } }
                bf16x8 Uh[2], Ul[2]; split8(U[0], U[1], Uh[0], Ul[0]); split8(U[2], U[3], Uh[1], Ul[1]);
#pragma unroll
                for (int mi = 0; mi < 4; ++mi) { f32x4 acc = {0.f, 0.f, 0.f, 0.f};
#pragma unroll
                    for (int kk = 0; kk < 2; ++kk) { const bf16x8 a = ldA2s(buf + 3 * G2_MAT, 16 * mi + fr, kk, fq); acc = mfma16(a, Sh[kk], acc); if (GDN_SPLIT) acc = mfma16(a, Sl[kk], acc);
                        const bf16x8 a2 = ldA2s(buf + G2_MAT, 16 * mi + fr, kk, fq); acc = mfma16(a2, Uh[kk], acc); if (GDN_SPLIT) acc = mfma16(a2, Ul[kk], acc); }
                    O[mi] = acc; }
                const float gamL = *(const LAS float*)(buf + G2_GAM);
#pragma unroll
                for (int m = 0; m < 4; ++m) { f32x4 acc = S[m] * gamL;
#pragma unroll
                    for (int kk = 0; kk < 2; ++kk) { const bf16x8 a = ldA2s(buf + 2 * G2_MAT, 16 * m + fr, kk, fq); acc = mfma16(a, Uh[kk], acc); if (GDN_SPLIT) acc = mfma16(a, Ul[kk], acc); }
                    S[m] = acc; }
#pragma unroll
                for (int mi = 0; mi < 4; ++mi)
#pragma unroll
                    for (int j = 0; j < 4; ++j) { const float s = row16_sum(O[mi][j] * O[mi][j]);
                        if (fr == 0) red[(n & 1) * 256 + wave * 64 + 16 * mi + fq * 4 + j] = s; }
            }
            G2_BAR();
            if (act) {
#pragma unroll
                for (int mi = 0; mi < 4; ++mi)
#pragma unroll
                    for (int j = 0; j < 4; ++j) { const int i = 16 * mi + fq * 4 + j; LAS float* rp = red + (n & 1) * 256 + i;
                        const float tot = rp[0] + rp[64] + rp[128] + rp[192]; const float rinv = rsqrtf(tot * (1.0f / 64.0f) + 1e-6f);
                        if (i < L) { const size_t row = seq0 + (size_t)n * 64 + i;
                            MIX[row * 1024 + 512 + h * 64 + dv] = (bf16)f2bf(O[mi][j] * rinv * gnw * siluf_(zr[mi][j])); } }
            }
        }
        if (act) { float* so = smp ? P.out + O_GDNS + ((size_t)(l * 32 + b) * 4 + h) * 4096 : P.out + O_GDNP + ((size_t)(l * 16 + b) * 4 + h) * 4096;
#pragma unroll
            for (int m = 0; m < 4; ++m)
#pragma unroll
                for (int j = 0; j < 4; ++j) so[(16 * m + fq * 4 + j) * 64 + dv] = S[m][j]; }
        __syncthreads();
    }
}

constexpr int AT_KROW = 208, AT_VROW = 144, AT_V = 64 * AT_KROW, AT_STAGE = AT_V + 64 * AT_VROW, AT_COMB = 2 * AT_STAGE;
static_assert(AT_COMB + 8 * 64 * 18 * 4 <= LDS_BYTES, "attn lds");
__device__ __forceinline__ void attn_prompt_unit(const PP P, LAS unsigned char* lds, int b, int h, int qt) {
    const int tid = P.tid, lane = tid & 63, wave = tid >> 6, fr = lane & 15, fq = lane >> 4;
    const bf16* Q = (const bf16*)(P.ws + WS_XB); const bf16* KN = (const bf16*)(P.ws + WS_KN); const bf16* VT = (const bf16*)(P.ws + WS_VT);
    const bf16* KPEB = (const bf16*)(P.ws + WS_KPEB); bf16* MIX = (bf16*)(P.ws + WS_MIX);
    const int qrow0 = b * 2048 + 256 * qt + 32 * wave, keybase = b * 2048;
    const int nt_blk = 4 * qt + 4, nt_w = 4 * qt + (wave >> 1) + 1;
    bf16x8 Qb[2][3];
#pragma unroll
    for (int g = 0; g < 2; ++g)
#pragma unroll
        for (int ks = 0; ks < 3; ++ks) Qb[g][ks] = *(const bf16x8*)(Q + (size_t)(qrow0 + 16 * g + fr) * 768 + h * 96 + 32 * ks + fq * 8);
    float m[2] = {-INFINITY, -INFINITY}, lsum[2] = {0.f, 0.f}; f32x4 O[2][4];
#pragma unroll
    for (int g = 0; g < 2; ++g)
#pragma unroll
        for (int nt = 0; nt < 4; ++nt) O[g][nt] = (f32x4){0.f, 0.f, 0.f, 0.f};
    const int r8 = tid >> 3, s8 = tid & 7, r4 = (tid & 255) >> 2, s4 = tid & 3;
    const bf16* gk = KN + (size_t)(keybase + r8) * 512 + h * 64 + s8 * 8;
    const bf16* gp = KPEB + (size_t)(keybase + r4) * 32 + s4 * 8;
    const bf16* gv = VT + (size_t)(h * 64 + r8) * NK + keybase + s8 * 8;
    const int lk = r8 * AT_KROW + s8 * 16, lp = r4 * AT_KROW + 128 + s4 * 16, lv = AT_V + r8 * AT_VROW + s8 * 16;
    u32x4 rk = *(const u32x4*)gk, rv = *(const u32x4*)gv, rp = {0u, 0u, 0u, 0u}; if (tid < 256) rp = *(const u32x4*)gp;
    *(LAS u32x4*)(lds + lk) = rk; *(LAS u32x4*)(lds + lv) = rv; if (tid < 256) *(LAS u32x4*)(lds + lp) = rp;
    __syncthreads();
    for (int kt = 0; kt < nt_blk; ++kt) {
        const bool more = kt + 1 < nt_blk;
        if (more) { rk = *(const u32x4*)(gk + (size_t)(kt + 1) * 64 * 512); rv = *(const u32x4*)(gv + (kt + 1) * 64); if (tid < 256) rp = *(const u32x4*)(gp + (size_t)(kt + 1) * 64 * 32); }
        if (kt < nt_w) {
            const LAS unsigned char* kb = lds + (kt & 1) * AT_STAGE; const LAS unsigned char* vb = kb + AT_V;
            f32x4 s[2][4];
#pragma unroll
            for (int sb = 0; sb < 4; ++sb) { s[0][sb] = (f32x4){0.f, 0.f, 0.f, 0.f}; s[1][sb] = (f32x4){0.f, 0.f, 0.f, 0.f};
#pragma unroll
                for (int ks = 0; ks < 3; ++ks) { const bf16x8 kf = *(const LAS bf16x8*)(kb + (16 * sb + fr) * AT_KROW + ks * 64 + fq * 16);
                    s[0][sb] = mfma16(kf, Qb[0][ks], s[0][sb]); s[1][sb] = mfma16(kf, Qb[1][ks], s[1][sb]); } }
            bf16x8 Pb[2][2];
#pragma unroll
            for (int g = 0; g < 2; ++g) {
                float mx = -INFINITY;
#pragma unroll
                for (int sb = 0; sb < 4; ++sb) mx = fmaxf(mx, fmaxf(fmaxf(s[g][sb][0], s[g][sb][1]), fmaxf(s[g][sb][2], s[g][sb][3])));
                mx = fmaxf(mx, xor16_get(mx)); mx = xor32_max(mx);
                const float mnew = fmaxf(m[g], mx), alpha = __builtin_amdgcn_exp2f(m[g] - mnew); m[g] = mnew;
                float ps = 0.f; float p[4][4];
#pragma unroll
                for (int sb = 0; sb < 4; ++sb)
#pragma unroll
                    for (int j = 0; j < 4; ++j) { p[sb][j] = __builtin_amdgcn_exp2f(s[g][sb][j] - mnew); ps += p[sb][j]; }
                lsum[g] = lsum[g] * alpha + ps;
#pragma unroll
                for (int kk = 0; kk < 2; ++kk) { u32x4 pw; pw.x = pk2(p[2 * kk][0], p[2 * kk][1]); pw.y = pk2(p[2 * kk][2], p[2 * kk][3]); pw.z = pk2(p[2 * kk + 1][0], p[2 * kk + 1][1]); pw.w = pk2(p[2 * kk + 1][2], p[2 * kk + 1][3]);
                    Pb[g][kk] = __builtin_bit_cast(bf16x8, pw); }
#pragma unroll
                for (int nt = 0; nt < 4; ++nt) O[g][nt] = O[g][nt] * alpha;
            }
#pragma unroll
            for (int nt = 0; nt < 4; ++nt)
#pragma unroll
                for (int kk = 0; kk < 2; ++kk) { const LAS unsigned char* vp = vb + (16 * nt + fr) * AT_VROW + kk * 64 + fq * 8;
                    const s16x4 a = *(const LAS s16x4*)vp, c = *(const LAS s16x4*)(vp + 32);
                    bf16x8 vf; vf[0] = a[0]; vf[1] = a[1]; vf[2] = a[2]; vf[3] = a[3]; vf[4] = c[0]; vf[5] = c[1]; vf[6] = c[2]; vf[7] = c[3];
                    O[0][nt] = mfma16(vf, Pb[0][kk], O[0][nt]); O[1][nt] = mfma16(vf, Pb[1][kk], O[1][nt]); }
        }
        if (more) { LAS unsigned char* nb = lds + ((kt + 1) & 1) * AT_STAGE; *(LAS u32x4*)(nb + lk) = rk; *(LAS u32x4*)(nb + lv) = rv; if (tid < 256) *(LAS u32x4*)(nb + lp) = rp; }
        __syncthreads();
    }
#pragma unroll
    for (int g = 0; g < 2; ++g) { float lt = lsum[g]; lt += xor16_get(lt); lt = xor32_sum(lt); const float inv = 1.0f / lt;
#pragma unroll
        for (int nt = 0; nt < 4; ++nt) { u32x2 w; w.x = pk2(O[g][nt][0] * inv, O[g][nt][1] * inv); w.y = pk2(O[g][nt][2] * inv, O[g][nt][3] * inv);
            *(u32x2*)(MIX + (size_t)(qrow0 + 16 * g + fr) * 1024 + h * 64 + 16 * nt + fq * 4) = w; } }
}
__device__ __forceinline__ void attn_sample_unit(const PP P, LAS unsigned char* lds, int b, int h) {
    const int tid = P.tid, lane = tid & 63, wave = tid >> 6, fr = lane & 15, fq = lane >> 4;
    const bf16* Q = (const bf16*)(P.ws + WS_XB); const bf16* KN = (const bf16*)(P.ws + WS_KN); const bf16* VT = (const bf16*)(P.ws + WS_VT);
    const bf16* KPEB = (const bf16*)(P.ws + WS_KPEB); bf16* MIX = (bf16*)(P.ws + WS_MIX);
    const int qrow0 = MP + b * 16, keybase = MP, nkeys = SKS;
    const bf16* qp = Q + (size_t)(qrow0 + fr) * 768 + h * 96 + fq * 8;
    bf16x8 Qb[3];
#pragma unroll
    for (int ks = 0; ks < 3; ++ks) Qb[ks] = *(const bf16x8*)(qp + 32 * ks);
    float m = -INFINITY, lsum = 0.f; f32x4 O[4];
#pragma unroll
    for (int nt = 0; nt < 4; ++nt) O[nt] = (f32x4){0.f, 0.f, 0.f, 0.f};
    const int nblk = (nkeys + 31) >> 5, kb0 = (wave * nblk) >> 3, kb1 = ((wave + 1) * nblk) >> 3;
    for (int kb = kb0; kb < kb1; ++kb) {
        f32x4 s[2]; int kof[2];
#pragma unroll
        for (int sub = 0; sub < 2; ++sub) { const int key0 = kb * 32 + sub * 16; const bool valid = key0 < nkeys; kof[sub] = (valid && key0 >= 2048) ? 65536 + b * 16 + (key0 - 2048) : b * 2048 + (valid ? key0 : 0);
            const size_t kr = (size_t)keybase + kof[sub] + fr;
            const bf16x8 a0 = *(const bf16x8*)(KN + kr * 512 + h * 64 + fq * 8), a1 = *(const bf16x8*)(KN + kr * 512 + h * 64 + 32 + fq * 8), a2 = *(const bf16x8*)(KPEB + kr * 32 + fq * 8);
            f32x4 acc = {0.f, 0.f, 0.f, 0.f}; acc = mfma16(a0, Qb[0], acc); acc = mfma16(a1, Qb[1], acc); acc = mfma16(a2, Qb[2], acc);
            if (!valid) acc = (f32x4){-INFINITY, -INFINITY, -INFINITY, -INFINITY};
            s[sub] = acc; }
        float mx = fmaxf(fmaxf(fmaxf(s[0][0], s[0][1]), fmaxf(s[0][2], s[0][3])), fmaxf(fmaxf(s[1][0], s[1][1]), fmaxf(s[1][2], s[1][3])));
        mx = fmaxf(mx, xor16_get(mx)); mx = xor32_max(mx);
        const float mnew = fmaxf(m, mx); const float alpha = __builtin_amdgcn_exp2f(m - mnew); m = mnew;
        float p[8]; float ps = 0.f;
#pragma unroll
        for (int j = 0; j < 4; ++j) { p[j] = __builtin_amdgcn_exp2f(s[0][j] - mnew); p[4 + j] = __builtin_amdgcn_exp2f(s[1][j] - mnew); ps += p[j] + p[4 + j]; }
        lsum = lsum * alpha + ps;
        u32x4 pw; pw.x = pk2(p[0], p[1]); pw.y = pk2(p[2], p[3]); pw.z = pk2(p[4], p[5]); pw.w = pk2(p[6], p[7]);
        const bf16x8 Pb = __builtin_bit_cast(bf16x8, pw);
#pragma unroll
        for (int nt = 0; nt < 4; ++nt) { const bf16* vrow = VT + (size_t)(h * 64 + 16 * nt + fr) * NK + keybase + fq * 4;
            const s16x4 a = *(const s16x4*)(vrow + kof[0]), c = *(const s16x4*)(vrow + kof[1]);
            bf16x8 va; va[0] = a[0]; va[1] = a[1]; va[2] = a[2]; va[3] = a[3]; va[4] = c[0]; va[5] = c[1]; va[6] = c[2]; va[7] = c[3];
            O[nt] = mfma16(va, Pb, O[nt] * alpha); }
    }
    float lt = lsum; lt += xor16_get(lt); lt = xor32_sum(lt);
    LAS float* cb = (LAS float*)(lds + AT_COMB) + (wave * 64 + lane) * 18;
#pragma unroll
    for (int nt = 0; nt < 4; ++nt)
#pragma unroll
        for (int j = 0; j < 4; ++j) cb[nt * 4 + j] = O[nt][j];
    cb[16] = m; cb[17] = lt;
    __syncthreads();
    if (wave == 0) {
        float mm = -INFINITY;
#pragma unroll
        for (int w = 0; w < 8; ++w) mm = fmaxf(mm, ((LAS float*)(lds + AT_COMB))[(w * 64 + lane) * 18 + 16]);
        float L = 0.f; float acc[16];
#pragma unroll
        for (int i = 0; i < 16; ++i) acc[i] = 0.f;
#pragma unroll
        for (int w = 0; w < 8; ++w) { const LAS float* pp = (LAS float*)(lds + AT_COMB) + (w * 64 + lane) * 18; const float sc = __builtin_amdgcn_exp2f(pp[16] - mm); L += pp[17] * sc;
#pragma unroll
            for (int i = 0; i < 16; ++i) acc[i] += pp[i] * sc; }
        const float inv = 1.0f / L;
#pragma unroll
        for (int nt = 0; nt < 4; ++nt) { u32x2 w; w.x = pk2(acc[nt * 4] * inv, acc[nt * 4 + 1] * inv); w.y = pk2(acc[nt * 4 + 2] * inv, acc[nt * 4 + 3] * inv);
            *(u32x2*)(MIX + (size_t)(qrow0 + fr) * 1024 + h * 64 + 16 * nt + fq * 4) = w; }
    }
    __syncthreads();
}
__device__ __forceinline__ void attn_phase(const PP P, LAS unsigned char* lds) {
    const int G = P.G;
    for (int u = P.bid; u < 256 + 1024; u += G) {
        if (u < 256) { attn_sample_unit(P, lds, u >> 3, u & 7); }
        else { const int v = u - 256, bh = v & 127, half = (v >> 7) & 1, k = v >> 8;
            const int qt = (k == 0) ? 7 - half : (k == 1) ? half : (k == 2) ? 5 - half : 2 + half;
            attn_prompt_unit(P, lds, bh >> 3, bh & 7, qt); }
    }
}

__device__ __forceinline__ void ln_phase(const PP P, const float* g, const float* bta) {
    const int tid = P.tid, lane = tid & 63, wave = tid >> 6, G = P.G;
    float* X = P.out; bf16* XB = (bf16*)(P.ws + WS_XB);
    for (int row = P.bid * 8 + wave; row < MT; row += G * 8) {
        float* p = X + (size_t)row * 1024; f32x4 v[4]; float s = 0.f;
#pragma unroll
        for (int i = 0; i < 4; ++i) { v[i] = *(const f32x4*)(p + 256 * i + lane * 4); s += (v[i][0] + v[i][1]) + (v[i][2] + v[i][3]); }
        const float mu = wave_sum(s) * (1.0f / 1024.0f); float q = 0.f;
#pragma unroll
        for (int i = 0; i < 4; ++i) { const f32x4 d = v[i] - mu; q += (d[0] * d[0] + d[1] * d[1]) + (d[2] * d[2] + d[3] * d[3]); }
        const float rstd = rsqrtf(wave_sum(q) * (1.0f / 1024.0f) + 1e-5f);
#pragma unroll
        for (int i = 0; i < 4; ++i) { const int col = 256 * i + lane * 4; const f32x4 gg = *(const f32x4*)(g + col), bb = *(const f32x4*)(bta + col);
            const f32x4 y = (v[i] - mu) * rstd * gg + bb; *(f32x4*)(p + col) = y;
            u32x2 w; w.x = pk2(y[0], y[1]); w.y = pk2(y[2], y[3]); *(u32x2*)(XB + (size_t)row * 1024 + col) = w; }
    }
}

__device__ __forceinline__ void sample_gemm_res(const PP P, LAS unsigned char* lds, const bf16* A  , const bf16* Bt, int K, const float* xin  , float* Xs  ) {
    const int tid = P.tid, lane = tid & 63, wave = tid >> 6, fr = lane & 15, fq = lane >> 4;
    LAS float* part = (LAS float*)lds;
    for (int t = P.bid; t < 256; t += P.G) {
        const int r0 = (t >> 4) * 32, c0 = (t & 15) * 64, kw = K >> 3, kb = wave * kw;
        f32x4 acc[2][4];
#pragma unroll
        for (int a = 0; a < 2; ++a)
#pragma unroll
            for (int n = 0; n < 4; ++n) acc[a][n] = (f32x4){0.f, 0.f, 0.f, 0.f};
        const bf16* ap = A + (size_t)(r0 + fr) * K + kb + fq * 8; const bf16* bp = Bt + (size_t)(c0 + fr) * K + kb + fq * 8;
#pragma unroll 2
        for (int k0 = 0; k0 < kw; k0 += 32) {
            bf16x8 af[2], bf_[4];
#pragma unroll
            for (int a = 0; a < 2; ++a) af[a] = *(const bf16x8*)(ap + (size_t)(16 * a) * K + k0);
#pragma unroll
            for (int n = 0; n < 4; ++n) bf_[n] = *(const bf16x8*)(bp + (size_t)(16 * n) * K + k0);
#pragma unroll
            for (int a = 0; a < 2; ++a)
#pragma unroll
                for (int n = 0; n < 4; ++n) acc[a][n] = mfma16(af[a], bf_[n], acc[a][n]);
        }
        LAS float* mp = part + (wave * 64 + lane) * 33;
#pragma unroll
        for (int a = 0; a < 2; ++a)
#pragma unroll
            for (int n = 0; n < 4; ++n)
#pragma unroll
                for (int j = 0; j < 4; ++j) mp[(a * 4 + n) * 4 + j] = acc[a][n][j];
        __syncthreads();
        { const int grp = wave;
          float sum[4] = {0.f, 0.f, 0.f, 0.f};
#pragma unroll
          for (int w = 0; w < 8; ++w)
#pragma unroll
              for (int j = 0; j < 4; ++j) sum[j] += part[(w * 64 + lane) * 33 + 4 * grp + j];
          const int a = grp >> 2, n = grp & 3, col = c0 + 16 * n + fr;
#pragma unroll
          for (int j = 0; j < 4; ++j) { const int row = r0 + 16 * a + fq * 4 + j; Xs[(size_t)row * 1024 + col] = DN_ALPHA * xin[(size_t)row * 1024 + col] + sum[j]; } }
        __syncthreads();
    }
}

#define GB_LD(p) __hip_atomic_load((p), __ATOMIC_RELAXED, __HIP_MEMORY_SCOPE_AGENT)
#define GB_ADD(p) __hip_atomic_fetch_add((p), 1u, __ATOMIC_RELAXED, __HIP_MEMORY_SCOPE_AGENT)
#define GB_ST(p, v) __hip_atomic_store((p), (v), __ATOMIC_RELAXED, __HIP_MEMORY_SCOPE_AGENT)
__device__ __forceinline__ void fast_grid_bar(unsigned* bar, unsigned k  , int tid, int bid, int G) {
    asm volatile("s_waitcnt vmcnt(0)" ::: "memory");
    __syncthreads();
    if (tid == 0) {
        const unsigned ng = (G < 8) ? (unsigned)G : 8u, g = (unsigned)bid % ng, gsize = ((unsigned)G - g + ng - 1u) / ng;
        unsigned* sub = bar + 64 * g; unsigned* gen = bar + 64 * (8 + g); unsigned* top = bar + 64 * 16; unsigned* topgen = bar + 64 * 17;
        __builtin_amdgcn_fence(__ATOMIC_RELEASE, "agent");
        asm volatile("s_waitcnt vmcnt(0)" ::: "memory");
        const unsigned old = GB_ADD(sub); unsigned sp = 0;
        if (old + 1u == k * gsize) { const unsigned o2 = GB_ADD(top); if (o2 + 1u == k * ng) GB_ST(topgen, k); }
        while (GB_LD(topgen) < k) { __builtin_amdgcn_s_sleep(1); if (++sp > (1u << 24)) break; }
        __builtin_amdgcn_fence(__ATOMIC_ACQUIRE, "agent");
        asm volatile("s_waitcnt vmcnt(0)" ::: "memory");
    }
    __syncthreads();
}

__global__ void __launch_bounds__(512) mega(Params P) {
    extern __shared__ __attribute__((aligned(16))) unsigned char lds_raw[];
    LAS unsigned char* lds = (LAS unsigned char*)lds_raw;
    cg::grid_group grid = cg::this_grid();
    const int lo_ = P.lo, hi_ = P.hi; const int wave_s = __builtin_amdgcn_readfirstlane((int)(threadIdx.x >> 6));
    for (int step = lo_; step < hi_; ++step) {
        PP pp; pp.ws = KWS(); pp.out = KOUT(); unsigned char* ws = pp.ws;
        { int t_, b_ = blockIdx.x, g_ = gridDim.x; asm volatile("v_mbcnt_lo_u32_b32 %0, -1, 0\n\tv_mbcnt_hi_u32_b32 %0, -1, %0\n\tv_lshl_add_u32 %0, %3, 6, %0" : "=&v"(t_), "+s"(b_), "+s"(g_) : "s"(wave_s)); pp.tid = t_; pp.bid = b_; pp.G = g_; }
        int l = 0, kind = 0;
        if (REPK == 0) { if (step > 0) { l = (step - 1) / 10; kind = 1 + (step - 1) % 10; } }
        else if (step > 0) { l = (step - 1) / 11; const int kidx = (step - 1) % 11; kind = (kidx < REPK) ? kidx + 1 : kidx; if (kind == 6 && l == 1 && kidx == REPK) kind = 11; }
        const bf16* WB = (const bf16*)(ws + WS_W) + (size_t)l * W_LAYER;
        int nj = 0;
        PP pp2 = pp; const bool split = pp.G > 64; if (split) { pp2.bid = pp.bid - 64; pp2.G = pp.G - 64; }
        const bool shadow = !split || pp.bid >= 64;
        switch (kind) {
            case 0: prep_phase(pp, lds, 0, true); break;
            case 2: tok_phase(pp, l); g1_phase(pp, l, lds); break;
            case 3: g2_phase(pp, l, lds);
                     if (shadow) { conv_phase(pp2, l, lds); cache_phase(pp2, l); if (l == 0) prep_phase(pp2, lds, 1, false); nj = 1; }
                     break;
            case 5: attn_phase(pp, lds); break;
            case 7: ln_phase(pp, KIN(22) + l * 1024, KIN(23) + l * 1024); break;
            case 10: ln_phase(pp, KIN(27) + l * 1024, KIN(28) + l * 1024); break;
            case 4: nj = 3; break;
            case 11: break;
            default: nj = 1; break;
        }
        if (kind == 6 || kind == 9) {
            const float* xs_ = (kind == 6 && l == 0) ? KIN(1) : pp.out + (size_t)MP * 1024;
            if (kind == 6) sample_gemm_res(pp, lds, (const bf16*)(ws + WS_MIX) + (size_t)MP * 1024, WB + W_OUT, 1024, xs_, pp.out + (size_t)MP * 1024);
            else           sample_gemm_res(pp, lds, (const bf16*)(ws + WS_F) + (size_t)MP * DFF, WB + W_DN, DFF, xs_, pp.out + (size_t)MP * 1024);
        }
        for (int j = 0; j < nj; ++j) {
            pg8::Gemm g; bool perm; int mode; bf16* O = nullptr; size_t ldc = 0;
            if (kind == 1)      { g = pg8::Gemm{(const bf16*)(ws + WS_XB), WB + W_IN, MT, HLD, 1024}; perm = true; mode = 0; O = (bf16*)(ws + WS_H); ldc = HLD; }
            else if (kind == 3) { g = pg8::Gemm{(const bf16*)(ws + WS_CQN), WB + W_UQ, MT, 768, 384}; perm = false; mode = 2; O = (bf16*)(ws + WS_XB); ldc = 768; }
            else if (kind == 4 && j == 2 && pp.bid < 4) { g = pg8::Gemm{(const bf16*)(ws + WS_CKVB) + (size_t)NKM * 256, WB + W_UK, 512, 512, 256}; perm = true; mode = 0; O = (bf16*)(ws + WS_KN) + (size_t)NKM * 512; ldc = 512; }
            else if (kind == 4 && j == 2) { g = pg8::Gemm{WB + W_UVT, (const bf16*)(ws + WS_CKVB) + (size_t)NKM * 256, 512, 512, 256}; perm = true; mode = 0; O = (bf16*)(ws + WS_VT) + NKM; ldc = NK; }
            else if (kind == 4 && j == 0) { g = pg8::Gemm{(const bf16*)(ws + WS_CKVB), WB + W_UK, NKM, 512, 256}; perm = true; mode = 0; O = (bf16*)(ws + WS_KN); ldc = 512; }
            else if (kind == 4)           { g = pg8::Gemm{WB + W_UVT, (const bf16*)(ws + WS_CKVB), 512, NKM, 256}; perm = true; mode = 0; O = (bf16*)(ws + WS_VT); ldc = NK; }
            else if (kind == 6) { g = pg8::Gemm{(const bf16*)(ws + WS_MIX), WB + W_OUT, MP, 1024, 1024}; perm = false; mode = 3; }
            else if (kind == 8) { g = pg8::Gemm{(const bf16*)(ws + WS_XB), WB + W_GU, MT, 5632, 1024}; perm = true; mode = 1; O = (bf16*)(ws + WS_F); ldc = DFF; }
            else                { g = pg8::Gemm{(const bf16*)(ws + WS_F), WB + W_DN, MP, 1024, DFF}; perm = false; mode = 3; }
            const float* xp = pp.out; const float* xs = pp.out + (size_t)MP * 1024; if (kind == 6 && l == 0) { xp = KIN(0); xs = KIN(1); }
            pg8::StaticOrder S; if (kind == 3) S.init(g.M, g.N, pp2.G, pp2.bid); else if (kind == 4 && j == 2) S.init(g.M, g.N, pp.G, (pp.bid < 4) ? pp.bid : ((pp.bid - 4 + pp.G) % pp.G)); else S.init(g.M, g.N, pp.G, pp.bid);
            if (perm) { EpiT<true> E{mode, O, ldc, xp, xs, pp.out, (const float2*)(ws + WS_ROPE)}; pg8::gemm_phase<EpiT<true>, pg8::StaticOrder, true, true>(lds, g, S, E, pp.tid); }
            else      { EpiT<false> E{mode, O, ldc, xp, xs, pp.out, (const float2*)(ws + WS_ROPE)}; pg8::gemm_phase<EpiT<false>, pg8::StaticOrder, true, true>(lds, g, S, E, pp.tid); }
            __syncthreads();
        }
        if (step + 1 < hi_) {
            if (step == lo_) grid.sync();
            else fast_grid_bar((unsigned*)(ws + WS_BAR), (unsigned)(step - lo_), pp.tid, pp.bid, pp.G);
        }
    }
}

extern "C" void kernel_launch(void* const* d_in, const int* in_sizes, int n_in, void* d_out, int out_size, void* d_ws, size_t ws_size, hipStream_t stream) {
    static int grid_blocks = 0;
    if (!grid_blocks) {
        if (hipFuncSetAttribute((const void*)mega, hipFuncAttributeMaxDynamicSharedMemorySize, LDS_BYTES) != hipSuccess) { fprintf(stderr, "kernel_launch: hipFuncSetAttribute failed\n"); grid_blocks = -1; }
        else { int dev = 0, cus = 0, per_cu = 0; hipGetDevice(&dev); hipDeviceGetAttribute(&cus, hipDeviceAttributeMultiprocessorCount, dev);
            hipOccupancyMaxActiveBlocksPerMultiprocessor(&per_cu, mega, 512, LDS_BYTES);
            if (per_cu < 1) { fprintf(stderr, "kernel_launch: occupancy query says %d\n", per_cu); per_cu = 1; }
            grid_blocks = cus; }
    }
    if (grid_blocks <= 0) return;
    if (ws_size < WS_TOTAL || n_in < 29) { fprintf(stderr, "kernel_launch: workspace too small (%zu < %zu) or n_in %d\n", ws_size, (size_t)WS_TOTAL, n_in); return; }
    Params p{};
    for (int i = 0; i < 29; ++i) p.in[i] = (const float*)d_in[i];
    p.out = (float*)d_out; p.ws = (unsigned char*)d_ws;
#if COOP
    p.lo = 0; p.hi = (REPK == 0) ? 21 : 23; void* args[] = {&p};
    hipMemsetAsync((unsigned char*)d_ws + WS_BAR, 0, 8192, stream);
    hipError_t e = hipLaunchCooperativeKernel((const void*)mega, dim3(grid_blocks), dim3(512), args, LDS_BYTES, stream);
    if (e != hipSuccess) fprintf(stderr, "cooperative launch failed: %s (grid %d)\n", hipGetErrorString(e), grid_blocks);
#else
    for (int s = 0; s < 21; ++s) { p.lo = s; p.hi = s + 1; hipLaunchKernelGGL(mega, dim3(grid_blocks), dim3(512), LDS_BYTES, stream, p); }
#endif
}
```

```cpp
#include <hip/hip_runtime.h>
#include <hip/hip_cooperative_groups.h>
#include <cstdio>
#include <cstdint>
namespace cg = cooperative_groups;
namespace pg8 {
#define PG8_LAS __attribute__((address_space(3)))
typedef unsigned short bf16_t;
typedef short bf16x8 __attribute__((ext_vector_type(8)));
typedef float f32x4 __attribute__((ext_vector_type(4)));
typedef unsigned u32x4 __attribute__((ext_vector_type(4)));
constexpr int BM = 256, BK = 64, HALF = 128, HTB = HALF * BK * 2  , STAGE_BYTES = 8 * HTB, NXCD = 8, WGM = 8;

__host__ __device__ __forceinline__ int lds_byte(int r, int c) { const int st = (r >> 4) * 2 + (c >> 5), rr = r & 15, cc = c & 31, ob = rr * 64 + cc * 2; return st * 1024 + (ob ^ (((ob >> 9) & 1) << 5)); }
__host__ __device__ __forceinline__ void stage_rc(int b, int& R, int& C) { const int st = b / 1024, sb = b % 1024, swz = sb ^ (((sb >> 9) & 1) << 5); R = (st >> 1) * 16 + swz / 64; C = (st & 1) * 32 + (swz % 64) / 2; }
__host__ __device__ __forceinline__ int perm32(int rho) { const int n = rho >> 4, i = rho & 15; return 8 * (i >> 2) + 4 * n + (i & 3); }

struct Unit { int pm, pn; };
struct Gemm { const bf16_t* A; const bf16_t* Bt; int M, N, K; };

struct StaticOrder {
    int nM, nN, nwg, G, c;
    __host__ __device__ void init(int M, int N, int G_, int c_) { nM = M / BM; nN = N / BM; nwg = nM * nN; G = G_; c = c_; }
    __host__ __device__ bool next(int i, Unit& u) const {
        const long L = (long)i * G + c; if (L >= nwg) return false;
        int wgid = (int)L; { const int q = nwg / NXCD, r = nwg % NXCD, xcd = wgid % NXCD, off = wgid / NXCD; wgid = (xcd < r ? xcd * (q + 1) : r * (q + 1) + (xcd - r) * q) + off; }
        const int nig = WGM * nN, gid = wgid / nig, fm = gid * WGM, gsz = (nM - fm) < WGM ? (nM - fm) : WGM;
        u.pm = fm + ((wgid % nig) % gsz); u.pn = (wgid % nig) / gsz; return true;
    }
    __device__ __forceinline__ void a_ready(const Unit&) const {}
    __device__ __forceinline__ void done(const Unit&) const {}
};
__device__ __forceinline__ unsigned cvt_pk_bf16(float lo, float hi) { unsigned r; asm volatile("v_cvt_pk_bf16_f32 %0, %1, %2" : "=v"(r) : "v"(lo), "v"(hi)); return r; }
template <class Epi, class Sched, bool ALIGN_EPI = false, bool SP2 = false>
__device__ __forceinline__ void gemm_phase(PG8_LAS unsigned char* lds, const Gemm g, const Sched& S, const Epi& E, const int tid) {
    const int  wid = __builtin_amdgcn_readfirstlane(tid >> 6), lane = tid & 63, wr = wid >> 2, wc = wid & 3, fr = lane & 15, fq = lane >> 4;
    const int K = g.K, nt = K / BK;
    unsigned voffA[2], voffB[2];
#pragma unroll
    for (int i = 0; i < 2; ++i) { int R, C; stage_rc(tid * 16 + i * 8192, R, C); const int Rb = Epi::PERM ? ((R & ~31) + perm32(R & 31)) : R;
        voffA[i] = (unsigned)(R * K + C) * 2u; voffB[i] = (unsigned)(Rb * K + C) * 2u; }
    const size_t kstep = (size_t)(BK * 2);
    const size_t hstep = (size_t)HALF * K * 2;
    const size_t tstep = 2 * hstep;
    const unsigned ldsw = (unsigned)wid * 1024u;
    const int aoff = lds_byte(wr * 64 + fr, fq * 8), boff = lds_byte(wc * 32 + fr, fq * 8);
#define PG8_SA(b, h) (((b) * 2 + (h)) * HTB)
#define PG8_SB(b, h) ((4 + (b) * 2 + (h)) * HTB)
#define PG8_STAGE(bufoff, gbase, voff) do { _Pragma("unroll") for (int _i = 0; _i < 2; ++_i) \
        __builtin_amdgcn_global_load_lds((const unsigned*)((const char*)(gbase) + (voff)[_i]), (PG8_LAS unsigned*)(lds + (bufoff) + ldsw + _i * 8192), 16, 0, 0); } while (0)
#define PG8_LDA(dst, b, h) do { _Pragma("unroll") for (int m = 0; m < 4; ++m) _Pragma("unroll") for (int k = 0; k < 2; ++k) dst[m][k] = *(const PG8_LAS bf16x8*)(lds + PG8_SA(b, h) + aoff + m * 2048 + k * 1024); } while (0)
#define PG8_LDB(dst, b, h) do { _Pragma("unroll") for (int n = 0; n < 2; ++n) _Pragma("unroll") for (int k = 0; k < 2; ++k) dst[n][k] = *(const PG8_LAS bf16x8*)(lds + PG8_SB(b, h) + boff + n * 2048 + k * 1024); } while (0)
#define PG8_MMA(ai, bj, At, Bt) do { __builtin_amdgcn_s_setprio(1); _Pragma("unroll") for (int m = 0; m < 4; ++m) _Pragma("unroll") for (int n = 0; n < 2; ++n) _Pragma("unroll") for (int k = 0; k < 2; ++k) \
        acc[ai][bj][m][n] = __builtin_amdgcn_mfma_f32_16x16x32_bf16(Bt[n][k], At[m][k], acc[ai][bj][m][n], 0, 0, 0); __builtin_amdgcn_s_setprio(0); } while (0)
#define PG8_WAIT_V(n) asm volatile("s_waitcnt vmcnt(" #n ")" ::: "memory")
#define PG8_WAIT_L(n) asm volatile("s_waitcnt lgkmcnt(" #n ")" ::: "memory")
#define PG8_BAR __builtin_amdgcn_s_barrier()
#define PG8_SCHED __builtin_amdgcn_sched_barrier(0)
    Unit cur, nxt; int ui = 0;
    if (!S.next(0, cur)) return;
    f32x4 acc[2][2][4][2];
#pragma unroll
    for (int a = 0; a < 2; ++a)
#pragma unroll
        for (int b = 0; b < 2; ++b)
#pragma unroll
            for (int m = 0; m < 4; ++m)
#pragma unroll
                for (int n = 0; n < 2; ++n) acc[a][b][m][n] = (f32x4){0.f, 0.f, 0.f, 0.f};
    bf16x8 At[4][2], B0[2][2], B1[2][2];
    const char* cA = (const char*)g.A + (size_t)cur.pm * tstep; const char* cB = (const char*)g.Bt + (size_t)cur.pn * tstep;
    S.a_ready(cur);
    if constexpr (SP2) {
        PG8_STAGE(PG8_SB(0, 0), cB, voffB); PG8_STAGE(PG8_SB(0, 1), cB + hstep, voffB); PG8_STAGE(PG8_SA(0, 0), cA, voffA); PG8_STAGE(PG8_SA(0, 1), cA + hstep, voffA);
        if (wr == 1) PG8_BAR;
        PG8_WAIT_V(2); PG8_BAR;
        PG8_STAGE(PG8_SB(1, 0), cB + kstep, voffB); PG8_STAGE(PG8_SA(1, 0), cA + kstep, voffA); PG8_STAGE(PG8_SB(1, 1), cB + hstep + kstep, voffB);
        PG8_WAIT_V(6); PG8_BAR;
    } else {
        PG8_STAGE(PG8_SB(0, 0), cB, voffB); PG8_STAGE(PG8_SA(0, 0), cA, voffA); PG8_STAGE(PG8_SB(0, 1), cB + hstep, voffB); PG8_STAGE(PG8_SA(0, 1), cA + hstep, voffA);
        if (wr == 1) PG8_BAR;
        PG8_WAIT_V(4); PG8_BAR;
        PG8_STAGE(PG8_SB(1, 0), cB + kstep, voffB); PG8_STAGE(PG8_SA(1, 0), cA + kstep, voffA); PG8_STAGE(PG8_SB(1, 1), cB + hstep + kstep, voffB);
        PG8_WAIT_V(6); PG8_BAR;
    }
    for (;;) {
        const bool has_next = S.next(ui + 1, nxt);
        const char* nA = has_next ? (const char*)g.A + (size_t)nxt.pm * tstep : cA; const char* nB = has_next ? (const char*)g.Bt + (size_t)nxt.pn * tstep : cB;
        for (int t = 0; t < nt; t += 2) {
            const bool last = (t == nt - 2);
            const char* a1 = cA + (size_t)(t + 1) * kstep;
            const char* a2 = last ? nA : cA + (size_t)(t + 2) * kstep; const char* b2 = last ? nB : cB + (size_t)(t + 2) * kstep;
            const char* a3 = a2 + kstep; const char* b3 = b2 + kstep;
            if (last && has_next) S.a_ready(nxt);
            if constexpr (SP2) {
            PG8_LDB(B0, 0, 0); PG8_LDB(B1, 0, 1); PG8_SCHED; PG8_LDA(At, 0, 0); PG8_STAGE(PG8_SA(1, 1), a1 + hstep, voffA);
            PG8_WAIT_V(8); PG8_WAIT_L(0); PG8_BAR; PG8_MMA(0, 0, At, B0); PG8_MMA(0, 1, At, B1); PG8_BAR; PG8_SCHED;
            PG8_LDA(At, 0, 1); PG8_STAGE(PG8_SB(0, 0), b2, voffB); PG8_STAGE(PG8_SB(0, 1), b2 + hstep, voffB); PG8_STAGE(PG8_SA(0, 0), a2, voffA);
            PG8_WAIT_V(8); PG8_WAIT_L(0); PG8_BAR; PG8_MMA(1, 0, At, B0); PG8_MMA(1, 1, At, B1); PG8_BAR; PG8_SCHED;
            PG8_LDB(B0, 1, 0); PG8_LDB(B1, 1, 1); PG8_SCHED; PG8_LDA(At, 1, 0); PG8_STAGE(PG8_SA(0, 1), a2 + hstep, voffA);
            PG8_WAIT_V(8); PG8_WAIT_L(0); PG8_BAR; PG8_MMA(0, 0, At, B0); PG8_MMA(0, 1, At, B1); PG8_BAR; PG8_SCHED;
            PG8_LDA(At, 1, 1); PG8_STAGE(PG8_SB(1, 0), b3, voffB); PG8_STAGE(PG8_SB(1, 1), b3 + hstep, voffB); PG8_STAGE(PG8_SA(1, 0), a3, voffA);
            PG8_WAIT_V(8); PG8_WAIT_L(0); PG8_BAR; PG8_MMA(1, 0, At, B0); PG8_MMA(1, 1, At, B1); PG8_BAR; PG8_SCHED;
            } else {
            PG8_LDB(B0, 0, 0); PG8_SCHED; PG8_LDA(At, 0, 0); PG8_STAGE(PG8_SA(1, 1), a1 + hstep, voffA);
            PG8_WAIT_L(8); PG8_BAR; PG8_WAIT_L(0); PG8_MMA(0, 0, At, B0); PG8_BAR; PG8_SCHED;
            PG8_LDB(B1, 0, 1); PG8_STAGE(PG8_SB(0, 0), b2, voffB);
            PG8_BAR; PG8_WAIT_L(0); PG8_MMA(0, 1, At, B1); PG8_BAR;
            PG8_LDA(At, 0, 1); PG8_STAGE(PG8_SA(0, 0), a2, voffA);
            PG8_BAR; PG8_WAIT_L(0); PG8_MMA(1, 0, At, B0); PG8_BAR; PG8_SCHED;
            PG8_STAGE(PG8_SB(0, 1), b2 + hstep, voffB);
            PG8_WAIT_V(6); PG8_BAR; PG8_MMA(1, 1, At, B1); PG8_BAR;
            PG8_LDB(B0, 1, 0); PG8_SCHED; PG8_LDA(At, 1, 0); PG8_STAGE(PG8_SA(0, 1), a2 + hstep, voffA);
            PG8_WAIT_L(8); PG8_BAR; PG8_WAIT_L(0); PG8_MMA(0, 0, At, B0); PG8_BAR; PG8_SCHED;
            PG8_LDB(B1, 1, 1); PG8_STAGE(PG8_SB(1, 0), b3, voffB);
            PG8_BAR; PG8_WAIT_L(0); PG8_MMA(0, 1, At, B1); PG8_BAR;
            PG8_LDA(At, 1, 1); PG8_STAGE(PG8_SA(1, 0), a3, voffA);
            PG8_BAR; PG8_WAIT_L(0); PG8_MMA(1, 0, At, B0); PG8_BAR; PG8_SCHED;
            PG8_STAGE(PG8_SB(1, 1), b3 + hstep, voffB);
            PG8_WAIT_V(6); PG8_BAR; PG8_MMA(1, 1, At, B1); PG8_BAR;
            }
        }
        if constexpr (ALIGN_EPI) { if (wr == 0) PG8_BAR; }
        if constexpr (!Epi::AFTER_DRAIN) { E(acc, cur, wr, wc, fr, fq); S.done(cur); }
        if (!has_next) break;
#pragma unroll
        for (int a = 0; a < 2; ++a)
#pragma unroll
            for (int b = 0; b < 2; ++b)
#pragma unroll
                for (int m = 0; m < 4; ++m)
#pragma unroll
                    for (int n = 0; n < 2; ++n) acc[a][b][m][n] = (f32x4){0.f, 0.f, 0.f, 0.f};
        cur = nxt; cA = nA; cB = nB; ++ui;
        if constexpr (ALIGN_EPI) { if (wr == 1) PG8_BAR; }
    }
    PG8_WAIT_V(0);
    if constexpr (!ALIGN_EPI) { if (wr == 0) PG8_BAR; }
    PG8_BAR;
    if constexpr (Epi::AFTER_DRAIN) { E.fused(acc, cur, wr, wc, fr, fq, lds, wid, lane); S.done(cur); }
#undef PG8_SA
#undef PG8_SB
#undef PG8_STAGE
#undef PG8_LDA
#undef PG8_LDB
#undef PG8_MMA
#undef PG8_WAIT_V
#undef PG8_WAIT_L
#undef PG8_BAR
#undef PG8_SCHED
}
}

#define LAS __attribute__((address_space(3)))
typedef unsigned short bf16;
typedef short bf16x8 __attribute__((ext_vector_type(8)));
typedef short s16x4 __attribute__((ext_vector_type(4)));
typedef float f32x4 __attribute__((ext_vector_type(4)));
typedef unsigned u32x4 __attribute__((ext_vector_type(4)));
typedef unsigned u32x2 __attribute__((ext_vector_type(2)));

#ifndef COOP
#define COOP 1
#endif
#ifndef REPK
#define REPK 0
#endif
#ifndef REPG1
#define REPG1 0
#endif
#ifndef REP2
#define REP2 0
#endif
#ifndef GDN_SPLIT
#define GDN_SPLIT 0
#endif

constexpr int MP = 32768, MS = 512, MT = MP + MS;
constexpr int SKS = 2064;
constexpr int NK = MP + 32 * SKS;
constexpr int NKM = MP + 65536;
constexpr int HLD = 2304;
constexpr int C_CKV = 384, C_KPE = 640, C_QKV = 672, C_B = 1440, C_A = 1444, C_Z = 1448, C_GA = 1704, C_GG = 1960;
constexpr int DFF = 2816;
constexpr float DN_ALPHA = 1.41421356237f;
constexpr float QSCALE = 0.10206207261596577f * 1.4426950408889634f;

constexpr size_t O_YP = 0, O_YS = 33554432, O_CKVP = 34078720, O_KPEP = 50855936, O_GDNP = 52953088, O_GCP = 53477376,
                 O_CVP = 53551104, O_CKVS = 53796864, O_KPES = 54059008, O_GDNS = 54091776, O_GCS = 55140352, O_CVS = 55287808;

constexpr size_t W_IN = 0, W_UQ = W_IN + 2304 * 1024, W_UK = W_UQ + 768 * 384, W_UVT = W_UK + 512 * 256, W_OUT = W_UVT + 512 * 256,
                 W_GU = W_OUT + 1024 * 1024, W_DN = W_GU + 5632 * 1024, W_LAYER = W_DN + 1024 * 2816;
constexpr size_t WS_W = 0, WS_ROPE = WS_W + 2 * W_LAYER * 2, WS_XB = WS_ROPE + 2064 * 16 * 8, WS_MIX = WS_XB + (size_t)MT * 1024 * 2,
                 WS_CQN = WS_MIX + (size_t)MT * 1024 * 2, WS_CKVB = WS_CQN + (size_t)MT * 384 * 2, WS_KPEB = WS_CKVB + (size_t)NK * 256 * 2,
                 WS_BIG = WS_KPEB + (size_t)NK * 32 * 2;
constexpr size_t GUNIT = 49408;
constexpr int NGU = 2176;
constexpr size_t WS_H = WS_BIG, WS_GSCR = WS_H + (size_t)MT * HLD * 2, BIG1 = (size_t)MT * HLD * 2 + (size_t)NGU * GUNIT;
constexpr size_t WS_Q = WS_BIG, WS_KN = WS_Q + (size_t)MT * 768 * 2, WS_VT = WS_KN + (size_t)NK * 512 * 2, BIG2 = (size_t)MT * 768 * 2 + 2 * (size_t)NK * 512 * 2;
constexpr size_t WS_F = WS_BIG, BIG3 = (size_t)MT * DFF * 2;
constexpr size_t BIGSZ = BIG1 > BIG2 ? (BIG1 > BIG3 ? BIG1 : BIG3) : (BIG2 > BIG3 ? BIG2 : BIG3);
constexpr size_t WS_BAR = WS_BIG + BIGSZ;
constexpr size_t WS_TOTAL = WS_BAR + 8192;
static_assert(WS_TOTAL <= 536870912ull, "workspace map exceeds 512 MiB");
static_assert(WS_XB % 256 == 0 && WS_BIG % 256 == 0 && WS_GSCR % 256 == 0 && WS_KN % 256 == 0 && WS_VT % 256 == 0, "alignment");

constexpr int LDS_BYTES = 139264;
constexpr int G1_GRP = 67584;

struct Params { const float* in[29]; float* out; unsigned char* ws; int lo, hi; };
template <int OFF> __device__ __forceinline__ unsigned long long karg_u64() {
    unsigned long long v; const unsigned long long kp = (unsigned long long)__builtin_amdgcn_kernarg_segment_ptr();
    asm volatile("s_load_dwordx2 %0, %1, %2\n\ts_waitcnt lgkmcnt(0)" : "=s"(v) : "s"(kp), "n"(OFF));
    return v;
}
#define GAS1 __attribute__((address_space(1)))
#define KIN(i) ((const float*)(const GAS1 float*)karg_u64<8 * (i)>())
#define KOUT() ((float*)(GAS1 float*)karg_u64<232>())
#define KWS() ((unsigned char*)(GAS1 unsigned char*)karg_u64<240>())
struct PP { unsigned char* ws; float* out; int tid, bid, G; };

__device__ __forceinline__ unsigned f2bf(float f) { unsigned u = __builtin_bit_cast(unsigned, f); return (u + 0x7fffu + ((u >> 16) & 1u)) >> 16; }
__device__ __forceinline__ float bf2f(unsigned b) { return __builtin_bit_cast(float, b << 16); }
__device__ __forceinline__ unsigned pk2(float lo, float hi) { return pg8::cvt_pk_bf16(lo, hi); }
__device__ __forceinline__ float sigmoidf_(float x) { return 1.0f / (1.0f + __expf(-x)); }
__device__ __forceinline__ float siluf_(float x) { return x * sigmoidf_(x); }

template <int CTRL> __device__ __forceinline__ float dpp_f(float v) { return __builtin_bit_cast(float, __builtin_amdgcn_update_dpp(0, __builtin_bit_cast(int, v), CTRL, 0xf, 0xf, false)); }
__device__ __forceinline__ float row16_sum(float v) { v += dpp_f<0xB1>(v); v += dpp_f<0x4E>(v); v += dpp_f<0x141>(v); v += dpp_f<0x140>(v); return v; }
__device__ __forceinline__ float xor16_get(float v) { return __builtin_bit_cast(float, __builtin_amdgcn_ds_swizzle(__builtin_bit_cast(int, v), 0x401F)); }
__device__ __forceinline__ float xor32_max(float v) { const unsigned u = __builtin_bit_cast(unsigned, v); auto r = __builtin_amdgcn_permlane32_swap(u, u, false, false); return fmaxf(__builtin_bit_cast(float, (unsigned)r[0]), __builtin_bit_cast(float, (unsigned)r[1])); }
__device__ __forceinline__ float xor32_sum(float v) { const unsigned u = __builtin_bit_cast(unsigned, v); auto r = __builtin_amdgcn_permlane32_swap(u, u, false, false); return __builtin_bit_cast(float, (unsigned)r[0]) + __builtin_bit_cast(float, (unsigned)r[1]); }
__device__ __forceinline__ float wave_sum(float v) {
    v = row16_sum(v); const int iv = __builtin_bit_cast(int, v);
    const float s0 = __builtin_bit_cast(float, __builtin_amdgcn_readlane(iv, 0)), s1 = __builtin_bit_cast(float, __builtin_amdgcn_readlane(iv, 16));
    const float s2 = __builtin_bit_cast(float, __builtin_amdgcn_readlane(iv, 32)), s3 = __builtin_bit_cast(float, __builtin_amdgcn_readlane(iv, 48));
    return (s0 + s1) + (s2 + s3);
}
#define LBAR() asm volatile("s_waitcnt lgkmcnt(0)\n\ts_barrier" ::: "memory")
__device__ __forceinline__ f32x4 mfma16(bf16x8 a, bf16x8 b, f32x4 c) { return __builtin_amdgcn_mfma_f32_16x16x32_bf16(a, b, c, 0, 0, 0); }

template <bool P> struct EpiT {
    static constexpr bool PERM = P, AFTER_DRAIN = false;
    int mode;
    bf16* O; size_t ldc;
    const float* xp; const float* xs; float* X;
    const float2* rope;
    __device__ __forceinline__ void operator()(const f32x4 (&acc)[2][2][4][2], const pg8::Unit& u, int wr, int wc, int fr, int fq) const {
        const int row0 = u.pm * 256 + wr * 64 + fr;
        if constexpr (P) {
            if (mode == 0) {
                const int col0 = u.pn * 256 + wc * 32 + 8 * fq;
#pragma unroll
                for (int ai = 0; ai < 2; ++ai)
#pragma unroll
                    for (int m = 0; m < 4; ++m) { bf16* rowp = O + (size_t)(row0 + ai * 128 + m * 16) * ldc + col0;
#pragma unroll
                        for (int bj = 0; bj < 2; ++bj) { const f32x4 v0 = acc[ai][bj][m][0], v1 = acc[ai][bj][m][1]; u32x4 w;
                            w.x = pk2(v0[0], v0[1]); w.y = pk2(v0[2], v0[3]); w.z = pk2(v1[0], v1[1]); w.w = pk2(v1[2], v1[3]);
                            *(u32x4*)(rowp + bj * 128) = w; } }
            } else {
                const int col0 = u.pn * 128 + wc * 32 + 8 * fq;
#pragma unroll
                for (int ai = 0; ai < 2; ++ai)
#pragma unroll
                    for (int m = 0; m < 4; ++m) { bf16* rowp = O + (size_t)(row0 + ai * 128 + m * 16) * ldc + col0;
                        float f[8];
#pragma unroll
                        for (int n = 0; n < 2; ++n)
#pragma unroll
                            for (int j = 0; j < 4; ++j) { const float g = acc[ai][0][m][n][j], up = acc[ai][1][m][n][j]; f[n * 4 + j] = siluf_(g) * up; }
                        u32x4 w; w.x = pk2(f[0], f[1]); w.y = pk2(f[2], f[3]); w.z = pk2(f[4], f[5]); w.w = pk2(f[6], f[7]);
                        *(u32x4*)rowp = w; }
            }
        } else {
            if (mode == 3) {
#pragma unroll
                for (int ai = 0; ai < 2; ++ai)
#pragma unroll
                    for (int m = 0; m < 4; ++m) { const int row = row0 + ai * 128 + m * 16;
                        const float* src = (row < MP) ? xp + (size_t)row * 1024 : xs + (size_t)(row - MP) * 1024;
                        float* dst = X + (size_t)row * 1024;
#pragma unroll
                        for (int bj = 0; bj < 2; ++bj)
#pragma unroll
                            for (int n = 0; n < 2; ++n) { const int col = u.pn * 256 + bj * 128 + wc * 32 + n * 16 + 4 * fq;
                                const f32x4 xi = *(const f32x4*)(src + col); f32x4 o = xi * DN_ALPHA + acc[ai][bj][m][n];
                                *(f32x4*)(dst + col) = o; }
                        __builtin_amdgcn_sched_barrier(0); }
            } else {
#pragma unroll
                for (int ai = 0; ai < 2; ++ai)
#pragma unroll
                    for (int m = 0; m < 4; ++m) { const int row = row0 + ai * 128 + m * 16;
                        const int pos = (row < MP) ? (row & 2047) : (2048 + ((row - MP) & 15));
                        bf16* rowp = O + (size_t)row * 768;
#pragma unroll
                        for (int bj = 0; bj < 2; ++bj) { const int g32 = u.pn * 256 + bj * 128 + wc * 32;
                            f32x4 a = acc[ai][bj][m][0], b = acc[ai][bj][m][1];
                            if ((g32 % 96) == 64) {
                                const float2* rp = rope + pos * 16 + 4 * fq;
#pragma unroll
                                for (int j = 0; j < 4; ++j) { const float2 cs = rp[j]; const float x1 = a[j], x2 = b[j]; a[j] = x1 * cs.x - x2 * cs.y; b[j] = x1 * cs.y + x2 * cs.x; }
                            }
                            a = a * QSCALE; b = b * QSCALE;
                            u32x2 w0, w1; w0.x = pk2(a[0], a[1]); w0.y = pk2(a[2], a[3]); w1.x = pk2(b[0], b[1]); w1.y = pk2(b[2], b[3]);
                            *(u32x2*)(rowp + g32 + 4 * fq) = w0; *(u32x2*)(rowp + g32 + 16 + 4 * fq) = w1; }
                        __builtin_amdgcn_sched_barrier(0); }
            }
        }
    }
};

__device__ __forceinline__ void prep_phase(const PP P, LAS unsigned char* lds, const int wl, const bool do_rest) {
    const int tid = P.tid, G = P.G;
    LAS float* tile = (LAS float*)lds;
    bf16* WB = (bf16*)(P.ws + WS_W);
    const int tx = tid & 63, ty = tid >> 6;
    for (int it = P.bid; it < 3080; it += G) {
        const int l = wl, r = it;
        const float* src; int ld, K, kt_n, tt; bf16* dst; int kind;
        if (r < 576)       { kind = 0; tt = r;        src = KIN(7) + (size_t)l * 1024 * 2216;  ld = 2216; K = 1024; kt_n = 16; dst = WB + l * W_LAYER + W_IN; }
        else if (r < 648)  { kind = 1; tt = r - 576;  src = KIN(9) + (size_t)l * 384 * 768;    ld = 768;  K = 384;  kt_n = 6;  dst = WB + l * W_LAYER + W_UQ; }
        else if (r < 680)  { kind = 1; tt = r - 648;  src = KIN(11) + (size_t)l * 256 * 512;   ld = 512;  K = 256;  kt_n = 4;  dst = WB + l * W_LAYER + W_UK; }
        else if (r < 712)  { kind = 1; tt = r - 680;  src = KIN(12) + (size_t)l * 256 * 512;   ld = 512;  K = 256;  kt_n = 4;  dst = WB + l * W_LAYER + W_UVT; }
        else if (r < 968)  { kind = 1; tt = r - 712;  src = KIN(21) + (size_t)l * 1024 * 1024; ld = 1024; K = 1024; kt_n = 16; dst = WB + l * W_LAYER + W_OUT; }
        else if (r < 2376) { kind = 2; tt = r - 968;  src = nullptr;                            ld = 2816; K = 1024; kt_n = 16; dst = WB + l * W_LAYER + W_GU; }
        else               { kind = 1; tt = r - 2376; src = KIN(26) + (size_t)l * 2816 * 1024; ld = 1024; K = 2816; kt_n = 44; dst = WB + l * W_LAYER + W_DN; }
        const int n0 = (tt / kt_n) * 64, k0 = (tt % kt_n) * 64;
        int col0 = n0; bool valid = true;
        if (kind == 0) valid = (n0 + tx) < 2216;
        if (kind == 2) { src = (((n0 >> 7) & 1) ? KIN(25) : KIN(24)) + (size_t)l * 1024 * 2816; col0 = (n0 >> 8) * 128 + (n0 & 127); }
#pragma unroll
        for (int kk = ty; kk < 64; kk += 8) tile[kk * 65 + tx] = valid ? src[(size_t)(k0 + kk) * ld + col0 + tx] : 0.f;
        __syncthreads();
#pragma unroll
        for (int nn = ty; nn < 64; nn += 8) dst[(size_t)(n0 + nn) * K + k0 + tx] = (bf16)f2bf(tile[tx * 65 + nn]);
        __syncthreads();
    }
    if (!do_rest) return;
    bf16* XB = (bf16*)(P.ws + WS_XB);
    for (int g = P.bid * 512 + tid; g < MT * 128; g += G * 512) {
        const int row = g >> 7, c8 = g & 127;
        const float* s = (row < MP) ? KIN(0) + (size_t)row * 1024 + c8 * 8 : KIN(1) + (size_t)(row - MP) * 1024 + c8 * 8;
        const f32x4 a = *(const f32x4*)s, b = *(const f32x4*)(s + 4);
        u32x4 w; w.x = pk2(a[0], a[1]); w.y = pk2(a[2], a[3]); w.z = pk2(b[0], b[1]); w.w = pk2(b[2], b[3]);
        *(u32x4*)(XB + (size_t)g * 8) = w;
    }
    float2* rope = (float2*)(P.ws + WS_ROPE);
    for (int idx = P.bid * 512 + tid; idx < 2064 * 16; idx += G * 512) {
        const int pos = idx >> 4, i = idx & 15;
        const float inv = __expf(-9.210340371976184f * (float)i / 16.0f);
        const float ang = (float)pos * inv;
        const float k = rintf(ang * 0.15915494309189535f);
        float rr = fmaf(-k, 6.2831854820251465f, ang); rr = fmaf(k, 1.7484555e-7f, rr);
        rope[idx] = make_float2(__cosf(rr), __sinf(rr));
    }
}

__device__ __forceinline__ void tok_phase(const PP P, int l) {
    const int tid = P.tid, lane = tid & 63, wave = tid >> 6, G = P.G;
    const bf16* H = (const bf16*)(P.ws + WS_H);
    bf16* CQN = (bf16*)(P.ws + WS_CQN); bf16* CKVB = (bf16*)(P.ws + WS_CKVB); bf16* KPEB = (bf16*)(P.ws + WS_KPEB);
    const float2* rope = (const float2*)(P.ws + WS_ROPE);
    const float* qn = KIN(8) + l * 384; const float* kvn = KIN(10) + l * 256;
    float* out = P.out;
    for (int row = P.bid * 8 + wave; row < MT; row += G * 8) {
        const bf16* hr = H + (size_t)row * HLD;
        const bool smp = row >= MP; int b, t, pos;
        if (!smp) { b = row >> 11; t = row & 2047; pos = t; } else { const int rr = row - MP; b = rr >> 4; t = rr & 15; pos = 2048 + t; }
        const size_t krow = smp ? (size_t)MP + 65536 + (size_t)b * 16 + t : (size_t)row;
        { float v[6]; float ss = 0.f;
#pragma unroll
          for (int i = 0; i < 3; ++i) { const unsigned w = *(const unsigned*)(hr + 128 * i + lane * 2); v[2 * i] = bf2f(w & 0xffffu); v[2 * i + 1] = bf2f(w >> 16); ss += v[2 * i] * v[2 * i] + v[2 * i + 1] * v[2 * i + 1]; }
          ss = wave_sum(ss); const float rinv = rsqrtf(ss * (1.0f / 384.0f) + 1e-6f);
#pragma unroll
          for (int i = 0; i < 3; ++i) { const int col = 128 * i + lane * 2; *(unsigned*)(CQN + (size_t)row * 384 + col) = pk2(v[2 * i] * rinv * qn[col], v[2 * i + 1] * rinv * qn[col + 1]); } }
        { const u32x2 w = *(const u32x2*)(hr + C_CKV + lane * 4);
          float v0 = bf2f(w.x & 0xffffu), v1 = bf2f(w.x >> 16), v2 = bf2f(w.y & 0xffffu), v3 = bf2f(w.y >> 16);
          float ss = wave_sum(v0 * v0 + v1 * v1 + v2 * v2 + v3 * v3); const float rinv = rsqrtf(ss * (1.0f / 256.0f) + 1e-6f);
          const f32x4 gn = *(const f32x4*)(kvn + lane * 4);
          f32x4 o; o[0] = v0 * rinv * gn[0]; o[1] = v1 * rinv * gn[1]; o[2] = v2 * rinv * gn[2]; o[3] = v3 * rinv * gn[3];
          float* op = smp ? out + O_CKVS + ((size_t)(l * 32 + b) * 16 + t) * 256 : out + O_CKVP + ((size_t)(l * 16 + b) * 2048 + t) * 256;
          *(f32x4*)(op + lane * 4) = o;
          u32x2 pw; pw.x = pk2(o[0], o[1]); pw.y = pk2(o[2], o[3]); *(u32x2*)(CKVB + krow * 256 + lane * 4) = pw; }
        if (lane < 16) { const float x1 = bf2f(hr[C_KPE + lane]), x2 = bf2f(hr[C_KPE + 16 + lane]); const float2 cs = rope[pos * 16 + lane];
          const float o1 = x1 * cs.x - x2 * cs.y, o2 = x1 * cs.y + x2 * cs.x;
          float* op = smp ? out + O_KPES + ((size_t)(l * 32 + b) * 16 + t) * 32 : out + O_KPEP + ((size_t)(l * 16 + b) * 2048 + t) * 32;
          op[lane] = o1; op[16 + lane] = o2; KPEB[krow * 32 + lane] = (bf16)f2bf(o1); KPEB[krow * 32 + 16 + lane] = (bf16)f2bf(o2); }
        { const int T = smp ? 16 : 2048;
          if (t >= T - 3) { const int j = t - (T - 3);
            float* op = smp ? out + O_GCS + ((size_t)(l * 32 + b) * 3 + j) * 768 : out + O_GCP + ((size_t)(l * 16 + b) * 3 + j) * 768;
#pragma unroll
            for (int i = 0; i < 12; ++i) op[lane + 64 * i] = bf2f(hr[C_QKV + lane + 64 * i]); } }
        if (smp || t >= 2018) {
            float* op = smp ? out + O_CVS + ((size_t)(l * 32 + b) * 30 + 14 + t) * 256 : out + O_CVP + ((size_t)(l * 16 + b) * 30 + (t - 2018)) * 256;
#pragma unroll
            for (int i = 0; i < 4; ++i) { const int ch = lane + 64 * i; op[ch] = bf2f(hr[C_GA + ch]) * sigmoidf_(bf2f(hr[C_GG + ch])); }
            if (smp && t == 0) {
                const float* sc = KIN(6) + ((size_t)(l * 32 + b) * 30 + 16) * 256; float* o2 = out + O_CVS + (size_t)(l * 32 + b) * 30 * 256;
                for (int e = lane; e < 14 * 256; e += 64) o2[e] = sc[e];
            }
        }
    }
}

__device__ __forceinline__ void cache_phase(const PP P, int l) {
    const int tid = P.tid, G = P.G;
    bf16* CKVB = (bf16*)(P.ws + WS_CKVB); bf16* KPEB = (bf16*)(P.ws + WS_KPEB);
    const float* cckv = KIN(2) + (size_t)l * 32 * 2048 * 256; const float* ckpe = KIN(3) + (size_t)l * 32 * 2048 * 32;
    for (int g = P.bid * 512 + tid; g < 65536 * 32; g += G * 512) {
        const int prow = g >> 5, c8 = g & 31, b = prow >> 11, s = prow & 2047;
        const float* sp = cckv + (size_t)prow * 256 + c8 * 8; const f32x4 a = *(const f32x4*)sp, c = *(const f32x4*)(sp + 4);
        u32x4 w; w.x = pk2(a[0], a[1]); w.y = pk2(a[2], a[3]); w.z = pk2(c[0], c[1]); w.w = pk2(c[2], c[3]);
        *(u32x4*)(CKVB + ((size_t)MP + (size_t)b * 2048 + s) * 256 + c8 * 8) = w;
    }
    for (int g = P.bid * 512 + tid; g < 65536 * 4; g += G * 512) {
        const int prow = g >> 2, c8 = g & 3, b = prow >> 11, s = prow & 2047;
        const float* sp = ckpe + (size_t)prow * 32 + c8 * 8; const f32x4 a = *(const f32x4*)sp, c = *(const f32x4*)(sp + 4);
        u32x4 w; w.x = pk2(a[0], a[1]); w.y = pk2(a[2], a[3]); w.z = pk2(c[0], c[1]); w.w = pk2(c[2], c[3]);
        *(u32x4*)(KPEB + ((size_t)MP + (size_t)b * 2048 + s) * 32 + c8 * 8) = w;
    }
}

__device__ __forceinline__ void conv_phase(const PP P, int l, LAS unsigned char* lds) {
    const int tid = P.tid, lane = tid & 63, wave = tid >> 6, G = P.G;
    const bf16* H = (const bf16*)(P.ws + WS_H); bf16* MIX = (bf16*)(P.ws + WS_MIX);
    LAS bf16* cs = (LAS bf16*)lds;
    LAS float* os = (LAS float*)(lds + 48128);
    const float* cw = KIN(17) + (size_t)l * 31 * 256; const float* cb = KIN(18) + l * 256;
    const float* lg = KIN(19) + l * 256; const float* lb = KIN(20) + l * 256; const float* sc = KIN(6);
    for (int u = P.bid; u < 544; u += G) {
        const bool smp = u < 32; int b, t0, ntok; size_t row0;
        if (!smp) { const int v = u - 32; b = v >> 5; t0 = (v & 31) * 64; ntok = 64; row0 = (size_t)b * 2048 + t0; } else { b = u; t0 = 0; ntok = 16; row0 = (size_t)MP + b * 16; }
        { const int ch2 = (tid & 127) * 2, rg = tid >> 7; const int nrow = 30 + ntok;
          const GAS1 bf16* hb = (const GAS1 bf16*)(H + ((long long)row0 - 30 + rg) * HLD + ch2);
          for (int k0 = 0; k0 < 24; k0 += 12) {
          unsigned ra[12], rgt[12];
#pragma unroll
          for (int k = 0; k < 12; ++k) { const int i = rg + 4 * (k0 + k), tt = t0 - 30 + i; ra[k] = 0u; rgt[k] = 0u;
              if (i < nrow && tt >= 0) { ra[k] = *(const GAS1 unsigned*)(hb + C_GA); rgt[k] = *(const GAS1 unsigned*)(hb + C_GG); }
              hb += 4 * HLD; asm volatile("" : "+v"(hb)); }
#pragma unroll
          for (int k = 0; k < 12; ++k) { const int i = rg + 4 * (k0 + k), tt = t0 - 30 + i;
              if (i < nrow) { float v0, v1;
                  if (tt >= 0 || !smp) { v0 = bf2f(ra[k] & 0xffffu) * sigmoidf_(bf2f(rgt[k] & 0xffffu)); v1 = bf2f(ra[k] >> 16) * sigmoidf_(bf2f(rgt[k] >> 16)); }
                  else { const float* sp = sc + ((size_t)(l * 32 + b) * 30 + (30 + tt)) * 256 + ch2; v0 = sp[0]; v1 = sp[1]; }
                  *(LAS unsigned*)(cs + i * 256 + ch2) = pk2(v0, v1); } } } }
        LBAR();
        { const int ch = tid & 255, gsel = tid >> 8; float w[31]; const GAS1 float* cwp = (const GAS1 float*)(cw + ch); asm volatile("" : "+v"(cwp));
#pragma unroll
          for (int j = 0; j < 31; ++j) w[j] = cwp[j * 256];
          const float bias = cb[ch];
          for (int g = gsel; g < (ntok >> 3); g += 2) { float win[38];
#pragma unroll
              for (int i = 0; i < 38; ++i) win[i] = bf2f(cs[(8 * g + i) * 256 + ch]);
#pragma unroll
              for (int t = 0; t < 8; ++t) { float acc = bias;
#pragma unroll
                  for (int j = 0; j < 31; ++j) acc += w[j] * win[t + j];
                  os[(8 * g + t) * 256 + ch] = acc; } } }
        LBAR();
        for (int t = wave; t < ntok; t += 8) {
            float v[4]; float sm = 0.f;
#pragma unroll
            for (int i = 0; i < 4; ++i) { v[i] = os[t * 256 + lane + 64 * i]; sm += v[i]; }
            const float mu = wave_sum(sm) * (1.0f / 256.0f); float q = 0.f;
#pragma unroll
            for (int i = 0; i < 4; ++i) { const float d = v[i] - mu; q += d * d; }
            const float rstd = rsqrtf(wave_sum(q) * (1.0f / 256.0f) + 1e-5f);
#pragma unroll
            for (int i = 0; i < 4; ++i) { const int ch = lane + 64 * i; const float y = (v[i] - mu) * rstd * lg[ch] + lb[ch]; MIX[(row0 + t) * 1024 + 768 + ch] = (bf16)f2bf(siluf_(y)); }
        }
        LBAR();
    }
}

__device__ __forceinline__ void g1_phase(const PP P, int l, LAS unsigned char* lds) {
    const int tid = P.tid, grp = tid >> 8, gt = tid & 255, G = P.G;
    const bf16* H = (const bf16*)(P.ws + WS_H);
    LAS float* qs = (LAS float*)(lds + grp * G1_GRP); LAS float* ks = qs + 64 * 65; LAS float* vs = ks + 64 * 65; LAS float* As = vs + 64 * 65;
    LAS float* Gs = As + 64 * 64; LAS float* bs = Gs + 64; LAS float* gs = bs + 64;
    const float* gcw = KIN(13) + (size_t)l * 4 * 768;
    const int rounds = (NGU + 2 * G - 1) / (2 * G);
    for (int it = 0; it < rounds; ++it) {
        const int u = (it * G + P.bid) * 2 + grp; const bool act = u < NGU;
        int b, h, ch, L; bool smp; size_t seq0;
        if (u < 2048) { const int bh = u >> 5; ch = u & 31; b = bh >> 2; h = bh & 3; L = 64; smp = false; seq0 = (size_t)b * 2048; }
        else { const int bh = u - 2048; b = bh >> 2; h = bh & 3; L = 16; smp = true; ch = 0; seq0 = (size_t)MP + b * 16; }
        unsigned char* ub = P.ws + WS_GSCR + (size_t)(act ? u : 0) * GUNIT;
        bf16* Wd = (bf16*)ub; bf16* QKd = (bf16*)(ub + 8192); bf16* KdT = (bf16*)(ub + 16384); bf16* QG = (bf16*)(ub + 24576); float* Uv = (float*)(ub + 32768);
#ifdef PROBE_SOLVE
        for (int pass_ = 0; pass_ < 2; ++pass_) {
#endif
        if (act) {
            if (gt < 192) { const int part = gt >> 6, cc = gt & 63, qcol = part * 256 + h * 64 + cc;
                const float w0 = gcw[qcol], w1 = gcw[768 + qcol], w2 = gcw[2 * 768 + qcol], w3 = gcw[3 * 768 + qcol];
                LAS float* dst = (part == 0 ? qs : (part == 1 ? ks : vs)) + cc;
                const bf16* hp = H + (seq0 + (size_t)ch * 64) * HLD + C_QKV + qcol;
                float x0 = 0.f, x1 = 0.f, x2 = 0.f;
                if (ch > 0) { x0 = bf2f(*(hp - 3 * HLD)); x1 = bf2f(*(hp - 2 * HLD)); x2 = bf2f(*(hp - HLD)); }
                else if (smp) { const float* sp = KIN(5) + (size_t)(l * 32 + b) * 3 * 768 + qcol; x0 = sp[0]; x1 = sp[768]; x2 = sp[2 * 768]; }
                const GAS1 bf16* pr = (const GAS1 bf16*)hp;
                if (L == 64) {
                  for (int tb = 0; tb < 64; tb += 32) { float xv[32];
#pragma unroll
                    for (int i = 0; i < 32; ++i) { xv[i] = bf2f(*pr); pr += HLD; asm volatile("" : "+v"(pr)); }
#pragma unroll
                    for (int i = 0; i < 32; ++i) { const float y = w0 * x0 + w1 * x1 + w2 * x2 + w3 * xv[i]; dst[(tb + i) * 65] = siluf_(y); x0 = x1; x1 = x2; x2 = xv[i]; } }
                } else { float xv[16];
#pragma unroll
                    for (int i = 0; i < 16; ++i) { xv[i] = bf2f(*pr); pr += HLD; asm volatile("" : "+v"(pr)); }
#pragma unroll
                    for (int i = 0; i < 16; ++i) { const float y = w0 * x0 + w1 * x1 + w2 * x2 + w3 * xv[i]; dst[i * 65] = siluf_(y); x0 = x1; x1 = x2; x2 = xv[i]; } }
                for (int t = L; t < 64; ++t) dst[t * 65] = 0.f;
            }
        }
        LBAR();
        if (act) {
            { const int rowid = gt >> 1, t = rowid & 63, part = rowid >> 6, half = gt & 1; LAS float* base = (part == 0 ? qs : ks) + t * 65 + half * 32; float ss = 0.f;
#pragma unroll
              for (int i = 0; i < 32; ++i) ss += base[i] * base[i];
              ss += dpp_f<0xB1>(ss); const float rinv = rsqrtf(ss + 1e-6f) * (part == 0 ? 0.125f : 1.0f);
#pragma unroll
              for (int i = 0; i < 32; ++i) base[i] *= rinv; }
            if (gt < 64) { const int t = gt; float beta = 0.f, g = 0.f;
                if (t < L) { const bf16* hr = H + (seq0 + (size_t)ch * 64 + t) * HLD; const float braw = bf2f(hr[C_B + h]), araw = bf2f(hr[C_A + h]);
                    beta = sigmoidf_(braw); const float x = araw + KIN(15)[l * 4 + h]; const float sp = x > 20.f ? x : __logf(1.0f + __expf(x)); g = -__expf(KIN(14)[l * 4 + h]) * sp; }
                bs[t] = beta; gs[t] = g; }
        }
        LBAR();
#ifdef PROBE_SOLVE
        if (pass_ == 0) {
#endif
        if (act && gt == 0) { float gg[64];
#pragma unroll
            for (int t = 0; t < 64; ++t) gg[t] = gs[t];
            float run = 0.f;
#pragma unroll
            for (int t = 0; t < 64; ++t) { run += gg[t]; Gs[t] = run; } }
        LBAR();
        if (act) {
            { const int mi = gt >> 6, ln = gt & 63, fr = ln & 15, fq = ln >> 4;
              bf16x8 ak[2], aq[2];
#pragma unroll
              for (int kk = 0; kk < 2; ++kk) { const LAS float* pk = ks + (16 * mi + fr) * 65 + 32 * kk + fq * 8; const LAS float* pq = qs + (16 * mi + fr) * 65 + 32 * kk + fq * 8;
                  u32x4 wk, wq; wk.x = pk2(pk[0], pk[1]); wk.y = pk2(pk[2], pk[3]); wk.z = pk2(pk[4], pk[5]); wk.w = pk2(pk[6], pk[7]);
                  wq.x = pk2(pq[0], pq[1]); wq.y = pk2(pq[2], pq[3]); wq.z = pk2(pq[4], pq[5]); wq.w = pk2(pq[6], pq[7]);
                  ak[kk] = __builtin_bit_cast(bf16x8, wk); aq[kk] = __builtin_bit_cast(bf16x8, wq); }
#pragma unroll
              for (int nj = 0; nj < 4; ++nj) { f32x4 ckk = {0.f, 0.f, 0.f, 0.f}, cqk = {0.f, 0.f, 0.f, 0.f};
                  if (nj <= mi && 16 * mi < L) {
#pragma unroll
                      for (int kk = 0; kk < 2; ++kk) { const LAS float* pb = ks + (16 * nj + fr) * 65 + 32 * kk + fq * 8;
                          u32x4 wb; wb.x = pk2(pb[0], pb[1]); wb.y = pk2(pb[2], pb[3]); wb.z = pk2(pb[4], pb[5]); wb.w = pk2(pb[6], pb[7]);
                          const bf16x8 bfr = __builtin_bit_cast(bf16x8, wb); ckk = mfma16(ak[kk], bfr, ckk); cqk = mfma16(aq[kk], bfr, cqk); } }
                  const int jc = 16 * nj + fr; const float gj = Gs[jc];
#pragma unroll
                  for (int j = 0; j < 4; ++j) { const int i = 16 * mi + fq * 4 + j; const float dec = (i >= jc) ? __expf(Gs[i] - gj) : 0.f;
                      As[i * 64 + jc] = (i > jc) ? bs[i] * ckk[j] * dec : 0.f; QKd[i * 64 + jc] = (bf16)f2bf(cqk[j] * dec); } } }
        }
        LBAR();
        if (act) {
            const float glast = Gs[63];
            for (int e = gt; e < 4096; e += 256) { const int hi = e >> 6, lo = e & 63;
                KdT[e] = (bf16)f2bf(ks[lo * 65 + hi] * __expf(glast - Gs[lo]));
                QG[e] = (bf16)f2bf(qs[hi * 65 + lo] * __expf(Gs[hi])); }
            if (gt == 0) *(float*)(ub + 49152) = __expf(glast);
        }
        LBAR();
#ifdef PROBE_SOLVE
        }
#endif
        if (act) {
            for (int e = gt; e < 8192; e += 256) { const int i = e >> 7, c = e & 127; LAS float* p = ((c < 64) ? ks : vs) + i * 65 + (c & 63);
                *p = *p * bs[i] * ((c < 64) ? __expf(Gs[i]) : 1.0f); }
        }
        LBAR();
#pragma unroll 1
        for (int R = 0; R < 4; ++R) {
            if (act && R > 0 && 16 * R < L) {
                const int wv = gt >> 6, ln = gt & 63, fr = ln & 15, fq = ln >> 4, nkk = (16 * R + 31) >> 5;
                bf16x8 af[2];
#pragma unroll
                for (int kk = 0; kk < 2; ++kk) { u32x4 w = {0u, 0u, 0u, 0u};
                    if (kk < nkk && 32 * kk + fq * 8 < 16 * R) { const LAS float* pa = As + (16 * R + fr) * 64 + 32 * kk + fq * 8; const f32x4 a0 = *(const LAS f32x4*)pa, a1 = *(const LAS f32x4*)(pa + 4);
                        w.x = pk2(a0[0], a0[1]); w.y = pk2(a0[2], a0[3]); w.z = pk2(a1[0], a1[1]); w.w = pk2(a1[2], a1[3]); }
                    af[kk] = __builtin_bit_cast(bf16x8, w); }
#pragma unroll
                for (int t = 0; t < 2; ++t) { const int nt = 2 * wv + t; LAS float* xb = ((nt < 4) ? ks : vs) + 16 * (nt & 3) + fr;
                    f32x4 acc = {0.f, 0.f, 0.f, 0.f};
#pragma unroll
                    for (int kk = 0; kk < 2; ++kk) if (kk < nkk) { const LAS float* pb = xb + (32 * kk + fq * 8) * 65;
                        u32x4 w; w.x = pk2(pb[0], pb[65]); w.y = pk2(pb[130], pb[195]); w.z = pk2(pb[260], pb[325]); w.w = pk2(pb[390], pb[455]);
                        acc = mfma16(af[kk], __builtin_bit_cast(bf16x8, w), acc); }
#pragma unroll
                    for (int j = 0; j < 4; ++j) xb[(16 * R + fq * 4 + j) * 65] -= acc[j]; }
            }
            LBAR();
            if (act && gt < 128) { const int c = gt; LAS float* col = ((c < 64) ? ks : vs) + (c & 63) + (16 * R) * 65; const LAS float* Dg = As + (16 * R) * 64 + 16 * R;
                float x[16];
                if (16 * R >= L) {
#pragma unroll
                    for (int a = 0; a < 16; ++a) x[a] = 0.f;
                } else {
#pragma unroll
                for (int a = 0; a < 16; ++a) { float v = col[a * 65];
                    f32x4 d[4];
#pragma unroll
                    for (int q4 = 0; q4 < 4; ++q4) if (4 * q4 < a) d[q4] = *(const LAS f32x4*)(Dg + a * 64 + 4 * q4);
#pragma unroll
                    for (int q = 0; q < a; ++q) v -= d[q >> 2][q & 3] * x[q];
                    x[a] = v; if ((a & 3) == 3) __builtin_amdgcn_sched_barrier(0); } }
#pragma unroll
                for (int a = 0; a < 16; ++a) { col[a * 65] = x[a];
                    if (c < 64) Wd[(16 * R + a) * 64 + c] = (bf16)f2bf(x[a]); else Uv[(16 * R + a) * 64 + (c - 64)] = x[a]; }
            }
            LBAR();
        }
#ifdef PROBE_SOLVE
        }
#endif
    }
}

__device__ __forceinline__ bf16x8 ldA2(const bf16* Mx, int row, int kk, int fq) {
    const bf16* p = Mx + row * 64 + 32 * kk + fq * 4; const s16x4 a = *(const s16x4*)p, b = *(const s16x4*)(p + 16);
    bf16x8 r; r[0] = a[0]; r[1] = a[1]; r[2] = a[2]; r[3] = a[3]; r[4] = b[0]; r[5] = b[1]; r[6] = b[2]; r[7] = b[3]; return r;
}
__device__ __forceinline__ void split8(const f32x4& lo4, const f32x4& hi4, bf16x8& h, bf16x8& lw) {
    u32x4 hw; hw.x = pk2(lo4[0], lo4[1]); hw.y = pk2(lo4[2], lo4[3]); hw.z = pk2(hi4[0], hi4[1]); hw.w = pk2(hi4[2], hi4[3]);
    h = __builtin_bit_cast(bf16x8, hw);
    if (GDN_SPLIT) {
        u32x4 lo; lo.x = pk2(lo4[0] - bf2f(hw.x & 0xffffu), lo4[1] - __builtin_bit_cast(float, hw.x & 0xffff0000u)); lo.y = pk2(lo4[2] - bf2f(hw.y & 0xffffu), lo4[3] - __builtin_bit_cast(float, hw.y & 0xffff0000u));
        lo.z = pk2(hi4[0] - bf2f(hw.z & 0xffffu), hi4[1] - __builtin_bit_cast(float, hw.z & 0xffff0000u)); lo.w = pk2(hi4[2] - bf2f(hw.w & 0xffffu), hi4[3] - __builtin_bit_cast(float, hw.w & 0xffff0000u));
        lw = __builtin_bit_cast(bf16x8, lo);
    } else lw = h;
}
constexpr int G2_MAT = 9216, G2_UV = 4 * G2_MAT, G2_Z = G2_UV + 64 * 272, G2_GAM = G2_Z + 9216, G2_BUF = G2_GAM + 16, G2_RED = 2 * G2_BUF;
static_assert(G2_RED + 2048 <= LDS_BYTES, "g2 lds");
__device__ __forceinline__ bf16x8 ldA2s(const LAS unsigned char* mat, int row, int kk, int fq) {
    const LAS unsigned char* p = mat + row * 144 + 64 * kk + fq * 8; const s16x4 a = *(const LAS s16x4*)p, b = *(const LAS s16x4*)(p + 32);
    bf16x8 r; r[0] = a[0]; r[1] = a[1]; r[2] = a[2]; r[3] = a[3]; r[4] = b[0]; r[5] = b[1]; r[6] = b[2]; r[7] = b[3]; return r;
}
__device__ __forceinline__ void g2_stage(LAS unsigned char* buf, const unsigned char* ub, const bf16* zsrc  , int ht, int nthr) {
    for (int c = ht; c < 2048; c += nthr) { const int mat = c >> 9, w = c & 511, row = w >> 3, seg = w & 7;
        *(LAS u32x4*)(buf + mat * G2_MAT + row * 144 + seg * 16) = *(const u32x4*)(ub + mat * 8192 + row * 128 + seg * 16); }
    for (int c = ht; c < 1024; c += nthr) { const int row = c >> 4, seg = c & 15;
        *(LAS u32x4*)(buf + G2_UV + row * 272 + seg * 16) = *(const u32x4*)(ub + 32768 + row * 256 + seg * 16); }
    for (int c = ht; c < 512; c += nthr) { const int row = c >> 3, seg = c & 7;
        *(LAS u32x4*)(buf + G2_Z + row * 144 + seg * 16) = *(const u32x4*)((const unsigned char*)(zsrc + (size_t)row * HLD) + seg * 16); }
    if (ht == 0) *(LAS float*)(buf + G2_GAM) = *(const float*)(ub + 49152);
}
__device__ __forceinline__ void g2_load(u32x4 (&r)[14], float& gam, const unsigned char* ub, const bf16* zsrc, int ht) {
    const unsigned go = 16u * ht, gz = (ht >> 3) * (HLD * 2) + (ht & 7) * 16;
#pragma unroll
    for (int i = 0; i < 8; ++i) r[i] = *(const u32x4*)(ub + i * 4096 + go);
#pragma unroll
    for (int i = 0; i < 4; ++i) r[8 + i] = *(const u32x4*)(ub + 32768 + i * 4096 + go);
#pragma unroll
    for (int i = 0; i < 2; ++i) r[12 + i] = *(const u32x4*)((const unsigned char*)zsrc + (size_t)i * 32 * HLD * 2 + gz);
    gam = *(const float*)(ub + 49152);
}
__device__ __forceinline__ void g2_store(LAS unsigned char* buf, const u32x4 (&r)[14], float gam, int ht) {
    LAS unsigned char* lm = buf + (ht >> 3) * 144 + (ht & 7) * 16; LAS unsigned char* lu = buf + G2_UV + (ht >> 4) * 272 + (ht & 15) * 16;
#pragma unroll
    for (int i = 0; i < 8; ++i) *(LAS u32x4*)(lm + (i >> 1) * G2_MAT + (i & 1) * 32 * 144) = r[i];
#pragma unroll
    for (int i = 0; i < 4; ++i) *(LAS u32x4*)(lu + i * 16 * 272) = r[8 + i];
#pragma unroll
    for (int i = 0; i < 2; ++i) *(LAS u32x4*)(lm + G2_Z + i * 32 * 144) = r[12 + i];
    if (ht == 0) *(LAS float*)(buf + G2_GAM) = gam;
}
#define G2_BAR() asm volatile("s_waitcnt lgkmcnt(0)\n\ts_barrier" ::: "memory")
__device__ __forceinline__ void g2_phase(const PP P, int l, LAS unsigned char* lds) {
    const int tid = P.tid, lane = tid & 63, wave = tid >> 6, fr = lane & 15, fq = lane >> 4, G = P.G;
    LAS float* red = (LAS float*)(lds + G2_RED);
    const bf16* H = (const bf16*)(P.ws + WS_H); bf16* MIX = (bf16*)(P.ws + WS_MIX);
    for (int u = P.bid; u < 192; u += G) {
        const bool smp = u >= 64; const int bh = smp ? u - 64 : u, b = bh >> 2, h = bh & 3, nch = smp ? 1 : 32, L = smp ? 16 : 64;
        const size_t seq0 = smp ? (size_t)MP + b * 16 : (size_t)b * 2048; const int gu0 = smp ? 2048 + bh : bh * 32;
        const bool act = wave < 4; const int dv = 16 * (wave & 3) + fr;
        const unsigned char* gs0 = P.ws + WS_GSCR + (size_t)gu0 * GUNIT; const bf16* z0 = H + seq0 * HLD + C_Z + h * 64;
        f32x4 S[4];
#pragma unroll
        for (int m = 0; m < 4; ++m)
#pragma unroll
            for (int j = 0; j < 4; ++j) S[m][j] = (smp && act) ? KIN(4)[(((size_t)(l * 32 + b) * 4 + h) * 64 + (16 * m + fq * 4 + j)) * 64 + dv] : 0.f;
        const float gnw = KIN(16)[l * 64 + dv];
        g2_stage(lds, gs0, z0, tid, 512);
        u32x4 hr_[14]; float hgam = 0.f;
#pragma unroll
        for (int i = 0; i < 14; ++i) hr_[i] = (u32x4){0u, 0u, 0u, 0u};
        if (!act && nch > 1) g2_load(hr_, hgam, gs0 + GUNIT, z0 + (size_t)64 * HLD, tid - 256);
        G2_BAR();
        for (int n = 0; n < nch; ++n) {
            LAS unsigned char* buf = lds + (n & 1) * G2_BUF;
            f32x4 O[4]; float zr[4][4];
            if (!act) {
                if (n + 1 < nch) g2_store(lds + ((n + 1) & 1) * G2_BUF, hr_, hgam, tid - 256);
                if (n + 2 < nch) g2_load(hr_, hgam, gs0 + (size_t)(n + 2) * GUNIT, z0 + (size_t)(n + 2) * 64 * HLD, tid - 256);
            } else {
                bf16x8 Sh[2], Sl[2]; split8(S[0], S[1], Sh[0], Sl[0]); split8(S[2], S[3], Sh[1], Sl[1]);
                f32x4 U[4];
#pragma unroll
                for (int mi = 0; mi < 4; ++mi) { f32x4 acc = {0.f, 0.f, 0.f, 0.f};
#pragma unroll
                    for (int kk = 0; kk < 2; ++kk) { const bf16x8 a = ldA2s(buf, 16 * mi + fr, kk, fq); acc = mfma16(a, Sh[kk], acc); if (GDN_SPLIT) acc = mfma16(a, Sl[kk], acc); }
#pragma unroll
                    for (int j = 0; j < 4; ++j) { const int i = 16 * mi + fq * 4 + j; U[mi][j] = *(const LAS float*)(buf + G2_UV + i * 272 + dv * 4) - acc[j];
                        zr[mi][j] = bf2f(*(const LAS bf16*)(buf + G2_Z + i * 144 + dv * 2)); } }
                bf16x8 Uh[2], Ul[2]; split8(U[0], U[1], Uh[0], Ul[0]); split8(U[2], U[3], Uh[1], Ul[1]);
#pragma unroll
                for (int mi = 0; mi < 4; ++mi) { f32x4 acc = {0.f, 0.f, 0.f, 0.f};
#pragma unroll
                    for (int kk = 0; kk < 2; ++kk) { const bf16x8 a = ldA2s(buf + 3 * G2_MAT, 16 * mi + fr, kk, fq); acc = mfma16(a, Sh[kk], acc); if (GDN_SPLIT) acc = mfma16(a, Sl[kk], acc);
                        const bf16x8 a2 = ldA2s(buf + G2_MAT, 16 * mi + fr, kk, fq); acc = mfma16(a2, Uh[kk], acc); if (GDN_SPLIT) acc = mfma16(a2, Ul[kk], acc); }
                    O[mi] = acc; }
                const float gamL = *(const LAS float*)(buf + G2_GAM);
#pragma unroll
                for (int m = 0; m < 4; ++m) { f32x4 acc = S[m] * gamL;
#pragma unroll
                    for (int kk = 0; kk < 2; ++kk) { const bf16x8 a = ldA2s(buf + 2 * G2_MAT, 16 * m + fr, kk, fq); acc = mfma16(a, Uh[kk], acc); if (GDN_SPLIT) acc = mfma16(a, Ul[kk], acc); }
                    S[m] = acc; }
#pragma unroll
                for (int mi = 0; mi < 4; ++mi)
#pragma unroll
                    for (int j = 0; j < 4; ++j) { const float s = row16_sum(O[mi][j] * O[mi][j]);
                        if (fr == 0) red[(n & 1) * 256 + wave * 64 + 16 * mi + fq * 4 + j] = s; }
            }
            G2_BAR();
            if (act) {
#pragma unroll
                for (int mi = 0; mi < 4; ++mi)
#pragma unroll
                    for (int j = 0; j < 4; ++j) { const int i = 16 * mi + fq * 4 + j; LAS float* rp = red + (n & 1) * 256 + i;
                        const float tot = rp[0] + rp[64] + rp[128] + rp[192]; const float rinv = rsqrtf(tot * (1.0f / 64.0f) + 1e-6f);
                        if (i < L) { const size_t row = seq0 + (size_t)n * 64 + i;
                            MIX[row * 1024 + 512 + h * 64 + dv] = (bf16)f2bf(O[mi][j] * rinv * gnw * siluf_(zr[mi][j])); } }
            }
        }
        if (act) { float* so = smp ? P.out + O_GDNS + ((size_t)(l * 32 + b) * 4 + h) * 4096 : P.out + O_GDNP + ((size_t)(l * 16 + b) * 4 + h) * 4096;
#pragma unroll
            for (int m = 0; m < 4; ++m)
#pragma unroll
                for (int j = 0; j < 4; ++j) so[(16 * m + fq * 4 + j) * 64 + dv] = S[m][j]; }
        __syncthreads();
    }
}

constexpr int AT_KROW = 208, AT_VROW = 144, AT_V = 64 * AT_KROW, AT_STAGE = AT_V + 64 * AT_VROW, AT_COMB = 2 * AT_STAGE;
static_assert(AT_COMB + 8 * 64 * 18 * 4 <= LDS_BYTES, "attn lds");
__device__ __forceinline__ void attn_prompt_unit(const PP P, LAS unsigned char* lds, int b, int h, int qt) {
    const int tid = P.tid, lane = tid & 63, wave = tid >> 6, fr = lane & 15, fq = lane >> 4;
    const bf16* Q = (const bf16*)(P.ws + WS_XB); const bf16* KN = (const bf16*)(P.ws + WS_KN); const bf16* VT = (const bf16*)(P.ws + WS_VT);
    const bf16* KPEB = (const bf16*)(P.ws + WS_KPEB); bf16* MIX = (bf16*)(P.ws + WS_MIX);
    const int qrow0 = b * 2048 + 256 * qt + 32 * wave, keybase = b * 2048;
    const int nt_blk = 4 * qt + 4, nt_w = 4 * qt + (wave >> 1) + 1;
    bf16x8 Qb[2][3];
#pragma unroll
    for (int g = 0; g < 2; ++g)
#pragma unroll
        for (int ks = 0; ks < 3; ++ks) Qb[g][ks] = *(const bf16x8*)(Q + (size_t)(qrow0 + 16 * g + fr) * 768 + h * 96 + 32 * ks + fq * 8);
    float m[2] = {-INFINITY, -INFINITY}, lsum[2] = {0.f, 0.f}; f32x4 O[2][4];
#pragma unroll
    for (int g = 0; g < 2; ++g)
#pragma unroll
        for (int nt = 0; nt < 4; ++nt) O[g][nt] = (f32x4){0.f, 0.f, 0.f, 0.f};
    const int r8 = tid >> 3, s8 = tid & 7, r4 = (tid & 255) >> 2, s4 = tid & 3;
    const bf16* gk = KN + (size_t)(keybase + r8) * 512 + h * 64 + s8 * 8;
    const bf16* gp = KPEB + (size_t)(keybase + r4) * 32 + s4 * 8;
    const bf16* gv = VT + (size_t)(h * 64 + r8) * NK + keybase + s8 * 8;
    const int lk = r8 * AT_KROW + s8 * 16, lp = r4 * AT_KROW + 128 + s4 * 16, lv = AT_V + r8 * AT_VROW + s8 * 16;
    u32x4 rk = *(const u32x4*)gk, rv = *(const u32x4*)gv, rp = {0u, 0u, 0u, 0u}; if (tid < 256) rp = *(const u32x4*)gp;
    *(LAS u32x4*)(lds + lk) = rk; *(LAS u32x4*)(lds + lv) = rv; if (tid < 256) *(LAS u32x4*)(lds + lp) = rp;
    __syncthreads();
    for (int kt = 0; kt < nt_blk; ++kt) {
        const bool more = kt + 1 < nt_blk;
        if (more) { rk = *(const u32x4*)(gk + (size_t)(kt + 1) * 64 * 512); rv = *(const u32x4*)(gv + (kt + 1) * 64); if (tid < 256) rp = *(const u32x4*)(gp + (size_t)(kt + 1) * 64 * 32); }
        if (kt < nt_w) {
            const LAS unsigned char* kb = lds + (kt & 1) * AT_STAGE; const LAS unsigned char* vb = kb + AT_V;
            f32x4 s[2][4];
            __builtin_amdgcn_s_setprio(1);
#pragma unroll
            for (int sb = 0; sb < 4; ++sb) { s[0][sb] = (f32x4){0.f, 0.f, 0.f, 0.f}; s[1][sb] = (f32x4){0.f, 0.f, 0.f, 0.f};
#pragma unroll
                for (int ks = 0; ks < 3; ++ks) { const bf16x8 kf = *(const LAS bf16x8*)(kb + (16 * sb + fr) * AT_KROW + ks * 64 + fq * 16);
                    s[0][sb] = mfma16(kf, Qb[0][ks], s[0][sb]); s[1][sb] = mfma16(kf, Qb[1][ks], s[1][sb]); } }
            __builtin_amdgcn_s_setprio(0);
            bf16x8 Pb[2][2];
#pragma unroll
            for (int g = 0; g < 2; ++g) {
                float mx = -INFINITY;
#pragma unroll
                for (int sb = 0; sb < 4; ++sb) mx = fmaxf(mx, fmaxf(fmaxf(s[g][sb][0], s[g][sb][1]), fmaxf(s[g][sb][2], s[g][sb][3])));
                mx = fmaxf(mx, xor16_get(mx)); mx = xor32_max(mx);
                const bool resc = __builtin_amdgcn_ballot_w64(mx - m[g] > 6.0f) != 0ull;
                if (resc) { const float mnew = fmaxf(m[g], mx), alpha = __builtin_amdgcn_exp2f(m[g] - mnew); m[g] = mnew; lsum[g] *= alpha;
#pragma unroll
                    for (int nt = 0; nt < 4; ++nt) O[g][nt] = O[g][nt] * alpha; }
                const float mref = m[g];
                float ps = 0.f; float p[4][4];
#pragma unroll
                for (int sb = 0; sb < 4; ++sb)
#pragma unroll
                    for (int j = 0; j < 4; ++j) { p[sb][j] = __builtin_amdgcn_exp2f(s[g][sb][j] - mref); ps += p[sb][j]; }
                lsum[g] += ps;
#pragma unroll
                for (int kk = 0; kk < 2; ++kk) { u32x4 pw; pw.x = pk2(p[2 * kk][0], p[2 * kk][1]); pw.y = pk2(p[2 * kk][2], p[2 * kk][3]); pw.z = pk2(p[2 * kk + 1][0], p[2 * kk + 1][1]); pw.w = pk2(p[2 * kk + 1][2], p[2 * kk + 1][3]);
                    Pb[g][kk] = __builtin_bit_cast(bf16x8, pw); }
            }
            __builtin_amdgcn_s_setprio(1);
#pragma unroll
            for (int nt = 0; nt < 4; ++nt)
#pragma unroll
                for (int kk = 0; kk < 2; ++kk) { const LAS unsigned char* vp = vb + (16 * nt + fr) * AT_VROW + kk * 64 + fq * 8;
                    const s16x4 a = *(const LAS s16x4*)vp, c = *(const LAS s16x4*)(vp + 32);
                    bf16x8 vf; vf[0] = a[0]; vf[1] = a[1]; vf[2] = a[2]; vf[3] = a[3]; vf[4] = c[0]; vf[5] = c[1]; vf[6] = c[2]; vf[7] = c[3];
                    O[0][nt] = mfma16(vf, Pb[0][kk], O[0][nt]); O[1][nt] = mfma16(vf, Pb[1][kk], O[1][nt]); }
            __builtin_amdgcn_s_setprio(0);
        }
        if (more) { LAS unsigned char* nb = lds + ((kt + 1) & 1) * AT_STAGE; *(LAS u32x4*)(nb + lk) = rk; *(LAS u32x4*)(nb + lv) = rv; if (tid < 256) *(LAS u32x4*)(nb + lp) = rp; }
        __syncthreads();
    }
#pragma unroll
    for (int g = 0; g < 2; ++g) { float lt = lsum[g]; lt += xor16_get(lt); lt = xor32_sum(lt); const float inv = 1.0f / lt;
#pragma unroll
        for (int nt = 0; nt < 4; ++nt) { u32x2 w; w.x = pk2(O[g][nt][0] * inv, O[g][nt][1] * inv); w.y = pk2(O[g][nt][2] * inv, O[g][nt][3] * inv);
            *(u32x2*)(MIX + (size_t)(qrow0 + 16 * g + fr) * 1024 + h * 64 + 16 * nt + fq * 4) = w; } }
}
__device__ __forceinline__ void attn_sample_unit(const PP P, LAS unsigned char* lds, int b, int h) {
    const int tid = P.tid, lane = tid & 63, wave = tid >> 6, fr = lane & 15, fq = lane >> 4;
    const bf16* Q = (const bf16*)(P.ws + WS_XB); const bf16* KN = (const bf16*)(P.ws + WS_KN); const bf16* VT = (const bf16*)(P.ws + WS_VT);
    const bf16* KPEB = (const bf16*)(P.ws + WS_KPEB); bf16* MIX = (bf16*)(P.ws + WS_MIX);
    const int qrow0 = MP + b * 16, keybase = MP, nkeys = SKS;
    const bf16* qp = Q + (size_t)(qrow0 + fr) * 768 + h * 96 + fq * 8;
    bf16x8 Qb[3];
#pragma unroll
    for (int ks = 0; ks < 3; ++ks) Qb[ks] = *(const bf16x8*)(qp + 32 * ks);
    float m = -INFINITY, lsum = 0.f; f32x4 O[4];
#pragma unroll
    for (int nt = 0; nt < 4; ++nt) O[nt] = (f32x4){0.f, 0.f, 0.f, 0.f};
    const int nblk = (nkeys + 31) >> 5, kb0 = (wave * nblk) >> 3, kb1 = ((wave + 1) * nblk) >> 3;
    for (int kb = kb0; kb < kb1; ++kb) {
        f32x4 s[2]; int kof[2];
#pragma unroll
        for (int sub = 0; sub < 2; ++sub) { const int key0 = kb * 32 + sub * 16; const bool valid = key0 < nkeys; kof[sub] = (valid && key0 >= 2048) ? 65536 + b * 16 + (key0 - 2048) : b * 2048 + (valid ? key0 : 0);
            const size_t kr = (size_t)keybase + kof[sub] + fr;
            const bf16x8 a0 = *(const bf16x8*)(KN + kr * 512 + h * 64 + fq * 8), a1 = *(const bf16x8*)(KN + kr * 512 + h * 64 + 32 + fq * 8), a2 = *(const bf16x8*)(KPEB + kr * 32 + fq * 8);
            f32x4 acc = {0.f, 0.f, 0.f, 0.f}; acc = mfma16(a0, Qb[0], acc); acc = mfma16(a1, Qb[1], acc); acc = mfma16(a2, Qb[2], acc);
            if (!valid) acc = (f32x4){-INFINITY, -INFINITY, -INFINITY, -INFINITY};
            s[sub] = acc; }
        float mx = fmaxf(fmaxf(fmaxf(s[0][0], s[0][1]), fmaxf(s[0][2], s[0][3])), fmaxf(fmaxf(s[1][0], s[1][1]), fmaxf(s[1][2], s[1][3])));
        mx = fmaxf(mx, xor16_get(mx)); mx = xor32_max(mx);
        const float mnew = fmaxf(m, mx); const float alpha = __builtin_amdgcn_exp2f(m - mnew); m = mnew;
        float p[8]; float ps = 0.f;
#pragma unroll
        for (int j = 0; j < 4; ++j) { p[j] = __builtin_amdgcn_exp2f(s[0][j] - mnew); p[4 + j] = __builtin_amdgcn_exp2f(s[1][j] - mnew); ps += p[j] + p[4 + j]; }
        lsum = lsum * alpha + ps;
        u32x4 pw; pw.x = pk2(p[0], p[1]); pw.y = pk2(p[2], p[3]); pw.z = pk2(p[4], p[5]); pw.w = pk2(p[6], p[7]);
        const bf16x8 Pb = __builtin_bit_cast(bf16x8, pw);
#pragma unroll
        for (int nt = 0; nt < 4; ++nt) { const bf16* vrow = VT + (size_t)(h * 64 + 16 * nt + fr) * NK + keybase + fq * 4;
            const s16x4 a = *(const s16x4*)(vrow + kof[0]), c = *(const s16x4*)(vrow + kof[1]);
            bf16x8 va; va[0] = a[0]; va[1] = a[1]; va[2] = a[2]; va[3] = a[3]; va[4] = c[0]; va[5] = c[1]; va[6] = c[2]; va[7] = c[3];
            O[nt] = mfma16(va, Pb, O[nt] * alpha); }
    }
    float lt = lsum; lt += xor16_get(lt); lt = xor32_sum(lt);
    LAS float* cb = (LAS float*)(lds + AT_COMB) + (wave * 64 + lane) * 18;
#pragma unroll
    for (int nt = 0; nt < 4; ++nt)
#pragma unroll
        for (int j = 0; j < 4; ++j) cb[nt * 4 + j] = O[nt][j];
    cb[16] = m; cb[17] = lt;
    __syncthreads();
    if (wave == 0) {
        float mm = -INFINITY;
#pragma unroll
        for (int w = 0; w < 8; ++w) mm = fmaxf(mm, ((LAS float*)(lds + AT_COMB))[(w * 64 + lane) * 18 + 16]);
        float L = 0.f; float acc[16];
#pragma unroll
        for (int i = 0; i < 16; ++i) acc[i] = 0.f;
#pragma unroll
        for (int w = 0; w < 8; ++w) { const LAS float* pp = (LAS float*)(lds + AT_COMB) + (w * 64 + lane) * 18; const float sc = __builtin_amdgcn_exp2f(pp[16] - mm); L += pp[17] * sc;
#pragma unroll
            for (int i = 0; i < 16; ++i) acc[i] += pp[i] * sc; }
        const float inv = 1.0f / L;
#pragma unroll
        for (int nt = 0; nt < 4; ++nt) { u32x2 w; w.x = pk2(acc[nt * 4] * inv, acc[nt * 4 + 1] * inv); w.y = pk2(acc[nt * 4 + 2] * inv, acc[nt * 4 + 3] * inv);
            *(u32x2*)(MIX + (size_t)(qrow0 + fr) * 1024 + h * 64 + 16 * nt + fq * 4) = w; }
    }
    __syncthreads();
}
__device__ __forceinline__ void attn_phase(const PP P, LAS unsigned char* lds) {
    const int G = P.G;
    for (int u = P.bid; u < 256 + 1024; u += G) {
        if (u < 256) { attn_sample_unit(P, lds, u >> 3, u & 7); }
        else { const int v = u - 256, bh = v & 127, half = (v >> 7) & 1, k = v >> 8;
            const int qt = (k == 0) ? 7 - half : (k == 1) ? half : (k == 2) ? 5 - half : 2 + half;
            attn_prompt_unit(P, lds, bh >> 3, bh & 7, qt); }
    }
}

__device__ __forceinline__ void ln_phase(const PP P, const float* g, const float* bta) {
    const int tid = P.tid, lane = tid & 63, wave = tid >> 6, G = P.G;
    float* X = P.out; bf16* XB = (bf16*)(P.ws + WS_XB);
    for (int row = P.bid * 8 + wave; row < MT; row += G * 8) {
        float* p = X + (size_t)row * 1024; f32x4 v[4]; float s = 0.f;
#pragma unroll
        for (int i = 0; i < 4; ++i) { v[i] = *(const f32x4*)(p + 256 * i + lane * 4); s += (v[i][0] + v[i][1]) + (v[i][2] + v[i][3]); }
        const float mu = wave_sum(s) * (1.0f / 1024.0f); float q = 0.f;
#pragma unroll
        for (int i = 0; i < 4; ++i) { const f32x4 d = v[i] - mu; q += (d[0] * d[0] + d[1] * d[1]) + (d[2] * d[2] + d[3] * d[3]); }
        const float rstd = rsqrtf(wave_sum(q) * (1.0f / 1024.0f) + 1e-5f);
#pragma unroll
        for (int i = 0; i < 4; ++i) { const int col = 256 * i + lane * 4; const f32x4 gg = *(const f32x4*)(g + col), bb = *(const f32x4*)(bta + col);
            const f32x4 y = (v[i] - mu) * rstd * gg + bb; *(f32x4*)(p + col) = y;
            u32x2 w; w.x = pk2(y[0], y[1]); w.y = pk2(y[2], y[3]); *(u32x2*)(XB + (size_t)row * 1024 + col) = w; }
    }
}

__device__ __forceinline__ void sample_gemm_res(const PP P, LAS unsigned char* lds, const bf16* A  , const bf16* Bt, int K, const float* xin  , float* Xs  ) {
    const int tid = P.tid, lane = tid & 63, wave = tid >> 6, fr = lane & 15, fq = lane >> 4;
    LAS float* part = (LAS float*)lds;
    for (int t = P.bid; t < 256; t += P.G) {
        const int r0 = (t >> 4) * 32, c0 = (t & 15) * 64, kw = K >> 3, kb = wave * kw;
        f32x4 acc[2][4];
#pragma unroll
        for (int a = 0; a < 2; ++a)
#pragma unroll
            for (int n = 0; n < 4; ++n) acc[a][n] = (f32x4){0.f, 0.f, 0.f, 0.f};
        const bf16* ap = A + (size_t)(r0 + fr) * K + kb + fq * 8; const bf16* bp = Bt + (size_t)(c0 + fr) * K + kb + fq * 8;
#pragma unroll 2
        for (int k0 = 0; k0 < kw; k0 += 32) {
            bf16x8 af[2], bf_[4];
#pragma unroll
            for (int a = 0; a < 2; ++a) af[a] = *(const bf16x8*)(ap + (size_t)(16 * a) * K + k0);
#pragma unroll
            for (int n = 0; n < 4; ++n) bf_[n] = *(const bf16x8*)(bp + (size_t)(16 * n) * K + k0);
#pragma unroll
            for (int a = 0; a < 2; ++a)
#pragma unroll
                for (int n = 0; n < 4; ++n) acc[a][n] = mfma16(af[a], bf_[n], acc[a][n]);
        }
        LAS float* mp = part + (wave * 64 + lane) * 33;
#pragma unroll
        for (int a = 0; a < 2; ++a)
#pragma unroll
            for (int n = 0; n < 4; ++n)
#pragma unroll
                for (int j = 0; j < 4; ++j) mp[(a * 4 + n) * 4 + j] = acc[a][n][j];
        __syncthreads();
        { const int grp = wave;
          float sum[4] = {0.f, 0.f, 0.f, 0.f};
#pragma unroll
          for (int w = 0; w < 8; ++w)
#pragma unroll
              for (int j = 0; j < 4; ++j) sum[j] += part[(w * 64 + lane) * 33 + 4 * grp + j];
          const int a = grp >> 2, n = grp & 3, col = c0 + 16 * n + fr;
#pragma unroll
          for (int j = 0; j < 4; ++j) { const int row = r0 + 16 * a + fq * 4 + j; Xs[(size_t)row * 1024 + col] = DN_ALPHA * xin[(size_t)row * 1024 + col] + sum[j]; } }
        __syncthreads();
    }
}

#define GB_LD(p) __hip_atomic_load((p), __ATOMIC_RELAXED, __HIP_MEMORY_SCOPE_AGENT)
#define GB_ADD(p) __hip_atomic_fetch_add((p), 1u, __ATOMIC_RELAXED, __HIP_MEMORY_SCOPE_AGENT)
#define GB_ST(p, v) __hip_atomic_store((p), (v), __ATOMIC_RELAXED, __HIP_MEMORY_SCOPE_AGENT)
__device__ __forceinline__ void fast_grid_bar(unsigned* bar, unsigned k  , int tid, int bid, int G) {
    asm volatile("s_waitcnt vmcnt(0)" ::: "memory");
    __syncthreads();
    if (tid == 0) {
        const unsigned ng = (G < 8) ? (unsigned)G : 8u, g = (unsigned)bid % ng, gsize = ((unsigned)G - g + ng - 1u) / ng;
        unsigned* sub = bar + 64 * g; unsigned* gen = bar + 64 * (8 + g); unsigned* top = bar + 64 * 16; unsigned* topgen = bar + 64 * 17;
        __builtin_amdgcn_fence(__ATOMIC_RELEASE, "agent");
        asm volatile("s_waitcnt vmcnt(0)" ::: "memory");
        const unsigned old = GB_ADD(sub); unsigned sp = 0;
        if (old + 1u == k * gsize) { const unsigned o2 = GB_ADD(top); if (o2 + 1u == k * ng) GB_ST(topgen, k); }
        while (GB_LD(topgen) < k) { __builtin_amdgcn_s_sleep(1); if (++sp > (1u << 24)) break; }
        __builtin_amdgcn_fence(__ATOMIC_ACQUIRE, "agent");
        asm volatile("s_waitcnt vmcnt(0)" ::: "memory");
    }
    __syncthreads();
}

__global__ void __launch_bounds__(512) mega(Params P) {
    extern __shared__ __attribute__((aligned(16))) unsigned char lds_raw[];
    LAS unsigned char* lds = (LAS unsigned char*)lds_raw;
    cg::grid_group grid = cg::this_grid();
    const int lo_ = P.lo, hi_ = P.hi; const int wave_s = __builtin_amdgcn_readfirstlane((int)(threadIdx.x >> 6));
    for (int step = lo_; step < hi_; ++step) {
        PP pp; pp.ws = KWS(); pp.out = KOUT(); unsigned char* ws = pp.ws;
        { int t_, b_ = blockIdx.x, g_ = gridDim.x; asm volatile("v_mbcnt_lo_u32_b32 %0, -1, 0\n\tv_mbcnt_hi_u32_b32 %0, -1, %0\n\tv_lshl_add_u32 %0, %3, 6, %0" : "=&v"(t_), "+s"(b_), "+s"(g_) : "s"(wave_s)); pp.tid = t_; pp.bid = b_; pp.G = g_; }
        int l = 0, kind = 0;
        if (REPK == 0) { if (step > 0) { l = (step - 1) / 10; kind = 1 + (step - 1) % 10; } }
        else if (step > 0) { l = (step - 1) / 11; const int kidx = (step - 1) % 11; kind = (kidx < REPK) ? kidx + 1 : kidx; if (kind == 6 && l == 1 && kidx == REPK) kind = 11; }
        const bf16* WB = (const bf16*)(ws + WS_W) + (size_t)l * W_LAYER;
        int nj = 0;
        PP pp2 = pp; const bool split = pp.G > 64; if (split) { pp2.bid = pp.bid - 64; pp2.G = pp.G - 64; }
        const bool shadow = !split || pp.bid >= 64;
        switch (kind) {
            case 0: prep_phase(pp, lds, 0, true); break;
            case 2: tok_phase(pp, l); g1_phase(pp, l, lds); break;
            case 3: g2_phase(pp, l, lds);
                     if (shadow) { conv_phase(pp2, l, lds); cache_phase(pp2, l); if (l == 0) prep_phase(pp2, lds, 1, false); nj = 1; }
                     break;
            case 5: attn_phase(pp, lds); break;
            case 7: ln_phase(pp, KIN(22) + l * 1024, KIN(23) + l * 1024); break;
            case 10: ln_phase(pp, KIN(27) + l * 1024, KIN(28) + l * 1024); break;
            case 4: nj = 3; break;
            case 11: break;
            default: nj = 1; break;
        }
        if (kind == 6 || kind == 9) {
            const float* xs_ = (kind == 6 && l == 0) ? KIN(1) : pp.out + (size_t)MP * 1024;
            if (kind == 6) sample_gemm_res(pp, lds, (const bf16*)(ws + WS_MIX) + (size_t)MP * 1024, WB + W_OUT, 1024, xs_, pp.out + (size_t)MP * 1024);
            else           sample_gemm_res(pp, lds, (const bf16*)(ws + WS_F) + (size_t)MP * DFF, WB + W_DN, DFF, xs_, pp.out + (size_t)MP * 1024);
        }
        for (int j = 0; j < nj; ++j) {
            pg8::Gemm g; bool perm; int mode; bf16* O = nullptr; size_t ldc = 0;
            if (kind == 1)      { g = pg8::Gemm{(const bf16*)(ws + WS_XB), WB + W_IN, MT, HLD, 1024}; perm = true; mode = 0; O = (bf16*)(ws + WS_H); ldc = HLD; }
            else if (kind == 3) { g = pg8::Gemm{(const bf16*)(ws + WS_CQN), WB + W_UQ, MT, 768, 384}; perm = false; mode = 2; O = (bf16*)(ws + WS_XB); ldc = 768; }
            else if (kind == 4 && j == 2 && pp.bid < 4) { g = pg8::Gemm{(const bf16*)(ws + WS_CKVB) + (size_t)NKM * 256, WB + W_UK, 512, 512, 256}; perm = true; mode = 0; O = (bf16*)(ws + WS_KN) + (size_t)NKM * 512; ldc = 512; }
            else if (kind == 4 && j == 2) { g = pg8::Gemm{WB + W_UVT, (const bf16*)(ws + WS_CKVB) + (size_t)NKM * 256, 512, 512, 256}; perm = true; mode = 0; O = (bf16*)(ws + WS_VT) + NKM; ldc = NK; }
            else if (kind == 4 && j == 0) { g = pg8::Gemm{(const bf16*)(ws + WS_CKVB), WB + W_UK, NKM, 512, 256}; perm = true; mode = 0; O = (bf16*)(ws + WS_KN); ldc = 512; }
            else if (kind == 4)           { g = pg8::Gemm{WB + W_UVT, (const bf16*)(ws + WS_CKVB), 512, NKM, 256}; perm = true; mode = 0; O = (bf16*)(ws + WS_VT); ldc = NK; }
            else if (kind == 6) { g = pg8::Gemm{(const bf16*)(ws + WS_MIX), WB + W_OUT, MP, 1024, 1024}; perm = false; mode = 3; }
            else if (kind == 8) { g = pg8::Gemm{(const bf16*)(ws + WS_XB), WB + W_GU, MT, 5632, 1024}; perm = true; mode = 1; O = (bf16*)(ws + WS_F); ldc = DFF; }
            else                { g = pg8::Gemm{(const bf16*)(ws + WS_F), WB + W_DN, MP, 1024, DFF}; perm = false; mode = 3; }
            const float* xp = pp.out; const float* xs = pp.out + (size_t)MP * 1024; if (kind == 6 && l == 0) { xp = KIN(0); xs = KIN(1); }
            pg8::StaticOrder S; if (kind == 3) S.init(g.M, g.N, pp2.G, pp2.bid); else if (kind == 4 && j == 2) S.init(g.M, g.N, pp.G, (pp.bid < 4) ? pp.bid : ((pp.bid - 4 + pp.G) % pp.G)); else S.init(g.M, g.N, pp.G, pp.bid);
            if (perm) { EpiT<true> E{mode, O, ldc, xp, xs, pp.out, (const float2*)(ws + WS_ROPE)}; pg8::gemm_phase<EpiT<true>, pg8::StaticOrder, true, true>(lds, g, S, E, pp.tid); }
            else      { EpiT<false> E{mode, O, ldc, xp, xs, pp.out, (const float2*)(ws + WS_ROPE)}; pg8::gemm_phase<EpiT<false>, pg8::StaticOrder, true, true>(lds, g, S, E, pp.tid); }
            __syncthreads();
        }
        if (step + 1 < hi_) {
            if (step == lo_) grid.sync();
            else fast_grid_bar((unsigned*)(ws + WS_BAR), (unsigned)(step - lo_), pp.tid, pp.bid, pp.G);
        }
    }
}

extern "C" void kernel_launch(void* const* d_in, const int* in_sizes, int n_in, void* d_out, int out_size, void* d_ws, size_t ws_size, hipStream_t stream) {
    static int grid_blocks = 0;
    if (!grid_blocks) {
        if (hipFuncSetAttribute((const void*)mega, hipFuncAttributeMaxDynamicSharedMemorySize, LDS_BYTES) != hipSuccess) { fprintf(stderr, "kernel_launch: hipFuncSetAttribute failed\n"); grid_blocks = -1; }
        else { int dev = 0, cus = 0, per_cu = 0; hipGetDevice(&dev); hipDeviceGetAttribute(&cus, hipDeviceAttributeMultiprocessorCount, dev);
            hipOccupancyMaxActiveBlocksPerMultiprocessor(&per_cu, mega, 512, LDS_BYTES);
            if (per_cu < 1) { fprintf(stderr, "kernel_launch: occupancy query says %d\n", per_cu); per_cu = 1; }
            grid_blocks = cus; }
    }
    if (grid_blocks <= 0) return;
    if (ws_size < WS_TOTAL || n_in < 29) { fprintf(stderr, "kernel_launch: workspace too small (%zu < %zu) or n_in %d\n", ws_size, (size_t)WS_TOTAL, n_in); return; }
    Params p{};
    for (int i = 0; i < 29; ++i) p.in[i] = (const float*)d_in[i];
    p.out = (float*)d_out; p.ws = (unsigned char*)d_ws;
#if COOP
    p.lo = 0; p.hi = (REPK == 0) ? 21 : 23; void* args[] = {&p};
    hipMemsetAsync((unsigned char*)d_ws + WS_BAR, 0, 8192, stream);
    hipError_t e = hipLaunchCooperativeKernel((const void*)mega, dim3(grid_blocks), dim3(512), args, LDS_BYTES, stream);
    if (e != hipSuccess) fprintf(stderr, "cooperative launch failed: %s (grid %d)\n", hipGetErrorString(e), grid_blocks);
#else
    for (int s = 0; s < 21; ++s) { p.lo = s; p.hi = s + 1; hipLaunchKernelGGL(mega, dim3(grid_blocks), dim3(512), LDS_BYTES, stream, p); }
#endif
}
```

```cpp
#include <hip/hip_runtime.h>
#include <hip/hip_cooperative_groups.h>
#include <cstdio>
#include <cstdint>
namespace cg = cooperative_groups;
namespace pg8 {
#define PG8_LAS __attribute__((address_space(3)))
typedef unsigned short bf16_t;
typedef short bf16x8 __attribute__((ext_vector_type(8)));
typedef float f32x4 __attribute__((ext_vector_type(4)));
typedef unsigned u32x4 __attribute__((ext_vector_type(4)));
constexpr int BM = 256, BK = 64, HALF = 128, HTB = HALF * BK * 2  , STAGE_BYTES = 8 * HTB, NXCD = 8, WGM = 8;

__host__ __device__ __forceinline__ int lds_byte(int r, int c) { const int st = (r >> 4) * 2 + (c >> 5), rr = r & 15, cc = c & 31, ob = rr * 64 + cc * 2; return st * 1024 + (ob ^ (((ob >> 9) & 1) << 5)); }
__host__ __device__ __forceinline__ void stage_rc(int b, int& R, int& C) { const int st = b / 1024, sb = b % 1024, swz = sb ^ (((sb >> 9) & 1) << 5); R = (st >> 1) * 16 + swz / 64; C = (st & 1) * 32 + (swz % 64) / 2; }
__host__ __device__ __forceinline__ int perm32(int rho) { const int n = rho >> 4, i = rho & 15; return 8 * (i >> 2) + 4 * n + (i & 3); }

struct Unit { int pm, pn; };
struct Gemm { const bf16_t* A; const bf16_t* Bt; int M, N, K; };

struct StaticOrder {
    int nM, nN, nwg, G, c;
    __host__ __device__ void init(int M, int N, int G_, int c_) { nM = M / BM; nN = N / BM; nwg = nM * nN; G = G_; c = c_; }
    __host__ __device__ bool next(int i, Unit& u) const {
        const long L = (long)i * G + c; if (L >= nwg) return false;
        int wgid = (int)L; { const int q = nwg / NXCD, r = nwg % NXCD, xcd = wgid % NXCD, off = wgid / NXCD; wgid = (xcd < r ? xcd * (q + 1) : r * (q + 1) + (xcd - r) * q) + off; }
        const int nig = WGM * nN, gid = wgid / nig, fm = gid * WGM, gsz = (nM - fm) < WGM ? (nM - fm) : WGM;
        u.pm = fm + ((wgid % nig) % gsz); u.pn = (wgid % nig) / gsz; return true;
    }
    __device__ __forceinline__ void a_ready(const Unit&) const {}
    __device__ __forceinline__ void done(const Unit&) const {}
};
__device__ __forceinline__ unsigned cvt_pk_bf16(float lo, float hi) { unsigned r; asm volatile("v_cvt_pk_bf16_f32 %0, %1, %2" : "=v"(r) : "v"(lo), "v"(hi)); return r; }
template <class Epi, class Sched, bool ALIGN_EPI = false, bool SP2 = false>
__device__ __forceinline__ void gemm_phase(PG8_LAS unsigned char* lds, const Gemm g, const Sched& S, const Epi& E, const int tid) {
    const int  wid = __builtin_amdgcn_readfirstlane(tid >> 6), lane = tid & 63, wr = wid >> 2, wc = wid & 3, fr = lane & 15, fq = lane >> 4;
    const int K = g.K, nt = K / BK;
    unsigned voffA[2], voffB[2];
#pragma unroll
    for (int i = 0; i < 2; ++i) { int R, C; stage_rc(tid * 16 + i * 8192, R, C); const int Rb = Epi::PERM ? ((R & ~31) + perm32(R & 31)) : R;
        voffA[i] = (unsigned)(R * K + C) * 2u; voffB[i] = (unsigned)(Rb * K + C) * 2u; }
    const size_t kstep = (size_t)(BK * 2);
    const size_t hstep = (size_t)HALF * K * 2;
    const size_t tstep = 2 * hstep;
    const unsigned ldsw = (unsigned)wid * 1024u;
    const int aoff = lds_byte(wr * 64 + fr, fq * 8), boff = lds_byte(wc * 32 + fr, fq * 8);
#define PG8_SA(b, h) (((b) * 2 + (h)) * HTB)
#define PG8_SB(b, h) ((4 + (b) * 2 + (h)) * HTB)
#define PG8_STAGE(bufoff, gbase, voff) do { _Pragma("unroll") for (int _i = 0; _i < 2; ++_i) \
        __builtin_amdgcn_global_load_lds((const unsigned*)((const char*)(gbase) + (voff)[_i]), (PG8_LAS unsigned*)(lds + (bufoff) + ldsw + _i * 8192), 16, 0, 0); } while (0)
#define PG8_LDA(dst, b, h) do { _Pragma("unroll") for (int m = 0; m < 4; ++m) _Pragma("unroll") for (int k = 0; k < 2; ++k) dst[m][k] = *(const PG8_LAS bf16x8*)(lds + PG8_SA(b, h) + aoff + m * 2048 + k * 1024); } while (0)
#define PG8_LDB(dst, b, h) do { _Pragma("unroll") for (int n = 0; n < 2; ++n) _Pragma("unroll") for (int k = 0; k < 2; ++k) dst[n][k] = *(const PG8_LAS bf16x8*)(lds + PG8_SB(b, h) + boff + n * 2048 + k * 1024); } while (0)
#define PG8_MMA(ai, bj, At, Bt) do { __builtin_amdgcn_s_setprio(1); _Pragma("unroll") for (int m = 0; m < 4; ++m) _Pragma("unroll") for (int n = 0; n < 2; ++n) _Pragma("unroll") for (int k = 0; k < 2; ++k) \
        acc[ai][bj][m][n] = __builtin_amdgcn_mfma_f32_16x16x32_bf16(Bt[n][k], At[m][k], acc[ai][bj][m][n], 0, 0, 0); __builtin_amdgcn_s_setprio(0); } while (0)
#define PG8_WAIT_V(n) asm volatile("s_waitcnt vmcnt(" #n ")" ::: "memory")
#define PG8_WAIT_L(n) asm volatile("s_waitcnt lgkmcnt(" #n ")" ::: "memory")
#define PG8_BAR __builtin_amdgcn_s_barrier()
#define PG8_SCHED __builtin_amdgcn_sched_barrier(0)
    Unit cur, nxt; int ui = 0;
    if (!S.next(0, cur)) return;
    f32x4 acc[2][2][4][2];
#pragma unroll
    for (int a = 0; a < 2; ++a)
#pragma unroll
        for (int b = 0; b < 2; ++b)
#pragma unroll
            for (int m = 0; m < 4; ++m)
#pragma unroll
                for (int n = 0; n < 2; ++n) acc[a][b][m][n] = (f32x4){0.f, 0.f, 0.f, 0.f};
    bf16x8 At[4][2], B0[2][2], B1[2][2];
    const char* cA = (const char*)g.A + (size_t)cur.pm * tstep; const char* cB = (const char*)g.Bt + (size_t)cur.pn * tstep;
    S.a_ready(cur);
    if constexpr (SP2) {
        PG8_STAGE(PG8_SB(0, 0), cB, voffB); PG8_STAGE(PG8_SB(0, 1), cB + hstep, voffB); PG8_STAGE(PG8_SA(0, 0), cA, voffA); PG8_STAGE(PG8_SA(0, 1), cA + hstep, voffA);
        if (wr == 1) PG8_BAR;
        PG8_WAIT_V(2); PG8_BAR;
        PG8_STAGE(PG8_SB(1, 0), cB + kstep, voffB); PG8_STAGE(PG8_SA(1, 0), cA + kstep, voffA); PG8_STAGE(PG8_SB(1, 1), cB + hstep + kstep, voffB);
        PG8_WAIT_V(6); PG8_BAR;
    } else {
        PG8_STAGE(PG8_SB(0, 0), cB, voffB); PG8_STAGE(PG8_SA(0, 0), cA, voffA); PG8_STAGE(PG8_SB(0, 1), cB + hstep, voffB); PG8_STAGE(PG8_SA(0, 1), cA + hstep, voffA);
        if (wr == 1) PG8_BAR;
        PG8_WAIT_V(4); PG8_BAR;
        PG8_STAGE(PG8_SB(1, 0), cB + kstep, voffB); PG8_STAGE(PG8_SA(1, 0), cA + kstep, voffA); PG8_STAGE(PG8_SB(1, 1), cB + hstep + kstep, voffB);
        PG8_WAIT_V(6); PG8_BAR;
    }
    for (;;) {
        const bool has_next = S.next(ui + 1, nxt);
        const char* nA = has_next ? (const char*)g.A + (size_t)nxt.pm * tstep : cA; const char* nB = has_next ? (const char*)g.Bt + (size_t)nxt.pn * tstep : cB;
        for (int t = 0; t < nt; t += 2) {
            const bool last = (t == nt - 2);
            const char* a1 = cA + (size_t)(t + 1) * kstep;
            const char* a2 = last ? nA : cA + (size_t)(t + 2) * kstep; const char* b2 = last ? nB : cB + (size_t)(t + 2) * kstep;
            const char* a3 = a2 + kstep; const char* b3 = b2 + kstep;
            if (last && has_next) S.a_ready(nxt);
            if constexpr (SP2) {
            PG8_LDB(B0, 0, 0); PG8_LDB(B1, 0, 1); PG8_SCHED; PG8_LDA(At, 0, 0); PG8_STAGE(PG8_SA(1, 1), a1 + hstep, voffA);
            PG8_WAIT_V(8); PG8_WAIT_L(0); PG8_BAR; PG8_MMA(0, 0, At, B0); PG8_MMA(0, 1, At, B1); PG8_BAR; PG8_SCHED;
            PG8_LDA(At, 0, 1); PG8_STAGE(PG8_SB(0, 0), b2, voffB); PG8_STAGE(PG8_SB(0, 1), b2 + hstep, voffB); PG8_STAGE(PG8_SA(0, 0), a2, voffA);
            PG8_WAIT_V(8); PG8_WAIT_L(0); PG8_BAR; PG8_MMA(1, 0, At, B0); PG8_MMA(1, 1, At, B1); PG8_BAR; PG8_SCHED;
            PG8_LDB(B0, 1, 0); PG8_LDB(B1, 1, 1); PG8_SCHED; PG8_LDA(At, 1, 0); PG8_STAGE(PG8_SA(0, 1), a2 + hstep, voffA);
            PG8_WAIT_V(8); PG8_WAIT_L(0); PG8_BAR; PG8_MMA(0, 0, At, B0); PG8_MMA(0, 1, At, B1); PG8_BAR; PG8_SCHED;
            PG8_LDA(At, 1, 1); PG8_STAGE(PG8_SB(1, 0), b3, voffB); PG8_STAGE(PG8_SB(1, 1), b3 + hstep, voffB); PG8_STAGE(PG8_SA(1, 0), a3, voffA);
            PG8_WAIT_V(8); PG8_WAIT_L(0); PG8_BAR; PG8_MMA(1, 0, At, B0); PG8_MMA(1, 1, At, B1); PG8_BAR; PG8_SCHED;
            } else {
            PG8_LDB(B0, 0, 0); PG8_SCHED; PG8_LDA(At, 0, 0); PG8_STAGE(PG8_SA(1, 1), a1 + hstep, voffA);
            PG8_WAIT_L(8); PG8_BAR; PG8_WAIT_L(0); PG8_MMA(0, 0, At, B0); PG8_BAR; PG8_SCHED;
            PG8_LDB(B1, 0, 1); PG8_STAGE(PG8_SB(0, 0), b2, voffB);
            PG8_BAR; PG8_WAIT_L(0); PG8_MMA(0, 1, At, B1); PG8_BAR;
            PG8_LDA(At, 0, 1); PG8_STAGE(PG8_SA(0, 0), a2, voffA);
            PG8_BAR; PG8_WAIT_L(0); PG8_MMA(1, 0, At, B0); PG8_BAR; PG8_SCHED;
            PG8_STAGE(PG8_SB(0, 1), b2 + hstep, voffB);
            PG8_WAIT_V(6); PG8_BAR; PG8_MMA(1, 1, At, B1); PG8_BAR;
            PG8_LDB(B0, 1, 0); PG8_SCHED; PG8_LDA(At, 1, 0); PG8_STAGE(PG8_SA(0, 1), a2 + hstep, voffA);
            PG8_WAIT_L(8); PG8_BAR; PG8_WAIT_L(0); PG8_MMA(0, 0, At, B0); PG8_BAR; PG8_SCHED;
            PG8_LDB(B1, 1, 1); PG8_STAGE(PG8_SB(1, 0), b3, voffB);
            PG8_BAR; PG8_WAIT_L(0); PG8_MMA(0, 1, At, B1); PG8_BAR;
            PG8_LDA(At, 1, 1); PG8_STAGE(PG8_SA(1, 0), a3, voffA);
            PG8_BAR; PG8_WAIT_L(0); PG8_MMA(1, 0, At, B0); PG8_BAR; PG8_SCHED;
            PG8_STAGE(PG8_SB(1, 1), b3 + hstep, voffB);
            PG8_WAIT_V(6); PG8_BAR; PG8_MMA(1, 1, At, B1); PG8_BAR;
            }
        }
        if constexpr (ALIGN_EPI) { if (wr == 0) PG8_BAR; }
        if constexpr (!Epi::AFTER_DRAIN) { E(acc, cur, wr, wc, fr, fq); S.done(cur); }
        if (!has_next) break;
#pragma unroll
        for (int a = 0; a < 2; ++a)
#pragma unroll
            for (int b = 0; b < 2; ++b)
#pragma unroll
                for (int m = 0; m < 4; ++m)
#pragma unroll
                    for (int n = 0; n < 2; ++n) acc[a][b][m][n] = (f32x4){0.f, 0.f, 0.f, 0.f};
        cur = nxt; cA = nA; cB = nB; ++ui;
        if constexpr (ALIGN_EPI) { if (wr == 1) PG8_BAR; }
    }
    PG8_WAIT_V(0);
    if constexpr (!ALIGN_EPI) { if (wr == 0) PG8_BAR; }
    PG8_BAR;
    if constexpr (Epi::AFTER_DRAIN) { E.fused(acc, cur, wr, wc, fr, fq, lds, wid, lane); S.done(cur); }
#undef PG8_SA
#undef PG8_SB
#undef PG8_STAGE
#undef PG8_LDA
#undef PG8_LDB
#undef PG8_MMA
#undef PG8_WAIT_V
#undef PG8_WAIT_L
#undef PG8_BAR
#undef PG8_SCHED
}
}

#define LAS __attribute__((address_space(3)))
typedef unsigned short bf16;
typedef short bf16x8 __attribute__((ext_vector_type(8)));
typedef short s16x4 __attribute__((ext_vector_type(4)));
typedef float f32x4 __attribute__((ext_vector_type(4)));
typedef unsigned u32x4 __attribute__((ext_vector_type(4)));
typedef unsigned u32x2 __attribute__((ext_vector_type(2)));

#ifndef COOP
#define COOP 1
#endif
#ifndef REPK
#define REPK 0
#endif
#ifndef REPG1
#define REPG1 0
#endif
#ifndef REP2
#define REP2 0
#endif
#ifndef GDN_SPLIT
#define GDN_SPLIT 0
#endif

constexpr int MP = 32768, MS = 512, MT = MP + MS;
constexpr int SKS = 2064;
constexpr int NK = MP + 32 * SKS;
constexpr int NKM = MP + 65536;
constexpr int HLD = 2304;
constexpr int C_CKV = 384, C_KPE = 640, C_QKV = 672, C_B = 1440, C_A = 1444, C_Z = 1448, C_GA = 1704, C_GG = 1960;
constexpr int DFF = 2816;
constexpr float DN_ALPHA = 1.41421356237f;
constexpr float QSCALE = 0.10206207261596577f * 1.4426950408889634f;

constexpr size_t O_YP = 0, O_YS = 33554432, O_CKVP = 34078720, O_KPEP = 50855936, O_GDNP = 52953088, O_GCP = 53477376,
                 O_CVP = 53551104, O_CKVS = 53796864, O_KPES = 54059008, O_GDNS = 54091776, O_GCS = 55140352, O_CVS = 55287808;

constexpr size_t W_IN = 0, W_UQ = W_IN + 2304 * 1024, W_UK = W_UQ + 768 * 384, W_UVT = W_UK + 512 * 256, W_OUT = W_UVT + 512 * 256,
                 W_GU = W_OUT + 1024 * 1024, W_DN = W_GU + 5632 * 1024, W_LAYER = W_DN + 1024 * 2816;
constexpr size_t WS_W = 0, WS_ROPE = WS_W + 2 * W_LAYER * 2, WS_XB = WS_ROPE + 2064 * 16 * 8, WS_MIX = WS_XB + (size_t)MT * 1024 * 2,
                 WS_CQN = WS_MIX + (size_t)MT * 1024 * 2, WS_CKVB = WS_CQN + (size_t)MT * 384 * 2, WS_KPEB = WS_CKVB + (size_t)NK * 256 * 2,
                 WS_BIG = WS_KPEB + (size_t)NK * 32 * 2;
constexpr size_t GUNIT = 49408;
constexpr int NGU = 2176;
constexpr size_t WS_H = WS_BIG, WS_GSCR = WS_H + (size_t)MT * HLD * 2, BIG1 = (size_t)MT * HLD * 2 + (size_t)NGU * GUNIT;
constexpr size_t WS_Q = WS_BIG, WS_KN = WS_Q + (size_t)MT * 768 * 2, WS_VT = WS_KN + (size_t)NK * 512 * 2, BIG2 = (size_t)MT * 768 * 2 + 2 * (size_t)NK * 512 * 2;
constexpr size_t WS_F = WS_BIG, BIG3 = (size_t)MT * DFF * 2;
constexpr size_t BIGSZ = BIG1 > BIG2 ? (BIG1 > BIG3 ? BIG1 : BIG3) : (BIG2 > BIG3 ? BIG2 : BIG3);
constexpr size_t WS_BAR = WS_BIG + BIGSZ;
constexpr size_t WS_TOTAL = WS_BAR + 8192;
static_assert(WS_TOTAL <= 536870912ull, "workspace map exceeds 512 MiB");
static_assert(WS_XB % 256 == 0 && WS_BIG % 256 == 0 && WS_GSCR % 256 == 0 && WS_KN % 256 == 0 && WS_VT % 256 == 0, "alignment");

constexpr int LDS_BYTES = 139264;
constexpr int G1_GRP = 67584;

struct Params { const float* in[29]; float* out; unsigned char* ws; int lo, hi; };
template <int OFF> __device__ __forceinline__ unsigned long long karg_u64() {
    unsigned long long v; const unsigned long long kp = (unsigned long long)__builtin_amdgcn_kernarg_segment_ptr();
    asm volatile("s_load_dwordx2 %0, %1, %2\n\ts_waitcnt lgkmcnt(0)" : "=s"(v) : "s"(kp), "n"(OFF));
    return v;
}
#define GAS1 __attribute__((address_space(1)))
#define KIN(i) ((const float*)(const GAS1 float*)karg_u64<8 * (i)>())
#define KOUT() ((float*)(GAS1 float*)karg_u64<232>())
#define KWS() ((unsigned char*)(GAS1 unsigned char*)karg_u64<240>())
struct PP { unsigned char* ws; float* out; int tid, bid, G; };

__device__ __forceinline__ unsigned f2bf(float f) { unsigned u = __builtin_bit_cast(unsigned, f); return (u + 0x7fffu + ((u >> 16) & 1u)) >> 16; }
__device__ __forceinline__ float bf2f(unsigned b) { return __builtin_bit_cast(float, b << 16); }
__device__ __forceinline__ unsigned pk2(float lo, float hi) { return pg8::cvt_pk_bf16(lo, hi); }
__device__ __forceinline__ float sigmoidf_(float x) { return __builtin_amdgcn_rcpf(1.0f + __expf(-x)); }
__device__ __forceinline__ float siluf_(float x) { return x * sigmoidf_(x); }

template <int CTRL> __device__ __forceinline__ float dpp_f(float v) { return __builtin_bit_cast(float, __builtin_amdgcn_update_dpp(0, __builtin_bit_cast(int, v), CTRL, 0xf, 0xf, false)); }
__device__ __forceinline__ float row16_sum(float v) { v += dpp_f<0xB1>(v); v += dpp_f<0x4E>(v); v += dpp_f<0x141>(v); v += dpp_f<0x140>(v); return v; }
__device__ __forceinline__ float xor16_get(float v) { return __builtin_bit_cast(float, __builtin_amdgcn_ds_swizzle(__builtin_bit_cast(int, v), 0x401F)); }
__device__ __forceinline__ float xor32_max(float v) { const unsigned u = __builtin_bit_cast(unsigned, v); auto r = __builtin_amdgcn_permlane32_swap(u, u, false, false); return fmaxf(__builtin_bit_cast(float, (unsigned)r[0]), __builtin_bit_cast(float, (unsigned)r[1])); }
__device__ __forceinline__ float xor32_sum(float v) { const unsigned u = __builtin_bit_cast(unsigned, v); auto r = __builtin_amdgcn_permlane32_swap(u, u, false, false); return __builtin_bit_cast(float, (unsigned)r[0]) + __builtin_bit_cast(float, (unsigned)r[1]); }
__device__ __forceinline__ float wave_sum(float v) {
    v = row16_sum(v); const int iv = __builtin_bit_cast(int, v);
    const float s0 = __builtin_bit_cast(float, __builtin_amdgcn_readlane(iv, 0)), s1 = __builtin_bit_cast(float, __builtin_amdgcn_readlane(iv, 16));
    const float s2 = __builtin_bit_cast(float, __builtin_amdgcn_readlane(iv, 32)), s3 = __builtin_bit_cast(float, __builtin_amdgcn_readlane(iv, 48));
    return (s0 + s1) + (s2 + s3);
}
#define LBAR() asm volatile("s_waitcnt lgkmcnt(0)\n\ts_barrier" ::: "memory")
__device__ __forceinline__ f32x4 mfma16(bf16x8 a, bf16x8 b, f32x4 c) { return __builtin_amdgcn_mfma_f32_16x16x32_bf16(a, b, c, 0, 0, 0); }

template <bool P> struct EpiT {
    static constexpr bool PERM = P, AFTER_DRAIN = false;
    int mode;
    bf16* O; size_t ldc;
    const float* xp; const float* xs; float* X;
    const float2* rope;
    __device__ __forceinline__ void operator()(const f32x4 (&acc)[2][2][4][2], const pg8::Unit& u, int wr, int wc, int fr, int fq) const {
        const int row0 = u.pm * 256 + wr * 64 + fr;
        if constexpr (P) {
            if (mode == 0) {
                const int col0 = u.pn * 256 + wc * 32 + 8 * fq;
#pragma unroll
                for (int ai = 0; ai < 2; ++ai)
#pragma unroll
                    for (int m = 0; m < 4; ++m) { bf16* rowp = O + (size_t)(row0 + ai * 128 + m * 16) * ldc + col0;
#pragma unroll
                        for (int bj = 0; bj < 2; ++bj) { const f32x4 v0 = acc[ai][bj][m][0], v1 = acc[ai][bj][m][1]; u32x4 w;
                            w.x = pk2(v0[0], v0[1]); w.y = pk2(v0[2], v0[3]); w.z = pk2(v1[0], v1[1]); w.w = pk2(v1[2], v1[3]);
                            *(u32x4*)(rowp + bj * 128) = w; } }
            } else {
                const int col0 = u.pn * 128 + wc * 32 + 8 * fq;
#pragma unroll
                for (int ai = 0; ai < 2; ++ai)
#pragma unroll
                    for (int m = 0; m < 4; ++m) { bf16* rowp = O + (size_t)(row0 + ai * 128 + m * 16) * ldc + col0;
                        float f[8];
#pragma unroll
                        for (int n = 0; n < 2; ++n)
#pragma unroll
                            for (int j = 0; j < 4; ++j) { const float g = acc[ai][0][m][n][j], up = acc[ai][1][m][n][j]; f[n * 4 + j] = siluf_(g) * up; }
                        u32x4 w; w.x = pk2(f[0], f[1]); w.y = pk2(f[2], f[3]); w.z = pk2(f[4], f[5]); w.w = pk2(f[6], f[7]);
                        *(u32x4*)rowp = w; }
            }
        } else {
            if (mode == 3) {
#pragma unroll
                for (int ai = 0; ai < 2; ++ai)
#pragma unroll
                    for (int m = 0; m < 4; ++m) { const int row = row0 + ai * 128 + m * 16;
                        const float* src = (row < MP) ? xp + (size_t)row * 1024 : xs + (size_t)(row - MP) * 1024;
                        float* dst = X + (size_t)row * 1024;
#pragma unroll
                        for (int bj = 0; bj < 2; ++bj)
#pragma unroll
                            for (int n = 0; n < 2; ++n) { const int col = u.pn * 256 + bj * 128 + wc * 32 + n * 16 + 4 * fq;
                                const f32x4 xi = *(const f32x4*)(src + col); f32x4 o = xi * DN_ALPHA + acc[ai][bj][m][n];
                                *(f32x4*)(dst + col) = o; }
                        __builtin_amdgcn_sched_barrier(0); }
            } else {
#pragma unroll
                for (int ai = 0; ai < 2; ++ai)
#pragma unroll
                    for (int m = 0; m < 4; ++m) { const int row = row0 + ai * 128 + m * 16;
                        const int pos = (row < MP) ? (row & 2047) : (2048 + ((row - MP) & 15));
                        bf16* rowp = O + (size_t)row * 768;
#pragma unroll
                        for (int bj = 0; bj < 2; ++bj) { const int g32 = u.pn * 256 + bj * 128 + wc * 32;
                            f32x4 a = acc[ai][bj][m][0], b = acc[ai][bj][m][1];
                            if ((g32 % 96) == 64) {
                                const float2* rp = rope + pos * 16 + 4 * fq;
#pragma unroll
                                for (int j = 0; j < 4; ++j) { const float2 cs = rp[j]; const float x1 = a[j], x2 = b[j]; a[j] = x1 * cs.x - x2 * cs.y; b[j] = x1 * cs.y + x2 * cs.x; }
                            }
                            a = a * QSCALE; b = b * QSCALE;
                            u32x2 w0, w1; w0.x = pk2(a[0], a[1]); w0.y = pk2(a[2], a[3]); w1.x = pk2(b[0], b[1]); w1.y = pk2(b[2], b[3]);
                            *(u32x2*)(rowp + g32 + 4 * fq) = w0; *(u32x2*)(rowp + g32 + 16 + 4 * fq) = w1; }
                        __builtin_amdgcn_sched_barrier(0); }
            }
        }
    }
};

__device__ __forceinline__ void prep_phase(const PP P, LAS unsigned char* lds, const int wl, const bool do_rest) {
    const int tid = P.tid, G = P.G;
    LAS float* tile = (LAS float*)lds;
    bf16* WB = (bf16*)(P.ws + WS_W);
    const int tx = tid & 63, ty = tid >> 6;
    for (int it = P.bid; it < 3080; it += G) {
        const int l = wl, r = it;
        const float* src; int ld, K, kt_n, tt; bf16* dst; int kind;
        if (r < 576)       { kind = 0; tt = r;        src = KIN(7) + (size_t)l * 1024 * 2216;  ld = 2216; K = 1024; kt_n = 16; dst = WB + l * W_LAYER + W_IN; }
        else if (r < 648)  { kind = 1; tt = r - 576;  src = KIN(9) + (size_t)l * 384 * 768;    ld = 768;  K = 384;  kt_n = 6;  dst = WB + l * W_LAYER + W_UQ; }
        else if (r < 680)  { kind = 1; tt = r - 648;  src = KIN(11) + (size_t)l * 256 * 512;   ld = 512;  K = 256;  kt_n = 4;  dst = WB + l * W_LAYER + W_UK; }
        else if (r < 712)  { kind = 1; tt = r - 680;  src = KIN(12) + (size_t)l * 256 * 512;   ld = 512;  K = 256;  kt_n = 4;  dst = WB + l * W_LAYER + W_UVT; }
        else if (r < 968)  { kind = 1; tt = r - 712;  src = KIN(21) + (size_t)l * 1024 * 1024; ld = 1024; K = 1024; kt_n = 16; dst = WB + l * W_LAYER + W_OUT; }
        else if (r < 2376) { kind = 2; tt = r - 968;  src = nullptr;                            ld = 2816; K = 1024; kt_n = 16; dst = WB + l * W_LAYER + W_GU; }
        else               { kind = 1; tt = r - 2376; src = KIN(26) + (size_t)l * 2816 * 1024; ld = 1024; K = 2816; kt_n = 44; dst = WB + l * W_LAYER + W_DN; }
        const int n0 = (tt / kt_n) * 64, k0 = (tt % kt_n) * 64;
        int col0 = n0; bool valid = true;
        if (kind == 0) valid = (n0 + tx) < 2216;
        if (kind == 2) { src = (((n0 >> 7) & 1) ? KIN(25) : KIN(24)) + (size_t)l * 1024 * 2816; col0 = (n0 >> 8) * 128 + (n0 & 127); }
#pragma unroll
        for (int kk = ty; kk < 64; kk += 8) tile[kk * 65 + tx] = valid ? src[(size_t)(k0 + kk) * ld + col0 + tx] : 0.f;
        __syncthreads();
#pragma unroll
        for (int nn = ty; nn < 64; nn += 8) dst[(size_t)(n0 + nn) * K + k0 + tx] = (bf16)f2bf(tile[tx * 65 + nn]);
        __syncthreads();
    }
    if (!do_rest) return;
    bf16* XB = (bf16*)(P.ws + WS_XB);
    for (int g = P.bid * 512 + tid; g < MT * 128; g += G * 512) {
        const int row = g >> 7, c8 = g & 127;
        const float* s = (row < MP) ? KIN(0) + (size_t)row * 1024 + c8 * 8 : KIN(1) + (size_t)(row - MP) * 1024 + c8 * 8;
        const f32x4 a = *(const f32x4*)s, b = *(const f32x4*)(s + 4);
        u32x4 w; w.x = pk2(a[0], a[1]); w.y = pk2(a[2], a[3]); w.z = pk2(b[0], b[1]); w.w = pk2(b[2], b[3]);
        *(u32x4*)(XB + (size_t)g * 8) = w;
    }
    float2* rope = (float2*)(P.ws + WS_ROPE);
    for (int idx = P.bid * 512 + tid; idx < 2064 * 16; idx += G * 512) {
        const int pos = idx >> 4, i = idx & 15;
        const float inv = __expf(-9.210340371976184f * (float)i / 16.0f);
        const float ang = (float)pos * inv;
        const float k = rintf(ang * 0.15915494309189535f);
        float rr = fmaf(-k, 6.2831854820251465f, ang); rr = fmaf(k, 1.7484555e-7f, rr);
        rope[idx] = make_float2(__cosf(rr), __sinf(rr));
    }
}

__device__ __forceinline__ void tok_phase(const PP P, int l) {
    const int tid = P.tid, lane = tid & 63, wave = tid >> 6, G = P.G;
    const bf16* H = (const bf16*)(P.ws + WS_H);
    bf16* CQN = (bf16*)(P.ws + WS_CQN); bf16* CKVB = (bf16*)(P.ws + WS_CKVB); bf16* KPEB = (bf16*)(P.ws + WS_KPEB);
    const float2* rope = (const float2*)(P.ws + WS_ROPE);
    const float* qn = KIN(8) + l * 384; const float* kvn = KIN(10) + l * 256;
    float* out = P.out;
    for (int row = P.bid * 8 + wave; row < MT; row += G * 8) {
        const bf16* hr = H + (size_t)row * HLD;
        const bool smp = row >= MP; int b, t, pos;
        if (!smp) { b = row >> 11; t = row & 2047; pos = t; } else { const int rr = row - MP; b = rr >> 4; t = rr & 15; pos = 2048 + t; }
        const size_t krow = smp ? (size_t)MP + 65536 + (size_t)b * 16 + t : (size_t)row;
        { float v[6]; float ss = 0.f;
#pragma unroll
          for (int i = 0; i < 3; ++i) { const unsigned w = *(const unsigned*)(hr + 128 * i + lane * 2); v[2 * i] = bf2f(w & 0xffffu); v[2 * i + 1] = bf2f(w >> 16); ss += v[2 * i] * v[2 * i] + v[2 * i + 1] * v[2 * i + 1]; }
          ss = wave_sum(ss); const float rinv = rsqrtf(ss * (1.0f / 384.0f) + 1e-6f);
#pragma unroll
          for (int i = 0; i < 3; ++i) { const int col = 128 * i + lane * 2; *(unsigned*)(CQN + (size_t)row * 384 + col) = pk2(v[2 * i] * rinv * qn[col], v[2 * i + 1] * rinv * qn[col + 1]); } }
        { const u32x2 w = *(const u32x2*)(hr + C_CKV + lane * 4);
          float v0 = bf2f(w.x & 0xffffu), v1 = bf2f(w.x >> 16), v2 = bf2f(w.y & 0xffffu), v3 = bf2f(w.y >> 16);
          float ss = wave_sum(v0 * v0 + v1 * v1 + v2 * v2 + v3 * v3); const float rinv = rsqrtf(ss * (1.0f / 256.0f) + 1e-6f);
          const f32x4 gn = *(const f32x4*)(kvn + lane * 4);
          f32x4 o; o[0] = v0 * rinv * gn[0]; o[1] = v1 * rinv * gn[1]; o[2] = v2 * rinv * gn[2]; o[3] = v3 * rinv * gn[3];
          float* op = smp ? out + O_CKVS + ((size_t)(l * 32 + b) * 16 + t) * 256 : out + O_CKVP + ((size_t)(l * 16 + b) * 2048 + t) * 256;
          *(f32x4*)(op + lane * 4) = o;
          u32x2 pw; pw.x = pk2(o[0], o[1]); pw.y = pk2(o[2], o[3]); *(u32x2*)(CKVB + krow * 256 + lane * 4) = pw; }
        if (lane < 16) { const float x1 = bf2f(hr[C_KPE + lane]), x2 = bf2f(hr[C_KPE + 16 + lane]); const float2 cs = rope[pos * 16 + lane];
          const float o1 = x1 * cs.x - x2 * cs.y, o2 = x1 * cs.y + x2 * cs.x;
          float* op = smp ? out + O_KPES + ((size_t)(l * 32 + b) * 16 + t) * 32 : out + O_KPEP + ((size_t)(l * 16 + b) * 2048 + t) * 32;
          op[lane] = o1; op[16 + lane] = o2; KPEB[krow * 32 + lane] = (bf16)f2bf(o1); KPEB[krow * 32 + 16 + lane] = (bf16)f2bf(o2); }
        { const int T = smp ? 16 : 2048;
          if (t >= T - 3) { const int j = t - (T - 3);
            float* op = smp ? out + O_GCS + ((size_t)(l * 32 + b) * 3 + j) * 768 : out + O_GCP + ((size_t)(l * 16 + b) * 3 + j) * 768;
#pragma unroll
            for (int i = 0; i < 12; ++i) op[lane + 64 * i] = bf2f(hr[C_QKV + lane + 64 * i]); } }
        if (smp || t >= 2018) {
            float* op = smp ? out + O_CVS + ((size_t)(l * 32 + b) * 30 + 14 + t) * 256 : out + O_CVP + ((size_t)(l * 16 + b) * 30 + (t - 2018)) * 256;
#pragma unroll
            for (int i = 0; i < 4; ++i) { const int ch = lane + 64 * i; op[ch] = bf2f(hr[C_GA + ch]) * sigmoidf_(bf2f(hr[C_GG + ch])); }
            if (smp && t == 0) {
                const float* sc = KIN(6) + ((size_t)(l * 32 + b) * 30 + 16) * 256; float* o2 = out + O_CVS + (size_t)(l * 32 + b) * 30 * 256;
                for (int e = lane; e < 14 * 256; e += 64) o2[e] = sc[e];
            }
        }
    }
}

__device__ __forceinline__ void cache_phase(const PP P, int l) {
    const int tid = P.tid, G = P.G;
    bf16* CKVB = (bf16*)(P.ws + WS_CKVB); bf16* KPEB = (bf16*)(P.ws + WS_KPEB);
    const float* cckv = KIN(2) + (size_t)l * 32 * 2048 * 256; const float* ckpe = KIN(3) + (size_t)l * 32 * 2048 * 32;
    for (int g = P.bid * 512 + tid; g < 65536 * 32; g += G * 512) {
        const int prow = g >> 5, c8 = g & 31, b = prow >> 11, s = prow & 2047;
        const float* sp = cckv + (size_t)prow * 256 + c8 * 8; const f32x4 a = *(const f32x4*)sp, c = *(const f32x4*)(sp + 4);
        u32x4 w; w.x = pk2(a[0], a[1]); w.y = pk2(a[2], a[3]); w.z = pk2(c[0], c[1]); w.w = pk2(c[2], c[3]);
        *(u32x4*)(CKVB + ((size_t)MP + (size_t)b * 2048 + s) * 256 + c8 * 8) = w;
    }
    for (int g = P.bid * 512 + tid; g < 65536 * 4; g += G * 512) {
        const int prow = g >> 2, c8 = g & 3, b = prow >> 11, s = prow & 2047;
        const float* sp = ckpe + (size_t)prow * 32 + c8 * 8; const f32x4 a = *(const f32x4*)sp, c = *(const f32x4*)(sp + 4);
        u32x4 w; w.x = pk2(a[0], a[1]); w.y = pk2(a[2], a[3]); w.z = pk2(c[0], c[1]); w.w = pk2(c[2], c[3]);
        *(u32x4*)(KPEB + ((size_t)MP + (size_t)b * 2048 + s) * 32 + c8 * 8) = w;
    }
}

__device__ __forceinline__ void conv_phase(const PP P, int l, LAS unsigned char* lds) {
    const int tid = P.tid, lane = tid & 63, wave = tid >> 6, G = P.G;
    const bf16* H = (const bf16*)(P.ws + WS_H); bf16* MIX = (bf16*)(P.ws + WS_MIX);
    LAS bf16* cs = (LAS bf16*)lds;
    LAS float* os = (LAS float*)(lds + 48128);
    const float* cw = KIN(17) + (size_t)l * 31 * 256; const float* cb = KIN(18) + l * 256;
    const float* lg = KIN(19) + l * 256; const float* lb = KIN(20) + l * 256; const float* sc = KIN(6);
    for (int u = P.bid; u < 544; u += G) {
        const bool smp = u < 32; int b, t0, ntok; size_t row0;
        if (!smp) { const int v = u - 32; b = v >> 5; t0 = (v & 31) * 64; ntok = 64; row0 = (size_t)b * 2048 + t0; } else { b = u; t0 = 0; ntok = 16; row0 = (size_t)MP + b * 16; }
        { const int ch2 = (tid & 127) * 2, rg = tid >> 7; const int nrow = 30 + ntok;
          const GAS1 bf16* hb = (const GAS1 bf16*)(H + ((long long)row0 - 30 + rg) * HLD + ch2);
          for (int k0 = 0; k0 < 24; k0 += 12) {
          unsigned ra[12], rgt[12];
#pragma unroll
          for (int k = 0; k < 12; ++k) { const int i = rg + 4 * (k0 + k), tt = t0 - 30 + i; ra[k] = 0u; rgt[k] = 0u;
              if (i < nrow && tt >= 0) { ra[k] = *(const GAS1 unsigned*)(hb + C_GA); rgt[k] = *(const GAS1 unsigned*)(hb + C_GG); }
              hb += 4 * HLD; asm volatile("" : "+v"(hb)); }
#pragma unroll
          for (int k = 0; k < 12; ++k) { const int i = rg + 4 * (k0 + k), tt = t0 - 30 + i;
              if (i < nrow) { float v0, v1;
                  if (tt >= 0 || !smp) { v0 = bf2f(ra[k] & 0xffffu) * sigmoidf_(bf2f(rgt[k] & 0xffffu)); v1 = bf2f(ra[k] >> 16) * sigmoidf_(bf2f(rgt[k] >> 16)); }
                  else { const float* sp = sc + ((size_t)(l * 32 + b) * 30 + (30 + tt)) * 256 + ch2; v0 = sp[0]; v1 = sp[1]; }
                  *(LAS unsigned*)(cs + i * 256 + ch2) = pk2(v0, v1); } } } }
        LBAR();
        { const int ch = tid & 255, gsel = tid >> 8; float w[31]; const GAS1 float* cwp = (const GAS1 float*)(cw + ch); asm volatile("" : "+v"(cwp));
#pragma unroll
          for (int j = 0; j < 31; ++j) w[j] = cwp[j * 256];
          const float bias = cb[ch];
          for (int g = gsel; g < (ntok >> 3); g += 2) { float win[38];
#pragma unroll
              for (int i = 0; i < 38; ++i) win[i] = bf2f(cs[(8 * g + i) * 256 + ch]);
#pragma unroll
              for (int t = 0; t < 8; ++t) { float acc = bias;
#pragma unroll
                  for (int j = 0; j < 31; ++j) acc += w[j] * win[t + j];
                  os[(8 * g + t) * 256 + ch] = acc; } } }
        LBAR();
        for (int t = wave; t < ntok; t += 8) {
            float v[4]; float sm = 0.f;
#pragma unroll
            for (int i = 0; i < 4; ++i) { v[i] = os[t * 256 + lane + 64 * i]; sm += v[i]; }
            const float mu = wave_sum(sm) * (1.0f / 256.0f); float q = 0.f;
#pragma unroll
            for (int i = 0; i < 4; ++i) { const float d = v[i] - mu; q += d * d; }
            const float rstd = rsqrtf(wave_sum(q) * (1.0f / 256.0f) + 1e-5f);
#pragma unroll
            for (int i = 0; i < 4; ++i) { const int ch = lane + 64 * i; const float y = (v[i] - mu) * rstd * lg[ch] + lb[ch]; MIX[(row0 + t) * 1024 + 768 + ch] = (bf16)f2bf(siluf_(y)); }
        }
        LBAR();
    }
}

__device__ __forceinline__ void g1_phase(const PP P, int l, LAS unsigned char* lds) {
    const int tid = P.tid, grp = tid >> 8, gt = tid & 255, G = P.G;
    const bf16* H = (const bf16*)(P.ws + WS_H);
    LAS float* qs = (LAS float*)(lds + grp * G1_GRP); LAS float* ks = qs + 64 * 65; LAS float* vs = ks + 64 * 65; LAS float* As = vs + 64 * 65;
    LAS float* Gs = As + 64 * 64; LAS float* bs = Gs + 64; LAS float* gs = bs + 64;
    const float* gcw = KIN(13) + (size_t)l * 4 * 768;
    const int rounds = (NGU + 2 * G - 1) / (2 * G);
    for (int it = 0; it < rounds; ++it) {
        const int u = (it * G + P.bid) * 2 + grp; const bool act = u < NGU;
        int b, h, ch, L; bool smp; size_t seq0;
        if (u < 2048) { const int bh = u >> 5; ch = u & 31; b = bh >> 2; h = bh & 3; L = 64; smp = false; seq0 = (size_t)b * 2048; }
        else { const int bh = u - 2048; b = bh >> 2; h = bh & 3; L = 16; smp = true; ch = 0; seq0 = (size_t)MP + b * 16; }
        unsigned char* ub = P.ws + WS_GSCR + (size_t)(act ? u : 0) * GUNIT;
        bf16* Wd = (bf16*)ub; bf16* QKd = (bf16*)(ub + 8192); bf16* KdT = (bf16*)(ub + 16384); bf16* QG = (bf16*)(ub + 24576); float* Uv = (float*)(ub + 32768);
#ifdef PROBE_SOLVE
        for (int pass_ = 0; pass_ < 2; ++pass_) {
#endif
        if (act) {
            if (gt < 192) { const int part = gt >> 6, cc = gt & 63, qcol = part * 256 + h * 64 + cc;
                const float w0 = gcw[qcol], w1 = gcw[768 + qcol], w2 = gcw[2 * 768 + qcol], w3 = gcw[3 * 768 + qcol];
                LAS float* dst = (part == 0 ? qs : (part == 1 ? ks : vs)) + cc;
                const bf16* hp = H + (seq0 + (size_t)ch * 64) * HLD + C_QKV + qcol;
                float x0 = 0.f, x1 = 0.f, x2 = 0.f;
                if (ch > 0) { x0 = bf2f(*(hp - 3 * HLD)); x1 = bf2f(*(hp - 2 * HLD)); x2 = bf2f(*(hp - HLD)); }
                else if (smp) { const float* sp = KIN(5) + (size_t)(l * 32 + b) * 3 * 768 + qcol; x0 = sp[0]; x1 = sp[768]; x2 = sp[2 * 768]; }
                const GAS1 bf16* pr = (const GAS1 bf16*)hp;
                if (L == 64) {
                  for (int tb = 0; tb < 64; tb += 32) { float xv[32];
#pragma unroll
                    for (int i = 0; i < 32; ++i) { xv[i] = bf2f(*pr); pr += HLD; asm volatile("" : "+v"(pr)); }
#pragma unroll
                    for (int i = 0; i < 32; ++i) { const float y = w0 * x0 + w1 * x1 + w2 * x2 + w3 * xv[i]; dst[(tb + i) * 65] = siluf_(y); x0 = x1; x1 = x2; x2 = xv[i]; } }
                } else { float xv[16];
#pragma unroll
                    for (int i = 0; i < 16; ++i) { xv[i] = bf2f(*pr); pr += HLD; asm volatile("" : "+v"(pr)); }
#pragma unroll
                    for (int i = 0; i < 16; ++i) { const float y = w0 * x0 + w1 * x1 + w2 * x2 + w3 * xv[i]; dst[i * 65] = siluf_(y); x0 = x1; x1 = x2; x2 = xv[i]; } }
                for (int t = L; t < 64; ++t) dst[t * 65] = 0.f;
            }
        }
        LBAR();
        if (act) {
            { const int rowid = gt >> 1, t = rowid & 63, part = rowid >> 6, half = gt & 1; LAS float* base = (part == 0 ? qs : ks) + t * 65 + half * 32; float ss = 0.f;
#pragma unroll
              for (int i = 0; i < 32; ++i) ss += base[i] * base[i];
              ss += dpp_f<0xB1>(ss); const float rinv = rsqrtf(ss + 1e-6f) * (part == 0 ? 0.125f : 1.0f);
#pragma unroll
              for (int i = 0; i < 32; ++i) base[i] *= rinv; }
            if (gt < 64) { const int t = gt; float beta = 0.f, g = 0.f;
                if (t < L) { const bf16* hr = H + (seq0 + (size_t)ch * 64 + t) * HLD; const float braw = bf2f(hr[C_B + h]), araw = bf2f(hr[C_A + h]);
                    beta = sigmoidf_(braw); const float x = araw + KIN(15)[l * 4 + h]; const float sp = x > 20.f ? x : __logf(1.0f + __expf(x)); g = -__expf(KIN(14)[l * 4 + h]) * sp; }
                bs[t] = beta; gs[t] = g; }
        }
        LBAR();
#ifdef PROBE_SOLVE
        if (pass_ == 0) {
#endif
        if (act && gt == 0) { float gg[64];
#pragma unroll
            for (int t = 0; t < 64; ++t) gg[t] = gs[t];
            float run = 0.f;
#pragma unroll
            for (int t = 0; t < 64; ++t) { run += gg[t]; Gs[t] = run; } }
        LBAR();
        if (act) {
            { const int mi = gt >> 6, ln = gt & 63, fr = ln & 15, fq = ln >> 4;
              bf16x8 ak[2], aq[2];
#pragma unroll
              for (int kk = 0; kk < 2; ++kk) { const LAS float* pk = ks + (16 * mi + fr) * 65 + 32 * kk + fq * 8; const LAS float* pq = qs + (16 * mi + fr) * 65 + 32 * kk + fq * 8;
                  u32x4 wk, wq; wk.x = pk2(pk[0], pk[1]); wk.y = pk2(pk[2], pk[3]); wk.z = pk2(pk[4], pk[5]); wk.w = pk2(pk[6], pk[7]);
                  wq.x = pk2(pq[0], pq[1]); wq.y = pk2(pq[2], pq[3]); wq.z = pk2(pq[4], pq[5]); wq.w = pk2(pq[6], pq[7]);
                  ak[kk] = __builtin_bit_cast(bf16x8, wk); aq[kk] = __builtin_bit_cast(bf16x8, wq); }
#pragma unroll
              for (int nj = 0; nj < 4; ++nj) { f32x4 ckk = {0.f, 0.f, 0.f, 0.f}, cqk = {0.f, 0.f, 0.f, 0.f};
                  if (nj <= mi && 16 * mi < L) {
#pragma unroll
                      for (int kk = 0; kk < 2; ++kk) { const LAS float* pb = ks + (16 * nj + fr) * 65 + 32 * kk + fq * 8;
                          u32x4 wb; wb.x = pk2(pb[0], pb[1]); wb.y = pk2(pb[2], pb[3]); wb.z = pk2(pb[4], pb[5]); wb.w = pk2(pb[6], pb[7]);
                          const bf16x8 bfr = __builtin_bit_cast(bf16x8, wb); ckk = mfma16(ak[kk], bfr, ckk); cqk = mfma16(aq[kk], bfr, cqk); } }
                  const int jc = 16 * nj + fr; const float gj = Gs[jc];
#pragma unroll
                  for (int j = 0; j < 4; ++j) { const int i = 16 * mi + fq * 4 + j; const float dec = (i >= jc) ? __expf(Gs[i] - gj) : 0.f;
                      As[i * 64 + jc] = (i > jc) ? bs[i] * ckk[j] * dec : 0.f; QKd[i * 64 + jc] = (bf16)f2bf(cqk[j] * dec); } } }
        }
        LBAR();
        if (act) {
            const float glast = Gs[63];
            for (int e = gt; e < 4096; e += 256) { const int hi = e >> 6, lo = e & 63;
                KdT[e] = (bf16)f2bf(ks[lo * 65 + hi] * __expf(glast - Gs[lo]));
                QG[e] = (bf16)f2bf(qs[hi * 65 + lo] * __expf(Gs[hi])); }
            if (gt == 0) *(float*)(ub + 49152) = __expf(glast);
        }
        LBAR();
#ifdef PROBE_SOLVE
        }
#endif
        if (act) {
            for (int e = gt; e < 8192; e += 256) { const int i = e >> 7, c = e & 127; LAS float* p = ((c < 64) ? ks : vs) + i * 65 + (c & 63);
                *p = *p * bs[i] * ((c < 64) ? __expf(Gs[i]) : 1.0f); }
        }
        LBAR();
#pragma unroll 1
        for (int R = 0; R < 4; ++R) {
            if (act && R > 0 && 16 * R < L) {
                const int wv = gt >> 6, ln = gt & 63, fr = ln & 15, fq = ln >> 4, nkk = (16 * R + 31) >> 5;
                bf16x8 af[2];
#pragma unroll
                for (int kk = 0; kk < 2; ++kk) { u32x4 w = {0u, 0u, 0u, 0u};
                    if (kk < nkk && 32 * kk + fq * 8 < 16 * R) { const LAS float* pa = As + (16 * R + fr) * 64 + 32 * kk + fq * 8; const f32x4 a0 = *(const LAS f32x4*)pa, a1 = *(const LAS f32x4*)(pa + 4);
                        w.x = pk2(a0[0], a0[1]); w.y = pk2(a0[2], a0[3]); w.z = pk2(a1[0], a1[1]); w.w = pk2(a1[2], a1[3]); }
                    af[kk] = __builtin_bit_cast(bf16x8, w); }
#pragma unroll
                for (int t = 0; t < 2; ++t) { const int nt = 2 * wv + t; LAS float* xb = ((nt < 4) ? ks : vs) + 16 * (nt & 3) + fr;
                    f32x4 acc = {0.f, 0.f, 0.f, 0.f};
#pragma unroll
                    for (int kk = 0; kk < 2; ++kk) if (kk < nkk) { const LAS float* pb = xb + (32 * kk + fq * 8) * 65;
                        u32x4 w; w.x = pk2(pb[0], pb[65]); w.y = pk2(pb[130], pb[195]); w.z = pk2(pb[260], pb[325]); w.w = pk2(pb[390], pb[455]);
                        acc = mfma16(af[kk], __builtin_bit_cast(bf16x8, w), acc); }
#pragma unroll
                    for (int j = 0; j < 4; ++j) xb[(16 * R + fq * 4 + j) * 65] -= acc[j]; }
            }
            LBAR();
            if (act && gt < 128) { const int c = gt; LAS float* col = ((c < 64) ? ks : vs) + (c & 63) + (16 * R) * 65; const LAS float* Dg = As + (16 * R) * 64 + 16 * R;
                float x[16];
                if (16 * R >= L) {
#pragma unroll
                    for (int a = 0; a < 16; ++a) x[a] = 0.f;
                } else {
#pragma unroll
                for (int a = 0; a < 16; ++a) { float v = col[a * 65];
                    f32x4 d[4];
#pragma unroll
                    for (int q4 = 0; q4 < 4; ++q4) if (4 * q4 < a) d[q4] = *(const LAS f32x4*)(Dg + a * 64 + 4 * q4);
#pragma unroll
                    for (int q = 0; q < a; ++q) v -= d[q >> 2][q & 3] * x[q];
                    x[a] = v; if ((a & 3) == 3) __builtin_amdgcn_sched_barrier(0); } }
#pragma unroll
                for (int a = 0; a < 16; ++a) { col[a * 65] = x[a];
                    if (c < 64) Wd[(16 * R + a) * 64 + c] = (bf16)f2bf(x[a]); else Uv[(16 * R + a) * 64 + (c - 64)] = x[a]; }
            }
            LBAR();
        }
#ifdef PROBE_SOLVE
        }
#endif
    }
}

__device__ __forceinline__ bf16x8 ldA2(const bf16* Mx, int row, int kk, int fq) {
    const bf16* p = Mx + row * 64 + 32 * kk + fq * 4; const s16x4 a = *(const s16x4*)p, b = *(const s16x4*)(p + 16);
    bf16x8 r; r[0] = a[0]; r[1] = a[1]; r[2] = a[2]; r[3] = a[3]; r[4] = b[0]; r[5] = b[1]; r[6] = b[2]; r[7] = b[3]; return r;
}
__device__ __forceinline__ void split8(const f32x4& lo4, const f32x4& hi4, bf16x8& h, bf16x8& lw) {
    u32x4 hw; hw.x = pk2(lo4[0], lo4[1]); hw.y = pk2(lo4[2], lo4[3]); hw.z = pk2(hi4[0], hi4[1]); hw.w = pk2(hi4[2], hi4[3]);
    h = __builtin_bit_cast(bf16x8, hw);
    if (GDN_SPLIT) {
        u32x4 lo; lo.x = pk2(lo4[0] - bf2f(hw.x & 0xffffu), lo4[1] - __builtin_bit_cast(float, hw.x & 0xffff0000u)); lo.y = pk2(lo4[2] - bf2f(hw.y & 0xffffu), lo4[3] - __builtin_bit_cast(float, hw.y & 0xffff0000u));
        lo.z = pk2(hi4[0] - bf2f(hw.z & 0xffffu), hi4[1] - __builtin_bit_cast(float, hw.z & 0xffff0000u)); lo.w = pk2(hi4[2] - bf2f(hw.w & 0xffffu), hi4[3] - __builtin_bit_cast(float, hw.w & 0xffff0000u));
        lw = __builtin_bit_cast(bf16x8, lo);
    } else lw = h;
}
constexpr int G2_MAT = 9216, G2_UV = 4 * G2_MAT, G2_Z = G2_UV + 64 * 272, G2_GAM = G2_Z + 9216, G2_BUF = G2_GAM + 16, G2_RED = 2 * G2_BUF;
static_assert(G2_RED + 2048 <= LDS_BYTES, "g2 lds");
__device__ __forceinline__ bf16x8 ldA2s(const LAS unsigned char* mat, int row, int kk, int fq) {
    const LAS unsigned char* p = mat + row * 144 + 64 * kk + fq * 8; const s16x4 a = *(const LAS s16x4*)p, b = *(const LAS s16x4*)(p + 32);
    bf16x8 r; r[0] = a[0]; r[1] = a[1]; r[2] = a[2]; r[3] = a[3]; r[4] = b[0]; r[5] = b[1]; r[6] = b[2]; r[7] = b[3]; return r;
}
__device__ __forceinline__ void g2_stage(LAS unsigned char* buf, const unsigned char* ub, const bf16* zsrc  , int ht, int nthr) {
    for (int c = ht; c < 2048; c += nthr) { const int mat = c >> 9, w = c & 511, row = w >> 3, seg = w & 7;
        *(LAS u32x4*)(buf + mat * G2_MAT + row * 144 + seg * 16) = *(const u32x4*)(ub + mat * 8192 + row * 128 + seg * 16); }
    for (int c = ht; c < 1024; c += nthr) { const int row = c >> 4, seg = c & 15;
        *(LAS u32x4*)(buf + G2_UV + row * 272 + seg * 16) = *(const u32x4*)(ub + 32768 + row * 256 + seg * 16); }
    for (int c = ht; c < 512; c += nthr) { const int row = c >> 3, seg = c & 7;
        *(LAS u32x4*)(buf + G2_Z + row * 144 + seg * 16) = *(const u32x4*)((const unsigned char*)(zsrc + (size_t)row * HLD) + seg * 16); }
    if (ht == 0) *(LAS float*)(buf + G2_GAM) = *(const float*)(ub + 49152);
}
__device__ __forceinline__ void g2_load(u32x4 (&r)[14], float& gam, const unsigned char* ub, const bf16* zsrc, int ht) {
    const unsigned go = 16u * ht, gz = (ht >> 3) * (HLD * 2) + (ht & 7) * 16;
#pragma unroll
    for (int i = 0; i < 8; ++i) r[i] = *(const u32x4*)(ub + i * 4096 + go);
#pragma unroll
    for (int i = 0; i < 4; ++i) r[8 + i] = *(const u32x4*)(ub + 32768 + i * 4096 + go);
#pragma unroll
    for (int i = 0; i < 2; ++i) r[12 + i] = *(const u32x4*)((const unsigned char*)zsrc + (size_t)i * 32 * HLD * 2 + gz);
    gam = *(const float*)(ub + 49152);
}
__device__ __forceinline__ void g2_store(LAS unsigned char* buf, const u32x4 (&r)[14], float gam, int ht) {
    LAS unsigned char* lm = buf + (ht >> 3) * 144 + (ht & 7) * 16; LAS unsigned char* lu = buf + G2_UV + (ht >> 4) * 272 + (ht & 15) * 16;
#pragma unroll
    for (int i = 0; i < 8; ++i) *(LAS u32x4*)(lm + (i >> 1) * G2_MAT + (i & 1) * 32 * 144) = r[i];
#pragma unroll
    for (int i = 0; i < 4; ++i) *(LAS u32x4*)(lu + i * 16 * 272) = r[8 + i];
#pragma unroll
    for (int i = 0; i < 2; ++i) *(LAS u32x4*)(lm + G2_Z + i * 32 * 144) = r[12 + i];
    if (ht == 0) *(LAS float*)(buf + G2_GAM) = gam;
}
#define G2_BAR() asm volatile("s_waitcnt lgkmcnt(0)\n\ts_barrier" ::: "memory")
__device__ __forceinline__ void g2_phase(const PP P, int l, LAS unsigned char* lds) {
    const int tid = P.tid, lane = tid & 63, wave = tid >> 6, fr = lane & 15, fq = lane >> 4, G = P.G;
    LAS float* red = (LAS float*)(lds + G2_RED);
    const bf16* H = (const bf16*)(P.ws + WS_H); bf16* MIX = (bf16*)(P.ws + WS_MIX);
    for (int u = P.bid; u < 192; u += G) {
        const bool smp = u >= 64; const int bh = smp ? u - 64 : u, b = bh >> 2, h = bh & 3, nch = smp ? 1 : 32, L = smp ? 16 : 64;
        const size_t seq0 = smp ? (size_t)MP + b * 16 : (size_t)b * 2048; const int gu0 = smp ? 2048 + bh : bh * 32;
        const bool act = wave < 4; const int dv = 16 * (wave & 3) + fr;
        const unsigned char* gs0 = P.ws + WS_GSCR + (size_t)gu0 * GUNIT; const bf16* z0 = H + seq0 * HLD + C_Z + h * 64;
        f32x4 S[4];
#pragma unroll
        for (int m = 0; m < 4; ++m)
#pragma unroll
            for (int j = 0; j < 4; ++j) S[m][j] = (smp && act) ? KIN(4)[(((size_t)(l * 32 + b) * 4 + h) * 64 + (16 * m + fq * 4 + j)) * 64 + dv] : 0.f;
        const float gnw = KIN(16)[l * 64 + dv];
        g2_stage(lds, gs0, z0, tid, 512);
        u32x4 hr_[14]; float hgam = 0.f;
#pragma unroll
        for (int i = 0; i < 14; ++i) hr_[i] = (u32x4){0u, 0u, 0u, 0u};
        if (!act && nch > 1) g2_load(hr_, hgam, gs0 + GUNIT, z0 + (size_t)64 * HLD, tid - 256);
        G2_BAR();
        for (int n = 0; n < nch; ++n) {
            LAS unsigned char* buf = lds + (n & 1) * G2_BUF;
            f32x4 O[4]; float zr[4][4];
            if (!act) {
                if (n + 1 < nch) g2_store(lds + ((n + 1) & 1) * G2_BUF, hr_, hgam, tid - 256);
                if (n + 2 < nch) g2_load(hr_, hgam, gs0 + (size_t)(n + 2) * GUNIT, z0 + (size_t)(n + 2) * 64 * HLD, tid - 256);
            } else {
                bf16x8 Sh[2], Sl[2]; split8(S[0], S[1], Sh[0], Sl[0]); split8(S[2], S[3], Sh[1], Sl[1]);
                f32x4 U[4];
#pragma unroll
                for (int mi = 0; mi < 4; ++mi) { f32x4 acc = {0.f, 0.f, 0.f, 0.f};
#pragma unroll
                    for (int kk = 0; kk < 2; ++kk) { const bf16x8 a = ldA2s(buf, 16 * mi + fr, kk, fq); acc = mfma16(a, Sh[kk], acc); if (GDN_SPLIT) acc = mfma16(a, Sl[kk], acc); }
#pragma unroll
                    for (int j = 0; j < 4; ++j) { const int i = 16 * mi + fq * 4 + j; U[mi][j] = *(const LAS float*)(buf + G2_UV + i * 272 + dv * 4) - acc[j];
                        zr[mi][j] = bf2f(*(const LAS bf16*)(buf + G2_Z + i * 144 + dv * 2)); } }
                bf16x8 Uh[2], Ul[2]; split8(U[0], U[1], Uh[0], Ul[0]); split8(U[2], U[3], Uh[1], Ul[1]);
#pragma unroll
                for (int mi = 0; mi < 4; ++mi) { f32x4 acc = {0.f, 0.f, 0.f, 0.f};
#pragma unroll
                    for (int kk = 0; kk < 2; ++kk) { const bf16x8 a = ldA2s(buf + 3 * G2_MAT, 16 * mi + fr, kk, fq); acc = mfma16(a, Sh[kk], acc); if (GDN_SPLIT) acc = mfma16(a, Sl[kk], acc);
                        const bf16x8 a2 = ldA2s(buf + G2_MAT, 16 * mi + fr, kk, fq); acc = mfma16(a2, Uh[kk], acc); if (GDN_SPLIT) acc = mfma16(a2, Ul[kk], acc); }
                    O[mi] = acc; }
                const float gamL = *(const LAS float*)(buf + G2_GAM);
#pragma unroll
                for (int m = 0; m < 4; ++m) { f32x4 acc = S[m] * gamL;
#pragma unroll
                    for (int kk = 0; kk < 2; ++kk) { const bf16x8 a = ldA2s(buf + 2 * G2_MAT, 16 * m + fr, kk, fq); acc = mfma16(a, Uh[kk], acc); if (GDN_SPLIT) acc = mfma16(a, Ul[kk], acc); }
                    S[m] = acc; }
#pragma unroll
                for (int mi = 0; mi < 4; ++mi)
#pragma unroll
                    for (int j = 0; j < 4; ++j) { const float s = row16_sum(O[mi][j] * O[mi][j]);
                        if (fr == 0) red[(n & 1) * 256 + wave * 64 + 16 * mi + fq * 4 + j] = s; }
            }
            G2_BAR();
            if (act) {
#pragma unroll
                for (int mi = 0; mi < 4; ++mi)
#pragma unroll
                    for (int j = 0; j < 4; ++j) { const int i = 16 * mi + fq * 4 + j; LAS float* rp = red + (n & 1) * 256 + i;
                        const float tot = rp[0] + rp[64] + rp[128] + rp[192]; const float rinv = rsqrtf(tot * (1.0f / 64.0f) + 1e-6f);
                        if (i < L) { const size_t row = seq0 + (size_t)n * 64 + i;
                            MIX[row * 1024 + 512 + h * 64 + dv] = (bf16)f2bf(O[mi][j] * rinv * gnw * siluf_(zr[mi][j])); } }
            }
        }
        if (act) { float* so = smp ? P.out + O_GDNS + ((size_t)(l * 32 + b) * 4 + h) * 4096 : P.out + O_GDNP + ((size_t)(l * 16 + b) * 4 + h) * 4096;
#pragma unroll
            for (int m = 0; m < 4; ++m)
#pragma unroll
                for (int j = 0; j < 4; ++j) so[(16 * m + fq * 4 + j) * 64 + dv] = S[m][j]; }
        __syncthreads();
    }
}

constexpr int AT_KROW = 208, AT_VROW = 144, AT_V = 64 * AT_KROW, AT_STAGE = AT_V + 64 * AT_VROW, AT_COMB = 2 * AT_STAGE;
static_assert(AT_COMB + 8 * 64 * 18 * 4 <= LDS_BYTES, "attn lds");
__device__ __forceinline__ void attn_prompt_unit(const PP P, LAS unsigned char* lds, int b, int h, int qt) {
    const int tid = P.tid, lane = tid & 63, wave = tid >> 6, fr = lane & 15, fq = lane >> 4;
    const bf16* Q = (const bf16*)(P.ws + WS_XB); const bf16* KN = (const bf16*)(P.ws + WS_KN); const bf16* VT = (const bf16*)(P.ws + WS_VT);
    const bf16* KPEB = (const bf16*)(P.ws + WS_KPEB); bf16* MIX = (bf16*)(P.ws + WS_MIX);
    const int qrow0 = b * 2048 + 256 * qt + 32 * wave, keybase = b * 2048;
    const int nt_blk = 4 * qt + 4, nt_w = 4 * qt + (wave >> 1) + 1;
    bf16x8 Qb[2][3];
#pragma unroll
    for (int g = 0; g < 2; ++g)
#pragma unroll
        for (int ks = 0; ks < 3; ++ks) Qb[g][ks] = *(const bf16x8*)(Q + (size_t)(qrow0 + 16 * g + fr) * 768 + h * 96 + 32 * ks + fq * 8);
    float m[2] = {-INFINITY, -INFINITY}, lsum[2] = {0.f, 0.f}; f32x4 O[2][4];
#pragma unroll
    for (int g = 0; g < 2; ++g)
#pragma unroll
        for (int nt = 0; nt < 4; ++nt) O[g][nt] = (f32x4){0.f, 0.f, 0.f, 0.f};
    const int r8 = tid >> 3, s8 = tid & 7, r4 = (tid & 255) >> 2, s4 = tid & 3;
    const bf16* gk = KN + (size_t)(keybase + r8) * 512 + h * 64 + s8 * 8;
    const bf16* gp = KPEB + (size_t)(keybase + r4) * 32 + s4 * 8;
    const bf16* gv = VT + (size_t)(h * 64 + r8) * NK + keybase + s8 * 8;
    const int lk = r8 * AT_KROW + s8 * 16, lp = r4 * AT_KROW + 128 + s4 * 16, lv = AT_V + r8 * AT_VROW + s8 * 16;
    u32x4 rk = *(const u32x4*)gk, rv = *(const u32x4*)gv, rp = {0u, 0u, 0u, 0u}; if (tid < 256) rp = *(const u32x4*)gp;
    *(LAS u32x4*)(lds + lk) = rk; *(LAS u32x4*)(lds + lv) = rv; if (tid < 256) *(LAS u32x4*)(lds + lp) = rp;
    __syncthreads();
    for (int kt = 0; kt < nt_blk; ++kt) {
        const bool more = kt + 1 < nt_blk;
        if (more) { rk = *(const u32x4*)(gk + (size_t)(kt + 1) * 64 * 512); rv = *(const u32x4*)(gv + (kt + 1) * 64); if (tid < 256) rp = *(const u32x4*)(gp + (size_t)(kt + 1) * 64 * 32); }
        if (kt < nt_w) {
            const LAS unsigned char* kb = lds + (kt & 1) * AT_STAGE; const LAS unsigned char* vb = kb + AT_V;
            f32x4 s[2][4];
#pragma unroll
            for (int sb = 0; sb < 4; ++sb) { s[0][sb] = (f32x4){0.f, 0.f, 0.f, 0.f}; s[1][sb] = (f32x4){0.f, 0.f, 0.f, 0.f};
#pragma unroll
                for (int ks = 0; ks < 3; ++ks) { const bf16x8 kf = *(const LAS bf16x8*)(kb + (16 * sb + fr) * AT_KROW + ks * 64 + fq * 16);
                    s[0][sb] = mfma16(kf, Qb[0][ks], s[0][sb]); s[1][sb] = mfma16(kf, Qb[1][ks], s[1][sb]); } }
            bf16x8 Pb[2][2];
#pragma unroll
            for (int g = 0; g < 2; ++g) {
                float mx = -INFINITY;
#pragma unroll
                for (int sb = 0; sb < 4; ++sb) mx = fmaxf(mx, fmaxf(fmaxf(s[g][sb][0], s[g][sb][1]), fmaxf(s[g][sb][2], s[g][sb][3])));
                mx = fmaxf(mx, xor16_get(mx)); mx = xor32_max(mx);
                const float mnew = fmaxf(m[g], mx), alpha = __builtin_amdgcn_exp2f(m[g] - mnew); m[g] = mnew;
                float ps = 0.f; float p[4][4];
#pragma unroll
                for (int sb = 0; sb < 4; ++sb)
#pragma unroll
                    for (int j = 0; j < 4; ++j) { p[sb][j] = __builtin_amdgcn_exp2f(s[g][sb][j] - mnew); ps += p[sb][j]; }
                lsum[g] = lsum[g] * alpha + ps;
#pragma unroll
                for (int kk = 0; kk < 2; ++kk) { u32x4 pw; pw.x = pk2(p[2 * kk][0], p[2 * kk][1]); pw.y = pk2(p[2 * kk][2], p[2 * kk][3]); pw.z = pk2(p[2 * kk + 1][0], p[2 * kk + 1][1]); pw.w = pk2(p[2 * kk + 1][2], p[2 * kk + 1][3]);
                    Pb[g][kk] = __builtin_bit_cast(bf16x8, pw); }
#pragma unroll
                for (int nt = 0; nt < 4; ++nt) O[g][nt] = O[g][nt] * alpha;
            }
#pragma unroll
            for (int nt = 0; nt < 4; ++nt)
#pragma unroll
                for (int kk = 0; kk < 2; ++kk) { const LAS unsigned char* vp = vb + (16 * nt + fr) * AT_VROW + kk * 64 + fq * 8;
                    const s16x4 a = *(const LAS s16x4*)vp, c = *(const LAS s16x4*)(vp + 32);
                    bf16x8 vf; vf[0] = a[0]; vf[1] = a[1]; vf[2] = a[2]; vf[3] = a[3]; vf[4] = c[0]; vf[5] = c[1]; vf[6] = c[2]; vf[7] = c[3];
                    O[0][nt] = mfma16(vf, Pb[0][kk], O[0][nt]); O[1][nt] = mfma16(vf, Pb[1][kk], O[1][nt]); }
        }
        if (more) { LAS unsigned char* nb = lds + ((kt + 1) & 1) * AT_STAGE; *(LAS u32x4*)(nb + lk) = rk; *(LAS u32x4*)(nb + lv) = rv; if (tid < 256) *(LAS u32x4*)(nb + lp) = rp; }
        __syncthreads();
    }
#pragma unroll
    for (int g = 0; g < 2; ++g) { float lt = lsum[g]; lt += xor16_get(lt); lt = xor32_sum(lt); const float inv = 1.0f / lt;
#pragma unroll
        for (int nt = 0; nt < 4; ++nt) { u32x2 w; w.x = pk2(O[g][nt][0] * inv, O[g][nt][1] * inv); w.y = pk2(O[g][nt][2] * inv, O[g][nt][3] * inv);
            *(u32x2*)(MIX + (size_t)(qrow0 + 16 * g + fr) * 1024 + h * 64 + 16 * nt + fq * 4) = w; } }
}
__device__ __forceinline__ void attn_sample_unit(const PP P, LAS unsigned char* lds, int b, int h) {
    const int tid = P.tid, lane = tid & 63, wave = tid >> 6, fr = lane & 15, fq = lane >> 4;
    const bf16* Q = (const bf16*)(P.ws + WS_XB); const bf16* KN = (const bf16*)(P.ws + WS_KN); const bf16* VT = (const bf16*)(P.ws + WS_VT);
    const bf16* KPEB = (const bf16*)(P.ws + WS_KPEB); bf16* MIX = (bf16*)(P.ws + WS_MIX);
    const int qrow0 = MP + b * 16, keybase = MP, nkeys = SKS;
    const bf16* qp = Q + (size_t)(qrow0 + fr) * 768 + h * 96 + fq * 8;
    bf16x8 Qb[3];
#pragma unroll
    for (int ks = 0; ks < 3; ++ks) Qb[ks] = *(const bf16x8*)(qp + 32 * ks);
    float m = -INFINITY, lsum = 0.f; f32x4 O[4];
#pragma unroll
    for (int nt = 0; nt < 4; ++nt) O[nt] = (f32x4){0.f, 0.f, 0.f, 0.f};
    const int nblk = (nkeys + 31) >> 5, kb0 = (wave * nblk) >> 3, kb1 = ((wave + 1) * nblk) >> 3;
    for (int kb = kb0; kb < kb1; ++kb) {
        f32x4 s[2]; int kof[2];
#pragma unroll
        for (int sub = 0; sub < 2; ++sub) { const int key0 = kb * 32 + sub * 16; const bool valid = key0 < nkeys; kof[sub] = (valid && key0 >= 2048) ? 65536 + b * 16 + (key0 - 2048) : b * 2048 + (valid ? key0 : 0);
            const size_t kr = (size_t)keybase + kof[sub] + fr;
            const bf16x8 a0 = *(const bf16x8*)(KN + kr * 512 + h * 64 + fq * 8), a1 = *(const bf16x8*)(KN + kr * 512 + h * 64 + 32 + fq * 8), a2 = *(const bf16x8*)(KPEB + kr * 32 + fq * 8);
            f32x4 acc = {0.f, 0.f, 0.f, 0.f}; acc = mfma16(a0, Qb[0], acc); acc = mfma16(a1, Qb[1], acc); acc = mfma16(a2, Qb[2], acc);
            if (!valid) acc = (f32x4){-INFINITY, -INFINITY, -INFINITY, -INFINITY};
            s[sub] = acc; }
        float mx = fmaxf(fmaxf(fmaxf(s[0][0], s[0][1]), fmaxf(s[0][2], s[0][3])), fmaxf(fmaxf(s[1][0], s[1][1]), fmaxf(s[1][2], s[1][3])));
        mx = fmaxf(mx, xor16_get(mx)); mx = xor32_max(mx);
        const float mnew = fmaxf(m, mx); const float alpha = __builtin_amdgcn_exp2f(m - mnew); m = mnew;
        float p[8]; float ps = 0.f;
#pragma unroll
        for (int j = 0; j < 4; ++j) { p[j] = __builtin_amdgcn_exp2f(s[0][j] - mnew); p[4 + j] = __builtin_amdgcn_exp2f(s[1][j] - mnew); ps += p[j] + p[4 + j]; }
        lsum = lsum * alpha + ps;
        u32x4 pw; pw.x = pk2(p[0], p[1]); pw.y = pk2(p[2], p[3]); pw.z = pk2(p[4], p[5]); pw.w = pk2(p[6], p[7]);
        const bf16x8 Pb = __builtin_bit_cast(bf16x8, pw);
#pragma unroll
        for (int nt = 0; nt < 4; ++nt) { const bf16* vrow = VT + (size_t)(h * 64 + 16 * nt + fr) * NK + keybase + fq * 4;
            const s16x4 a = *(const s16x4*)(vrow + kof[0]), c = *(const s16x4*)(vrow + kof[1]);
            bf16x8 va; va[0] = a[0]; va[1] = a[1]; va[2] = a[2]; va[3] = a[3]; va[4] = c[0]; va[5] = c[1]; va[6] = c[2]; va[7] = c[3];
            O[nt] = mfma16(va, Pb, O[nt] * alpha); }
    }
    float lt = lsum; lt += xor16_get(lt); lt = xor32_sum(lt);
    LAS float* cb = (LAS float*)(lds + AT_COMB) + (wave * 64 + lane) * 18;
#pragma unroll
    for (int nt = 0; nt < 4; ++nt)
#pragma unroll
        for (int j = 0; j < 4; ++j) cb[nt * 4 + j] = O[nt][j];
    cb[16] = m; cb[17] = lt;
    __syncthreads();
    if (wave == 0) {
        float mm = -INFINITY;
#pragma unroll
        for (int w = 0; w < 8; ++w) mm = fmaxf(mm, ((LAS float*)(lds + AT_COMB))[(w * 64 + lane) * 18 + 16]);
        float L = 0.f; float acc[16];
#pragma unroll
        for (int i = 0; i < 16; ++i) acc[i] = 0.f;
#pragma unroll
        for (int w = 0; w < 8; ++w) { const LAS float* pp = (LAS float*)(lds + AT_COMB) + (w * 64 + lane) * 18; const float sc = __builtin_amdgcn_exp2f(pp[16] - mm); L += pp[17] * sc;
#pragma unroll
            for (int i = 0; i < 16; ++i) acc[i] += pp[i] * sc; }
        const float inv = 1.0f / L;
#pragma unroll
        for (int nt = 0; nt < 4; ++nt) { u32x2 w; w.x = pk2(acc[nt * 4] * inv, acc[nt * 4 + 1] * inv); w.y = pk2(acc[nt * 4 + 2] * inv, acc[nt * 4 + 3] * inv);
            *(u32x2*)(MIX + (size_t)(qrow0 + fr) * 1024 + h * 64 + 16 * nt + fq * 4) = w; }
    }
    __syncthreads();
}
__device__ __forceinline__ void attn_phase(const PP P, LAS unsigned char* lds) {
    const int G = P.G;
    for (int u = P.bid; u < 256 + 1024; u += G) {
        if (u < 256) { attn_sample_unit(P, lds, u >> 3, u & 7); }
        else { const int v = u - 256, bh = v & 127, half = (v >> 7) & 1, k = v >> 8;
            const int qt = (k == 0) ? 7 - half : (k == 1) ? half : (k == 2) ? 5 - half : 2 + half;
            attn_prompt_unit(P, lds, bh >> 3, bh & 7, qt); }
    }
}

__device__ __forceinline__ void ln_phase(const PP P, const float* g, const float* bta) {
    const int tid = P.tid, lane = tid & 63, wave = tid >> 6, G = P.G;
    float* X = P.out; bf16* XB = (bf16*)(P.ws + WS_XB);
    for (int row = P.bid * 8 + wave; row < MT; row += G * 8) {
        float* p = X + (size_t)row * 1024; f32x4 v[4]; float s = 0.f;
#pragma unroll
        for (int i = 0; i < 4; ++i) { v[i] = *(const f32x4*)(p + 256 * i + lane * 4); s += (v[i][0] + v[i][1]) + (v[i][2] + v[i][3]); }
        const float mu = wave_sum(s) * (1.0f / 1024.0f); float q = 0.f;
#pragma unroll
        for (int i = 0; i < 4; ++i) { const f32x4 d = v[i] - mu; q += (d[0] * d[0] + d[1] * d[1]) + (d[2] * d[2] + d[3] * d[3]); }
        const float rstd = rsqrtf(wave_sum(q) * (1.0f / 1024.0f) + 1e-5f);
#pragma unroll
        for (int i = 0; i < 4; ++i) { const int col = 256 * i + lane * 4; const f32x4 gg = *(const f32x4*)(g + col), bb = *(const f32x4*)(bta + col);
            const f32x4 y = (v[i] - mu) * rstd * gg + bb; *(f32x4*)(p + col) = y;
            u32x2 w; w.x = pk2(y[0], y[1]); w.y = pk2(y[2], y[3]); *(u32x2*)(XB + (size_t)row * 1024 + col) = w; }
    }
}

__device__ __forceinline__ void sample_gemm_res(const PP P, LAS unsigned char* lds, const bf16* A  , const bf16* Bt, int K, const float* xin  , float* Xs  ) {
    const int tid = P.tid, lane = tid & 63, wave = tid >> 6, fr = lane & 15, fq = lane >> 4;
    LAS float* part = (LAS float*)lds;
    for (int t = P.bid; t < 256; t += P.G) {
        const int r0 = (t >> 4) * 32, c0 = (t & 15) * 64, kw = K >> 3, kb = wave * kw;
        f32x4 acc[2][4];
#pragma unroll
        for (int a = 0; a < 2; ++a)
#pragma unroll
            for (int n = 0; n < 4; ++n) acc[a][n] = (f32x4){0.f, 0.f, 0.f, 0.f};
        const bf16* ap = A + (size_t)(r0 + fr) * K + kb + fq * 8; const bf16* bp = Bt + (size_t)(c0 + fr) * K + kb + fq * 8;
#pragma unroll 2
        for (int k0 = 0; k0 < kw; k0 += 32) {
            bf16x8 af[2], bf_[4];
#pragma unroll
            for (int a = 0; a < 2; ++a) af[a] = *(const bf16x8*)(ap + (size_t)(16 * a) * K + k0);
#pragma unroll
            for (int n = 0; n < 4; ++n) bf_[n] = *(const bf16x8*)(bp + (size_t)(16 * n) * K + k0);
#pragma unroll
            for (int a = 0; a < 2; ++a)
#pragma unroll
                for (int n = 0; n < 4; ++n) acc[a][n] = mfma16(af[a], bf_[n], acc[a][n]);
        }
        LAS float* mp = part + (wave * 64 + lane) * 33;
#pragma unroll
        for (int a = 0; a < 2; ++a)
#pragma unroll
            for (int n = 0; n < 4; ++n)
#pragma unroll
                for (int j = 0; j < 4; ++j) mp[(a * 4 + n) * 4 + j] = acc[a][n][j];
        __syncthreads();
        { const int grp = wave;
          float sum[4] = {0.f, 0.f, 0.f, 0.f};
#pragma unroll
          for (int w = 0; w < 8; ++w)
#pragma unroll
              for (int j = 0; j < 4; ++j) sum[j] += part[(w * 64 + lane) * 33 + 4 * grp + j];
          const int a = grp >> 2, n = grp & 3, col = c0 + 16 * n + fr;
#pragma unroll
          for (int j = 0; j < 4; ++j) { const int row = r0 + 16 * a + fq * 4 + j; Xs[(size_t)row * 1024 + col] = DN_ALPHA * xin[(size_t)row * 1024 + col] + sum[j]; } }
        __syncthreads();
    }
}

#define GB_LD(p) __hip_atomic_load((p), __ATOMIC_RELAXED, __HIP_MEMORY_SCOPE_AGENT)
#define GB_ADD(p) __hip_atomic_fetch_add((p), 1u, __ATOMIC_RELAXED, __HIP_MEMORY_SCOPE_AGENT)
#define GB_ST(p, v) __hip_atomic_store((p), (v), __ATOMIC_RELAXED, __HIP_MEMORY_SCOPE_AGENT)
__device__ __forceinline__ void fast_grid_bar(unsigned* bar, unsigned k  , int tid, int bid, int G) {
    asm volatile("s_waitcnt vmcnt(0)" ::: "memory");
    __syncthreads();
    if (tid == 0) {
        const unsigned ng = (G < 8) ? (unsigned)G : 8u, g = (unsigned)bid % ng, gsize = ((unsigned)G - g + ng - 1u) / ng;
        unsigned* sub = bar + 64 * g; unsigned* gen = bar + 64 * (8 + g); unsigned* top = bar + 64 * 16; unsigned* topgen = bar + 64 * 17;
        __builtin_amdgcn_fence(__ATOMIC_RELEASE, "agent");
        asm volatile("s_waitcnt vmcnt(0)" ::: "memory");
        const unsigned old = GB_ADD(sub); unsigned sp = 0;
        if (old + 1u == k * gsize) { const unsigned o2 = GB_ADD(top); if (o2 + 1u == k * ng) GB_ST(topgen, k); }
        while (GB_LD(topgen) < k) { __builtin_amdgcn_s_sleep(1); if (++sp > (1u << 24)) break; }
        __builtin_amdgcn_fence(__ATOMIC_ACQUIRE, "agent");
        asm volatile("s_waitcnt vmcnt(0)" ::: "memory");
    }
    __syncthreads();
}

__global__ void __launch_bounds__(512) mega(Params P) {
    extern __shared__ __attribute__((aligned(16))) unsigned char lds_raw[];
    LAS unsigned char* lds = (LAS unsigned char*)lds_raw;
    cg::grid_group grid = cg::this_grid();
    const int lo_ = P.lo, hi_ = P.hi; const int wave_s = __builtin_amdgcn_readfirstlane((int)(threadIdx.x >> 6));
    for (int step = lo_; step < hi_; ++step) {
        PP pp; pp.ws = KWS(); pp.out = KOUT(); unsigned char* ws = pp.ws;
        { int t_, b_ = blockIdx.x, g_ = gridDim.x; asm volatile("v_mbcnt_lo_u32_b32 %0, -1, 0\n\tv_mbcnt_hi_u32_b32 %0, -1, %0\n\tv_lshl_add_u32 %0, %3, 6, %0" : "=&v"(t_), "+s"(b_), "+s"(g_) : "s"(wave_s)); pp.tid = t_; pp.bid = b_; pp.G = g_; }
        int l = 0, kind = 0;
        if (REPK == 0) { if (step > 0) { l = (step - 1) / 10; kind = 1 + (step - 1) % 10; } }
        else if (step > 0) { l = (step - 1) / 11; const int kidx = (step - 1) % 11; kind = (kidx < REPK) ? kidx + 1 : kidx; if (kind == 6 && l == 1 && kidx == REPK) kind = 11; }
        const bf16* WB = (const bf16*)(ws + WS_W) + (size_t)l * W_LAYER;
        int nj = 0;
        PP pp2 = pp; const bool split = pp.G > 64; if (split) { pp2.bid = pp.bid - 64; pp2.G = pp.G - 64; }
        const bool shadow = !split || pp.bid >= 64;
        switch (kind) {
            case 0: prep_phase(pp, lds, 0, true); break;
            case 2: tok_phase(pp, l); g1_phase(pp, l, lds); break;
            case 3: g2_phase(pp, l, lds);
                     if (shadow) { conv_phase(pp2, l, lds); cache_phase(pp2, l); if (l == 0) prep_phase(pp2, lds, 1, false); nj = 1; }
                     break;
            case 5: attn_phase(pp, lds); break;
            case 7: ln_phase(pp, KIN(22) + l * 1024, KIN(23) + l * 1024); break;
            case 10: ln_phase(pp, KIN(27) + l * 1024, KIN(28) + l * 1024); break;
            case 4: nj = 3; break;
            case 11: break;
            default: nj = 1; break;
        }
        if (kind == 6 || kind == 9) {
            const float* xs_ = (kind == 6 && l == 0) ? KIN(1) : pp.out + (size_t)MP * 1024;
            if (kind == 6) sample_gemm_res(pp, lds, (const bf16*)(ws + WS_MIX) + (size_t)MP * 1024, WB + W_OUT, 1024, xs_, pp.out + (size_t)MP * 1024);
            else           sample_gemm_res(pp, lds, (const bf16*)(ws + WS_F) + (size_t)MP * DFF, WB + W_DN, DFF, xs_, pp.out + (size_t)MP * 1024);
        }
        for (int j = 0; j < nj; ++j) {
            pg8::Gemm g; bool perm; int mode; bf16* O = nullptr; size_t ldc = 0;
            if (kind == 1)      { g = pg8::Gemm{(const bf16*)(ws + WS_XB), WB + W_IN, MT, HLD, 1024}; perm = true; mode = 0; O = (bf16*)(ws + WS_H); ldc = HLD; }
            else if (kind == 3) { g = pg8::Gemm{(const bf16*)(ws + WS_CQN), WB + W_UQ, MT, 768, 384}; perm = false; mode = 2; O = (bf16*)(ws + WS_XB); ldc = 768; }
            else if (kind == 4 && j == 2 && pp.bid < 4) { g = pg8::Gemm{(const bf16*)(ws + WS_CKVB) + (size_t)NKM * 256, WB + W_UK, 512, 512, 256}; perm = true; mode = 0; O = (bf16*)(ws + WS_KN) + (size_t)NKM * 512; ldc = 512; }
            else if (kind == 4 && j == 2) { g = pg8::Gemm{WB + W_UVT, (const bf16*)(ws + WS_CKVB) + (size_t)NKM * 256, 512, 512, 256}; perm = true; mode = 0; O = (bf16*)(ws + WS_VT) + NKM; ldc = NK; }
            else if (kind == 4 && j == 0) { g = pg8::Gemm{(const bf16*)(ws + WS_CKVB), WB + W_UK, NKM, 512, 256}; perm = true; mode = 0; O = (bf16*)(ws + WS_KN); ldc = 512; }
            else if (kind == 4)           { g = pg8::Gemm{WB + W_UVT, (const bf16*)(ws + WS_CKVB), 512, NKM, 256}; perm = true; mode = 0; O = (bf16*)(ws + WS_VT); ldc = NK; }
            else if (kind == 6) { g = pg8::Gemm{(const bf16*)(ws + WS_MIX), WB + W_OUT, MP, 1024, 1024}; perm = false; mode = 3; }
            else if (kind == 8) { g = pg8::Gemm{(const bf16*)(ws + WS_XB), WB + W_GU, MT, 5632, 1024}; perm = true; mode = 1; O = (bf16*)(ws + WS_F); ldc = DFF; }
            else                { g = pg8::Gemm{(const bf16*)(ws + WS_F), WB + W_DN, MP, 1024, DFF}; perm = false; mode = 3; }
            const float* xp = pp.out; const float* xs = pp.out + (size_t)MP * 1024; if (kind == 6 && l == 0) { xp = KIN(0); xs = KIN(1); }
            pg8::StaticOrder S; if (kind == 3) S.init(g.M, g.N, pp2.G, pp2.bid); else if (kind == 4 && j == 2) S.init(g.M, g.N, pp.G, (pp.bid < 4) ? pp.bid : ((pp.bid - 4 + pp.G) % pp.G)); else S.init(g.M, g.N, pp.G, pp.bid);
            if (perm) { EpiT<true> E{mode, O, ldc, xp, xs, pp.out, (const float2*)(ws + WS_ROPE)}; pg8::gemm_phase<EpiT<true>, pg8::StaticOrder, true, true>(lds, g, S, E, pp.tid); }
            else      { EpiT<false> E{mode, O, ldc, xp, xs, pp.out, (const float2*)(ws + WS_ROPE)}; pg8::gemm_phase<EpiT<false>, pg8::StaticOrder, true, true>(lds, g, S, E, pp.tid); }
            __syncthreads();
        }
        if (step + 1 < hi_) {
            if (step == lo_) grid.sync();
            else fast_grid_bar((unsigned*)(ws + WS_BAR), (unsigned)(step - lo_), pp.tid, pp.bid, pp.G);
        }
    }
}

extern "C" void kernel_launch(void* const* d_in, const int* in_sizes, int n_in, void* d_out, int out_size, void* d_ws, size_t ws_size, hipStream_t stream) {
    static int grid_blocks = 0;
    if (!grid_blocks) {
        if (hipFuncSetAttribute((const void*)mega, hipFuncAttributeMaxDynamicSharedMemorySize, LDS_BYTES) != hipSuccess) { fprintf(stderr, "kernel_launch: hipFuncSetAttribute failed\n"); grid_blocks = -1; }
        else { int dev = 0, cus = 0, per_cu = 0; hipGetDevice(&dev); hipDeviceGetAttribute(&cus, hipDeviceAttributeMultiprocessorCount, dev);
            hipOccupancyMaxActiveBlocksPerMultiprocessor(&per_cu, mega, 512, LDS_BYTES);
            if (per_cu < 1) { fprintf(stderr, "kernel_launch: occupancy query says %d\n", per_cu); per_cu = 1; }
            grid_blocks = cus; }
    }
    if (grid_blocks <= 0) return;
    if (ws_size < WS_TOTAL || n_in < 29) { fprintf(stderr, "kernel_launch: workspace too small (%zu < %zu) or n_in %d\n", ws_size, (size_t)WS_TOTAL, n_in); return; }
    Params p{};
    for (int i = 0; i < 29; ++i) p.in[i] = (const float*)d_in[i];
    p.out = (float*)d_out; p.ws = (unsigned char*)d_ws;
#if COOP
    p.lo = 0; p.hi = (REPK == 0) ? 21 : 23; void* args[] = {&p};
    hipMemsetAsync((unsigned char*)d_ws + WS_BAR, 0, 8192, stream);
    hipError_t e = hipLaunchCooperativeKernel((const void*)mega, dim3(grid_blocks), dim3(512), args, LDS_BYTES, stream);
    if (e != hipSuccess) fprintf(stderr, "cooperative launch failed: %s (grid %d)\n", hipGetErrorString(e), grid_blocks);
#else
    for (int s = 0; s < 21; ++s) { p.lo = s; p.hi = s + 1; hipLaunchKernelGGL(mega, dim3(grid_blocks), dim3(512), LDS_BYTES, stream, p); }
#endif
}
```

```cpp
#include <hip/hip_runtime.h>
#include <hip/hip_cooperative_groups.h>
#include <cstdio>
#include <cstdint>
namespace cg = cooperative_groups;
namespace pg8 {
#define PG8_LAS __attribute__((address_space(3)))
typedef unsigned short bf16_t;
typedef short bf16x8 __attribute__((ext_vector_type(8)));
typedef float f32x4 __attribute__((ext_vector_type(4)));
typedef unsigned u32x4 __attribute__((ext_vector_type(4)));
constexpr int BM = 256, BK = 64, HALF = 128, HTB = HALF * BK * 2  , STAGE_BYTES = 8 * HTB, NXCD = 8, WGM = 8;

__host__ __device__ __forceinline__ int lds_byte(int r, int c) { const int st = (r >> 4) * 2 + (c >> 5), rr = r & 15, cc = c & 31, ob = rr * 64 + cc * 2; return st * 1024 + (ob ^ (((ob >> 9) & 1) << 5)); }
__host__ __device__ __forceinline__ void stage_rc(int b, int& R, int& C) { const int st = b / 1024, sb = b % 1024, swz = sb ^ (((sb >> 9) & 1) << 5); R = (st >> 1) * 16 + swz / 64; C = (st & 1) * 32 + (swz % 64) / 2; }
__host__ __device__ __forceinline__ int perm32(int rho) { const int n = rho >> 4, i = rho & 15; return 8 * (i >> 2) + 4 * n + (i & 3); }

struct Unit { int pm, pn; };
struct Gemm { const bf16_t* A; const bf16_t* Bt; int M, N, K; };

struct StaticOrder {
    int nM, nN, nwg, G, c;
    __host__ __device__ void init(int M, int N, int G_, int c_) { nM = M / BM; nN = N / BM; nwg = nM * nN; G = G_; c = c_; }
    __host__ __device__ bool next(int i, Unit& u) const {
        const long L = (long)i * G + c; if (L >= nwg) return false;
        int wgid = (int)L; { const int q = nwg / NXCD, r = nwg % NXCD, xcd = wgid % NXCD, off = wgid / NXCD; wgid = (xcd < r ? xcd * (q + 1) : r * (q + 1) + (xcd - r) * q) + off; }
        const int nig = WGM * nN, gid = wgid / nig, fm = gid * WGM, gsz = (nM - fm) < WGM ? (nM - fm) : WGM;
        u.pm = fm + ((wgid % nig) % gsz); u.pn = (wgid % nig) / gsz; return true;
    }
    __device__ __forceinline__ void a_ready(const Unit&) const {}
    __device__ __forceinline__ void done(const Unit&) const {}
};
__device__ __forceinline__ unsigned cvt_pk_bf16(float lo, float hi) { unsigned r; asm volatile("v_cvt_pk_bf16_f32 %0, %1, %2" : "=v"(r) : "v"(lo), "v"(hi)); return r; }
template <class Epi, class Sched, bool ALIGN_EPI = false, bool SP2 = false>
__device__ __forceinline__ void gemm_phase(PG8_LAS unsigned char* lds, const Gemm g, const Sched& S, const Epi& E, const int tid) {
    const int  wid = __builtin_amdgcn_readfirstlane(tid >> 6), lane = tid & 63, wr = wid >> 2, wc = wid & 3, fr = lane & 15, fq = lane >> 4;
    const int K = g.K, nt = K / BK;
    unsigned voffA[2], voffB[2];
#pragma unroll
    for (int i = 0; i < 2; ++i) { int R, C; stage_rc(tid * 16 + i * 8192, R, C); const int Rb = Epi::PERM ? ((R & ~31) + perm32(R & 31)) : R;
        voffA[i] = (unsigned)(R * K + C) * 2u; voffB[i] = (unsigned)(Rb * K + C) * 2u; }
    const size_t kstep = (size_t)(BK * 2);
    const size_t hstep = (size_t)HALF * K * 2;
    const size_t tstep = 2 * hstep;
    const unsigned ldsw = (unsigned)wid * 1024u;
    const int aoff = lds_byte(wr * 64 + fr, fq * 8), boff = lds_byte(wc * 32 + fr, fq * 8);
#define PG8_SA(b, h) (((b) * 2 + (h)) * HTB)
#define PG8_SB(b, h) ((4 + (b) * 2 + (h)) * HTB)
#define PG8_STAGE(bufoff, gbase, voff) do { _Pragma("unroll") for (int _i = 0; _i < 2; ++_i) \
        __builtin_amdgcn_global_load_lds((const unsigned*)((const char*)(gbase) + (voff)[_i]), (PG8_LAS unsigned*)(lds + (bufoff) + ldsw + _i * 8192), 16, 0, 0); } while (0)
#define PG8_LDA(dst, b, h) do { _Pragma("unroll") for (int m = 0; m < 4; ++m) _Pragma("unroll") for (int k = 0; k < 2; ++k) dst[m][k] = *(const PG8_LAS bf16x8*)(lds + PG8_SA(b, h) + aoff + m * 2048 + k * 1024); } while (0)
#define PG8_LDB(dst, b, h) do { _Pragma("unroll") for (int n = 0; n < 2; ++n) _Pragma("unroll") for (int k = 0; k < 2; ++k) dst[n][k] = *(const PG8_LAS bf16x8*)(lds + PG8_SB(b, h) + boff + n * 2048 + k * 1024); } while (0)
#define PG8_MMA(ai, bj, At, Bt) do { __builtin_amdgcn_s_setprio(1); _Pragma("unroll") for (int m = 0; m < 4; ++m) _Pragma("unroll") for (int n = 0; n < 2; ++n) _Pragma("unroll") for (int k = 0; k < 2; ++k) \
        acc[ai][bj][m][n] = __builtin_amdgcn_mfma_f32_16x16x32_bf16(Bt[n][k], At[m][k], acc[ai][bj][m][n], 0, 0, 0); __builtin_amdgcn_s_setprio(0); } while (0)
#define PG8_WAIT_V(n) asm volatile("s_waitcnt vmcnt(" #n ")" ::: "memory")
#define PG8_WAIT_L(n) asm volatile("s_waitcnt lgkmcnt(" #n ")" ::: "memory")
#define PG8_BAR __builtin_amdgcn_s_barrier()
#define PG8_SCHED __builtin_amdgcn_sched_barrier(0)
    Unit cur, nxt; int ui = 0;
    if (!S.next(0, cur)) return;
    f32x4 acc[2][2][4][2];
#pragma unroll
    for (int a = 0; a < 2; ++a)
#pragma unroll
        for (int b = 0; b < 2; ++b)
#pragma unroll
            for (int m = 0; m < 4; ++m)
#pragma unroll
                for (int n = 0; n < 2; ++n) acc[a][b][m][n] = (f32x4){0.f, 0.f, 0.f, 0.f};
    bf16x8 At[4][2], B0[2][2], B1[2][2];
    const char* cA = (const char*)g.A + (size_t)cur.pm * tstep; const char* cB = (const char*)g.Bt + (size_t)cur.pn * tstep;
    S.a_ready(cur);
    if constexpr (SP2) {
        PG8_STAGE(PG8_SB(0, 0), cB, voffB); PG8_STAGE(PG8_SB(0, 1), cB + hstep, voffB); PG8_STAGE(PG8_SA(0, 0), cA, voffA); PG8_STAGE(PG8_SA(0, 1), cA + hstep, voffA);
        if (wr == 1) PG8_BAR;
        PG8_WAIT_V(2); PG8_BAR;
        PG8_STAGE(PG8_SB(1, 0), cB + kstep, voffB); PG8_STAGE(PG8_SA(1, 0), cA + kstep, voffA); PG8_STAGE(PG8_SB(1, 1), cB + hstep + kstep, voffB);
        PG8_WAIT_V(6); PG8_BAR;
    } else {
        PG8_STAGE(PG8_SB(0, 0), cB, voffB); PG8_STAGE(PG8_SA(0, 0), cA, voffA); PG8_STAGE(PG8_SB(0, 1), cB + hstep, voffB); PG8_STAGE(PG8_SA(0, 1), cA + hstep, voffA);
        if (wr == 1) PG8_BAR;
        PG8_WAIT_V(4); PG8_BAR;
        PG8_STAGE(PG8_SB(1, 0), cB + kstep, voffB); PG8_STAGE(PG8_SA(1, 0), cA + kstep, voffA); PG8_STAGE(PG8_SB(1, 1), cB + hstep + kstep, voffB);
        PG8_WAIT_V(6); PG8_BAR;
    }
    for (;;) {
        const bool has_next = S.next(ui + 1, nxt);
        const char* nA = has_next ? (const char*)g.A + (size_t)nxt.pm * tstep : cA; const char* nB = has_next ? (const char*)g.Bt + (size_t)nxt.pn * tstep : cB;
        for (int t = 0; t < nt; t += 2) {
            const bool last = (t == nt - 2);
            const char* a1 = cA + (size_t)(t + 1) * kstep;
            const char* a2 = last ? nA : cA + (size_t)(t + 2) * kstep; const char* b2 = last ? nB : cB + (size_t)(t + 2) * kstep;
            const char* a3 = a2 + kstep; const char* b3 = b2 + kstep;
            if (last && has_next) S.a_ready(nxt);
            if constexpr (SP2) {
            PG8_LDB(B0, 0, 0); PG8_LDB(B1, 0, 1); PG8_SCHED; PG8_LDA(At, 0, 0); PG8_STAGE(PG8_SA(1, 1), a1 + hstep, voffA);
            PG8_WAIT_V(8); PG8_WAIT_L(0); PG8_BAR; PG8_MMA(0, 0, At, B0); PG8_MMA(0, 1, At, B1); PG8_BAR; PG8_SCHED;
            PG8_LDA(At, 0, 1); PG8_STAGE(PG8_SB(0, 0), b2, voffB); PG8_STAGE(PG8_SB(0, 1), b2 + hstep, voffB); PG8_STAGE(PG8_SA(0, 0), a2, voffA);
            PG8_WAIT_V(8); PG8_WAIT_L(0); PG8_BAR; PG8_MMA(1, 0, At, B0); PG8_MMA(1, 1, At, B1); PG8_BAR; PG8_SCHED;
            PG8_LDB(B0, 1, 0); PG8_LDB(B1, 1, 1); PG8_SCHED; PG8_LDA(At, 1, 0); PG8_STAGE(PG8_SA(0, 1), a2 + hstep, voffA);
            PG8_WAIT_V(8); PG8_WAIT_L(0); PG8_BAR; PG8_MMA(0, 0, At, B0); PG8_MMA(0, 1, At, B1); PG8_BAR; PG8_SCHED;
            PG8_LDA(At, 1, 1); PG8_STAGE(PG8_SB(1, 0), b3, voffB); PG8_STAGE(PG8_SB(1, 1), b3 + hstep, voffB); PG8_STAGE(PG8_SA(1, 0), a3, voffA);
            PG8_WAIT_V(8); PG8_WAIT_L(0); PG8_BAR; PG8_MMA(1, 0, At, B0); PG8_MMA(1, 1, At, B1); PG8_BAR; PG8_SCHED;
            } else {
            PG8_LDB(B0, 0, 0); PG8_SCHED; PG8_LDA(At, 0, 0); PG8_STAGE(PG8_SA(1, 1), a1 + hstep, voffA);
            PG8_WAIT_L(8); PG8_BAR; PG8_WAIT_L(0); PG8_MMA(0, 0, At, B0); PG8_BAR; PG8_SCHED;
            PG8_LDB(B1, 0, 1); PG8_STAGE(PG8_SB(0, 0), b2, voffB);
            PG8_BAR; PG8_WAIT_L(0); PG8_MMA(0, 1, At, B1); PG8_BAR;
            PG8_LDA(At, 0, 1); PG8_STAGE(PG8_SA(0, 0), a2, voffA);
            PG8_BAR; PG8_WAIT_L(0); PG8_MMA(1, 0, At, B0); PG8_BAR; PG8_SCHED;
            PG8_STAGE(PG8_SB(0, 1), b2 + hstep, voffB);
            PG8_WAIT_V(6); PG8_BAR; PG8_MMA(1, 1, At, B1); PG8_BAR;
            PG8_LDB(B0, 1, 0); PG8_SCHED; PG8_LDA(At, 1, 0); PG8_STAGE(PG8_SA(0, 1), a2 + hstep, voffA);
            PG8_WAIT_L(8); PG8_BAR; PG8_WAIT_L(0); PG8_MMA(0, 0, At, B0); PG8_BAR; PG8_SCHED;
            PG8_LDB(B1, 1, 1); PG8_STAGE(PG8_SB(1, 0), b3, voffB);
            PG8_BAR; PG8_WAIT_L(0); PG8_MMA(0, 1, At, B1); PG8_BAR;
            PG8_LDA(At, 1, 1); PG8_STAGE(PG8_SA(1, 0), a3, voffA);
            PG8_BAR; PG8_WAIT_L(0); PG8_MMA(1, 0, At, B0); PG8_BAR; PG8_SCHED;
            PG8_STAGE(PG8_SB(1, 1), b3 + hstep, voffB);
            PG8_WAIT_V(6); PG8_BAR; PG8_MMA(1, 1, At, B1); PG8_BAR;
            }
        }
        if constexpr (ALIGN_EPI) { if (wr == 0) PG8_BAR; }
        if constexpr (!Epi::AFTER_DRAIN) { E(acc, cur, wr, wc, fr, fq); S.done(cur); }
        if (!has_next) break;
#pragma unroll
        for (int a = 0; a < 2; ++a)
#pragma unroll
            for (int b = 0; b < 2; ++b)
#pragma unroll
                for (int m = 0; m < 4; ++m)
#pragma unroll
                    for (int n = 0; n < 2; ++n) acc[a][b][m][n] = (f32x4){0.f, 0.f, 0.f, 0.f};
        cur = nxt; cA = nA; cB = nB; ++ui;
        if constexpr (ALIGN_EPI) { if (wr == 1) PG8_BAR; }
    }
    PG8_WAIT_V(0);
    if constexpr (!ALIGN_EPI) { if (wr == 0) PG8_BAR; }
    PG8_BAR;
    if constexpr (Epi::AFTER_DRAIN) { E.fused(acc, cur, wr, wc, fr, fq, lds, wid, lane); S.done(cur); }
#undef PG8_SA
#undef PG8_SB
#undef PG8_STAGE
#undef PG8_LDA
#undef PG8_LDB
#undef PG8_MMA
#undef PG8_WAIT_V
#undef PG8_WAIT_L
#undef PG8_BAR
#undef PG8_SCHED
}
}

#define LAS __attribute__((address_space(3)))
typedef unsigned short bf16;
typedef short bf16x8 __attribute__((ext_vector_type(8)));
typedef short s16x4 __attribute__((ext_vector_type(4)));
typedef float f32x4 __attribute__((ext_vector_type(4)));
typedef unsigned u32x4 __attribute__((ext_vector_type(4)));
typedef unsigned u32x2 __attribute__((ext_vector_type(2)));

#ifndef COOP
#define COOP 1
#endif
#ifndef REPK
#define REPK 0
#endif
#ifndef REPG1
#define REPG1 0
#endif
#ifndef REP2
#define REP2 0
#endif
#ifndef GDN_SPLIT
#define GDN_SPLIT 0
#endif

constexpr int MP = 32768, MS = 512, MT = MP + MS;
constexpr int SKS = 2064;
constexpr int NK = MP + 32 * SKS;
constexpr int NKM = MP + 65536;
constexpr int HLD = 2304;
constexpr int C_CKV = 384, C_KPE = 640, C_QKV = 672, C_B = 1440, C_A = 1444, C_Z = 1448, C_GA = 1704, C_GG = 1960;
constexpr int DFF = 2816;
constexpr float DN_ALPHA = 1.41421356237f;
constexpr float QSCALE = 0.10206207261596577f * 1.4426950408889634f;

constexpr size_t O_YP = 0, O_YS = 33554432, O_CKVP = 34078720, O_KPEP = 50855936, O_GDNP = 52953088, O_GCP = 53477376,
                 O_CVP = 53551104, O_CKVS = 53796864, O_KPES = 54059008, O_GDNS = 54091776, O_GCS = 55140352, O_CVS = 55287808;

constexpr size_t W_IN = 0, W_UQ = W_IN + 2304 * 1024, W_UK = W_UQ + 768 * 384, W_UVT = W_UK + 512 * 256, W_OUT = W_UVT + 512 * 256,
                 W_GU = W_OUT + 1024 * 1024, W_DN = W_GU + 5632 * 1024, W_LAYER = W_DN + 1024 * 2816;
constexpr size_t WS_W = 0, WS_ROPE = WS_W + 2 * W_LAYER * 2, WS_XB = WS_ROPE + 2064 * 16 * 8, WS_MIX = WS_XB + (size_t)MT * 1024 * 2,
                 WS_CQN = WS_MIX + (size_t)MT * 1024 * 2, WS_CKVB = WS_CQN + (size_t)MT * 384 * 2, WS_KPEB = WS_CKVB + (size_t)NK * 256 * 2,
                 WS_BIG = WS_KPEB + (size_t)NK * 32 * 2;
constexpr size_t GUNIT = 49408;
constexpr int NGU = 2176;
constexpr size_t WS_H = WS_BIG, WS_GSCR = WS_H + (size_t)MT * HLD * 2, BIG1 = (size_t)MT * HLD * 2 + (size_t)NGU * GUNIT;
constexpr size_t WS_Q = WS_BIG, WS_KN = WS_Q + (size_t)MT * 768 * 2, WS_VT = WS_KN + (size_t)NK * 512 * 2, BIG2 = (size_t)MT * 768 * 2 + 2 * (size_t)NK * 512 * 2;
constexpr size_t WS_F = WS_BIG, BIG3 = (size_t)MT * DFF * 2;
constexpr size_t BIGSZ = BIG1 > BIG2 ? (BIG1 > BIG3 ? BIG1 : BIG3) : (BIG2 > BIG3 ? BIG2 : BIG3);
constexpr size_t WS_BAR = WS_BIG + BIGSZ;
constexpr size_t WS_TOTAL = WS_BAR + 8192;
static_assert(WS_TOTAL <= 536870912ull, "workspace map exceeds 512 MiB");
static_assert(WS_XB % 256 == 0 && WS_BIG % 256 == 0 && WS_GSCR % 256 == 0 && WS_KN % 256 == 0 && WS_VT % 256 == 0, "alignment");

constexpr int LDS_BYTES = 139264;
constexpr int G1_GRP = 67584;

struct Params { const float* in[29]; float* out; unsigned char* ws; int lo, hi; };
template <int OFF> __device__ __forceinline__ unsigned long long karg_u64() {
    unsigned long long v; const unsigned long long kp = (unsigned long long)__builtin_amdgcn_kernarg_segment_ptr();
    asm volatile("s_load_dwordx2 %0, %1, %2\n\ts_waitcnt lgkmcnt(0)" : "=s"(v) : "s"(kp), "n"(OFF));
    return v;
}
#define GAS1 __attribute__((address_space(1)))
#define KIN(i) ((const float*)(const GAS1 float*)karg_u64<8 * (i)>())
#define KOUT() ((float*)(GAS1 float*)karg_u64<232>())
#define KWS() ((unsigned char*)(GAS1 unsigned char*)karg_u64<240>())
struct PP { unsigned char* ws; float* out; int tid, bid, G; };

typedef float f32x2_ __attribute__((ext_vector_type(2))); typedef __bf16 bf16x2_ __attribute__((ext_vector_type(2)));
__device__ __forceinline__ unsigned f2bf(float f) { const f32x2_ v = {f, 0.f}; const bf16x2_ b = __builtin_convertvector(v, bf16x2_); return __builtin_bit_cast(unsigned, b) & 0xffffu; }
__device__ __forceinline__ float bf2f(unsigned b) { return __builtin_bit_cast(float, b << 16); }
__device__ __forceinline__ unsigned pk2(float lo, float hi) { return pg8::cvt_pk_bf16(lo, hi); }
__device__ __forceinline__ float sigmoidf_(float x) { return __builtin_amdgcn_rcpf(1.0f + __expf(-x)); }
__device__ __forceinline__ float siluf_(float x) { return x * sigmoidf_(x); }

template <int CTRL> __device__ __forceinline__ float dpp_f(float v) { return __builtin_bit_cast(float, __builtin_amdgcn_update_dpp(0, __builtin_bit_cast(int, v), CTRL, 0xf, 0xf, false)); }
__device__ __forceinline__ float row16_sum(float v) { v += dpp_f<0xB1>(v); v += dpp_f<0x4E>(v); v += dpp_f<0x141>(v); v += dpp_f<0x140>(v); return v; }
__device__ __forceinline__ float xor16_get(float v) { return __builtin_bit_cast(float, __builtin_amdgcn_ds_swizzle(__builtin_bit_cast(int, v), 0x401F)); }
__device__ __forceinline__ float xor32_max(float v) { const unsigned u = __builtin_bit_cast(unsigned, v); auto r = __builtin_amdgcn_permlane32_swap(u, u, false, false); return fmaxf(__builtin_bit_cast(float, (unsigned)r[0]), __builtin_bit_cast(float, (unsigned)r[1])); }
__device__ __forceinline__ float xor32_sum(float v) { const unsigned u = __builtin_bit_cast(unsigned, v); auto r = __builtin_amdgcn_permlane32_swap(u, u, false, false); return __builtin_bit_cast(float, (unsigned)r[0]) + __builtin_bit_cast(float, (unsigned)r[1]); }
__device__ __forceinline__ float wave_sum(float v) {
    v = row16_sum(v); const int iv = __builtin_bit_cast(int, v);
    const float s0 = __builtin_bit_cast(float, __builtin_amdgcn_readlane(iv, 0)), s1 = __builtin_bit_cast(float, __builtin_amdgcn_readlane(iv, 16));
    const float s2 = __builtin_bit_cast(float, __builtin_amdgcn_readlane(iv, 32)), s3 = __builtin_bit_cast(float, __builtin_amdgcn_readlane(iv, 48));
    return (s0 + s1) + (s2 + s3);
}
#define LBAR() asm volatile("s_waitcnt lgkmcnt(0)\n\ts_barrier" ::: "memory")
__device__ __forceinline__ f32x4 mfma16(bf16x8 a, bf16x8 b, f32x4 c) { return __builtin_amdgcn_mfma_f32_16x16x32_bf16(a, b, c, 0, 0, 0); }

template <bool P> struct EpiT {
    static constexpr bool PERM = P, AFTER_DRAIN = false;
    int mode;
    bf16* O; size_t ldc;
    const float* xp; const float* xs; float* X;
    const float2* rope;
    __device__ __forceinline__ void operator()(const f32x4 (&acc)[2][2][4][2], const pg8::Unit& u, int wr, int wc, int fr, int fq) const {
        const int row0 = u.pm * 256 + wr * 64 + fr;
        if constexpr (P) {
            if (mode == 0) {
                const int col0 = u.pn * 256 + wc * 32 + 8 * fq;
#pragma unroll
                for (int ai = 0; ai < 2; ++ai)
#pragma unroll
                    for (int m = 0; m < 4; ++m) { bf16* rowp = O + (size_t)(row0 + ai * 128 + m * 16) * ldc + col0;
#pragma unroll
                        for (int bj = 0; bj < 2; ++bj) { const f32x4 v0 = acc[ai][bj][m][0], v1 = acc[ai][bj][m][1]; u32x4 w;
                            w.x = pk2(v0[0], v0[1]); w.y = pk2(v0[2], v0[3]); w.z = pk2(v1[0], v1[1]); w.w = pk2(v1[2], v1[3]);
                            *(u32x4*)(rowp + bj * 128) = w; } }
            } else {
                const int col0 = u.pn * 128 + wc * 32 + 8 * fq;
#pragma unroll
                for (int ai = 0; ai < 2; ++ai)
#pragma unroll
                    for (int m = 0; m < 4; ++m) { bf16* rowp = O + (size_t)(row0 + ai * 128 + m * 16) * ldc + col0;
                        float f[8];
#pragma unroll
                        for (int n = 0; n < 2; ++n)
#pragma unroll
                            for (int j = 0; j < 4; ++j) { const float g = acc[ai][0][m][n][j], up = acc[ai][1][m][n][j]; f[n * 4 + j] = siluf_(g) * up; }
                        u32x4 w; w.x = pk2(f[0], f[1]); w.y = pk2(f[2], f[3]); w.z = pk2(f[4], f[5]); w.w = pk2(f[6], f[7]);
                        *(u32x4*)rowp = w; }
            }
        } else {
            if (mode == 3) {
#pragma unroll
                for (int ai = 0; ai < 2; ++ai)
#pragma unroll
                    for (int m = 0; m < 4; ++m) { const int row = row0 + ai * 128 + m * 16;
                        const float* src = (row < MP) ? xp + (size_t)row * 1024 : xs + (size_t)(row - MP) * 1024;
                        float* dst = X + (size_t)row * 1024;
#pragma unroll
                        for (int bj = 0; bj < 2; ++bj)
#pragma unroll
                            for (int n = 0; n < 2; ++n) { const int col = u.pn * 256 + bj * 128 + wc * 32 + n * 16 + 4 * fq;
                                const f32x4 xi = *(const f32x4*)(src + col); f32x4 o = xi * DN_ALPHA + acc[ai][bj][m][n];
                                *(f32x4*)(dst + col) = o; }
                        __builtin_amdgcn_sched_barrier(0); }
            } else {
#pragma unroll
                for (int ai = 0; ai < 2; ++ai)
#pragma unroll
                    for (int m = 0; m < 4; ++m) { const int row = row0 + ai * 128 + m * 16;
                        const int pos = (row < MP) ? (row & 2047) : (2048 + ((row - MP) & 15));
                        bf16* rowp = O + (size_t)row * 768;
#pragma unroll
                        for (int bj = 0; bj < 2; ++bj) { const int g32 = u.pn * 256 + bj * 128 + wc * 32;
                            f32x4 a = acc[ai][bj][m][0], b = acc[ai][bj][m][1];
                            if ((g32 % 96) == 64) {
                                const float2* rp = rope + pos * 16 + 4 * fq;
#pragma unroll
                                for (int j = 0; j < 4; ++j) { const float2 cs = rp[j]; const float x1 = a[j], x2 = b[j]; a[j] = x1 * cs.x - x2 * cs.y; b[j] = x1 * cs.y + x2 * cs.x; }
                            }
                            a = a * QSCALE; b = b * QSCALE;
                            u32x2 w0, w1; w0.x = pk2(a[0], a[1]); w0.y = pk2(a[2], a[3]); w1.x = pk2(b[0], b[1]); w1.y = pk2(b[2], b[3]);
                            *(u32x2*)(rowp + g32 + 4 * fq) = w0; *(u32x2*)(rowp + g32 + 16 + 4 * fq) = w1; }
                        __builtin_amdgcn_sched_barrier(0); }
            }
        }
    }
};

__device__ __forceinline__ void prep_phase(const PP P, LAS unsigned char* lds, const int wl, const bool do_rest) {
    const int tid = P.tid, G = P.G;
    LAS float* tile = (LAS float*)lds;
    bf16* WB = (bf16*)(P.ws + WS_W);
    const int tx = tid & 63, ty = tid >> 6;
    for (int it = P.bid; it < 3080; it += G) {
        const int l = wl, r = it;
        const float* src; int ld, K, kt_n, tt; bf16* dst; int kind;
        if (r < 576)       { kind = 0; tt = r;        src = KIN(7) + (size_t)l * 1024 * 2216;  ld = 2216; K = 1024; kt_n = 16; dst = WB + l * W_LAYER + W_IN; }
        else if (r < 648)  { kind = 1; tt = r - 576;  src = KIN(9) + (size_t)l * 384 * 768;    ld = 768;  K = 384;  kt_n = 6;  dst = WB + l * W_LAYER + W_UQ; }
        else if (r < 680)  { kind = 1; tt = r - 648;  src = KIN(11) + (size_t)l * 256 * 512;   ld = 512;  K = 256;  kt_n = 4;  dst = WB + l * W_LAYER + W_UK; }
        else if (r < 712)  { kind = 1; tt = r - 680;  src = KIN(12) + (size_t)l * 256 * 512;   ld = 512;  K = 256;  kt_n = 4;  dst = WB + l * W_LAYER + W_UVT; }
        else if (r < 968)  { kind = 1; tt = r - 712;  src = KIN(21) + (size_t)l * 1024 * 1024; ld = 1024; K = 1024; kt_n = 16; dst = WB + l * W_LAYER + W_OUT; }
        else if (r < 2376) { kind = 2; tt = r - 968;  src = nullptr;                            ld = 2816; K = 1024; kt_n = 16; dst = WB + l * W_LAYER + W_GU; }
        else               { kind = 1; tt = r - 2376; src = KIN(26) + (size_t)l * 2816 * 1024; ld = 1024; K = 2816; kt_n = 44; dst = WB + l * W_LAYER + W_DN; }
        const int n0 = (tt / kt_n) * 64, k0 = (tt % kt_n) * 64;
        int col0 = n0; bool valid = true;
        if (kind == 0) valid = (n0 + tx) < 2216;
        if (kind == 2) { src = (((n0 >> 7) & 1) ? KIN(25) : KIN(24)) + (size_t)l * 1024 * 2816; col0 = (n0 >> 8) * 128 + (n0 & 127); }
#pragma unroll
        for (int kk = ty; kk < 64; kk += 8) tile[kk * 65 + tx] = valid ? src[(size_t)(k0 + kk) * ld + col0 + tx] : 0.f;
        __syncthreads();
#pragma unroll
        for (int nn = ty; nn < 64; nn += 8) dst[(size_t)(n0 + nn) * K + k0 + tx] = (bf16)f2bf(tile[tx * 65 + nn]);
        __syncthreads();
    }
    if (!do_rest) return;
    bf16* XB = (bf16*)(P.ws + WS_XB);
    for (int g = P.bid * 512 + tid; g < MT * 128; g += G * 512) {
        const int row = g >> 7, c8 = g & 127;
        const float* s = (row < MP) ? KIN(0) + (size_t)row * 1024 + c8 * 8 : KIN(1) + (size_t)(row - MP) * 1024 + c8 * 8;
        const f32x4 a = *(const f32x4*)s, b = *(const f32x4*)(s + 4);
        u32x4 w; w.x = pk2(a[0], a[1]); w.y = pk2(a[2], a[3]); w.z = pk2(b[0], b[1]); w.w = pk2(b[2], b[3]);
        *(u32x4*)(XB + (size_t)g * 8) = w;
    }
    float2* rope = (float2*)(P.ws + WS_ROPE);
    for (int idx = P.bid * 512 + tid; idx < 2064 * 16; idx += G * 512) {
        const int pos = idx >> 4, i = idx & 15;
        const float inv = __expf(-9.210340371976184f * (float)i / 16.0f);
        const float ang = (float)pos * inv;
        const float k = rintf(ang * 0.15915494309189535f);
        float rr = fmaf(-k, 6.2831854820251465f, ang); rr = fmaf(k, 1.7484555e-7f, rr);
        rope[idx] = make_float2(__cosf(rr), __sinf(rr));
    }
}

__device__ __forceinline__ void tok_phase(const PP P, int l) {
    const int tid = P.tid, lane = tid & 63, wave = tid >> 6, G = P.G;
    const bf16* H = (const bf16*)(P.ws + WS_H);
    bf16* CQN = (bf16*)(P.ws + WS_CQN); bf16* CKVB = (bf16*)(P.ws + WS_CKVB); bf16* KPEB = (bf16*)(P.ws + WS_KPEB);
    const float2* rope = (const float2*)(P.ws + WS_ROPE);
    const float* qn = KIN(8) + l * 384; const float* kvn = KIN(10) + l * 256;
    float* out = P.out;
    for (int row = P.bid * 8 + wave; row < MT; row += G * 8) {
        const bf16* hr = H + (size_t)row * HLD;
        const bool smp = row >= MP; int b, t, pos;
        if (!smp) { b = row >> 11; t = row & 2047; pos = t; } else { const int rr = row - MP; b = rr >> 4; t = rr & 15; pos = 2048 + t; }
        const size_t krow = smp ? (size_t)MP + 65536 + (size_t)b * 16 + t : (size_t)row;
        { float v[6]; float ss = 0.f;
#pragma unroll
          for (int i = 0; i < 3; ++i) { const unsigned w = *(const unsigned*)(hr + 128 * i + lane * 2); v[2 * i] = bf2f(w & 0xffffu); v[2 * i + 1] = bf2f(w >> 16); ss += v[2 * i] * v[2 * i] + v[2 * i + 1] * v[2 * i + 1]; }
          ss = wave_sum(ss); const float rinv = rsqrtf(ss * (1.0f / 384.0f) + 1e-6f);
#pragma unroll
          for (int i = 0; i < 3; ++i) { const int col = 128 * i + lane * 2; *(unsigned*)(CQN + (size_t)row * 384 + col) = pk2(v[2 * i] * rinv * qn[col], v[2 * i + 1] * rinv * qn[col + 1]); } }
        { const u32x2 w = *(const u32x2*)(hr + C_CKV + lane * 4);
          float v0 = bf2f(w.x & 0xffffu), v1 = bf2f(w.x >> 16), v2 = bf2f(w.y & 0xffffu), v3 = bf2f(w.y >> 16);
          float ss = wave_sum(v0 * v0 + v1 * v1 + v2 * v2 + v3 * v3); const float rinv = rsqrtf(ss * (1.0f / 256.0f) + 1e-6f);
          const f32x4 gn = *(const f32x4*)(kvn + lane * 4);
          f32x4 o; o[0] = v0 * rinv * gn[0]; o[1] = v1 * rinv * gn[1]; o[2] = v2 * rinv * gn[2]; o[3] = v3 * rinv * gn[3];
          float* op = smp ? out + O_CKVS + ((size_t)(l * 32 + b) * 16 + t) * 256 : out + O_CKVP + ((size_t)(l * 16 + b) * 2048 + t) * 256;
          *(f32x4*)(op + lane * 4) = o;
          u32x2 pw; pw.x = pk2(o[0], o[1]); pw.y = pk2(o[2], o[3]); *(u32x2*)(CKVB + krow * 256 + lane * 4) = pw; }
        if (lane < 16) { const float x1 = bf2f(hr[C_KPE + lane]), x2 = bf2f(hr[C_KPE + 16 + lane]); const float2 cs = rope[pos * 16 + lane];
          const float o1 = x1 * cs.x - x2 * cs.y, o2 = x1 * cs.y + x2 * cs.x;
          float* op = smp ? out + O_KPES + ((size_t)(l * 32 + b) * 16 + t) * 32 : out + O_KPEP + ((size_t)(l * 16 + b) * 2048 + t) * 32;
          op[lane] = o1; op[16 + lane] = o2; KPEB[krow * 32 + lane] = (bf16)f2bf(o1); KPEB[krow * 32 + 16 + lane] = (bf16)f2bf(o2); }
        { const int T = smp ? 16 : 2048;
          if (t >= T - 3) { const int j = t - (T - 3);
            float* op = smp ? out + O_GCS + ((size_t)(l * 32 + b) * 3 + j) * 768 : out + O_GCP + ((size_t)(l * 16 + b) * 3 + j) * 768;
#pragma unroll
            for (int i = 0; i < 12; ++i) op[lane + 64 * i] = bf2f(hr[C_QKV + lane + 64 * i]); } }
        if (smp || t >= 2018) {
            float* op = smp ? out + O_CVS + ((size_t)(l * 32 + b) * 30 + 14 + t) * 256 : out + O_CVP + ((size_t)(l * 16 + b) * 30 + (t - 2018)) * 256;
#pragma unroll
            for (int i = 0; i < 4; ++i) { const int ch = lane + 64 * i; op[ch] = bf2f(hr[C_GA + ch]) * sigmoidf_(bf2f(hr[C_GG + ch])); }
            if (smp && t == 0) {
                const float* sc = KIN(6) + ((size_t)(l * 32 + b) * 30 + 16) * 256; float* o2 = out + O_CVS + (size_t)(l * 32 + b) * 30 * 256;
                for (int e = lane; e < 14 * 256; e += 64) o2[e] = sc[e];
            }
        }
    }
}

__device__ __forceinline__ void cache_phase(const PP P, int l) {
    const int tid = P.tid, G = P.G;
    bf16* CKVB = (bf16*)(P.ws + WS_CKVB); bf16* KPEB = (bf16*)(P.ws + WS_KPEB);
    const float* cckv = KIN(2) + (size_t)l * 32 * 2048 * 256; const float* ckpe = KIN(3) + (size_t)l * 32 * 2048 * 32;
    for (int g = P.bid * 512 + tid; g < 65536 * 32; g += G * 512) {
        const int prow = g >> 5, c8 = g & 31, b = prow >> 11, s = prow & 2047;
        const float* sp = cckv + (size_t)prow * 256 + c8 * 8; const f32x4 a = *(const f32x4*)sp, c = *(const f32x4*)(sp + 4);
        u32x4 w; w.x = pk2(a[0], a[1]); w.y = pk2(a[2], a[3]); w.z = pk2(c[0], c[1]); w.w = pk2(c[2], c[3]);
        *(u32x4*)(CKVB + ((size_t)MP + (size_t)b * 2048 + s) * 256 + c8 * 8) = w;
    }
    for (int g = P.bid * 512 + tid; g < 65536 * 4; g += G * 512) {
        const int prow = g >> 2, c8 = g & 3, b = prow >> 11, s = prow & 2047;
        const float* sp = ckpe + (size_t)prow * 32 + c8 * 8; const f32x4 a = *(const f32x4*)sp, c = *(const f32x4*)(sp + 4);
        u32x4 w; w.x = pk2(a[0], a[1]); w.y = pk2(a[2], a[3]); w.z = pk2(c[0], c[1]); w.w = pk2(c[2], c[3]);
        *(u32x4*)(KPEB + ((size_t)MP + (size_t)b * 2048 + s) * 32 + c8 * 8) = w;
    }
}

__device__ __forceinline__ void conv_phase(const PP P, int l, LAS unsigned char* lds) {
    const int tid = P.tid, lane = tid & 63, wave = tid >> 6, G = P.G;
    const bf16* H = (const bf16*)(P.ws + WS_H); bf16* MIX = (bf16*)(P.ws + WS_MIX);
    LAS bf16* cs = (LAS bf16*)lds;
    LAS float* os = (LAS float*)(lds + 48128);
    const float* cw = KIN(17) + (size_t)l * 31 * 256; const float* cb = KIN(18) + l * 256;
    const float* lg = KIN(19) + l * 256; const float* lb = KIN(20) + l * 256; const float* sc = KIN(6);
    for (int u = P.bid; u < 544; u += G) {
        const bool smp = u < 32; int b, t0, ntok; size_t row0;
        if (!smp) { const int v = u - 32; b = v >> 5; t0 = (v & 31) * 64; ntok = 64; row0 = (size_t)b * 2048 + t0; } else { b = u; t0 = 0; ntok = 16; row0 = (size_t)MP + b * 16; }
        { const int ch2 = (tid & 127) * 2, rg = tid >> 7; const int nrow = 30 + ntok;
          const GAS1 bf16* hb = (const GAS1 bf16*)(H + ((long long)row0 - 30 + rg) * HLD + ch2);
          for (int k0 = 0; k0 < 24; k0 += 12) {
          unsigned ra[12], rgt[12];
#pragma unroll
          for (int k = 0; k < 12; ++k) { const int i = rg + 4 * (k0 + k), tt = t0 - 30 + i; ra[k] = 0u; rgt[k] = 0u;
              if (i < nrow && tt >= 0) { ra[k] = *(const GAS1 unsigned*)(hb + C_GA); rgt[k] = *(const GAS1 unsigned*)(hb + C_GG); }
              hb += 4 * HLD; asm volatile("" : "+v"(hb)); }
#pragma unroll
          for (int k = 0; k < 12; ++k) { const int i = rg + 4 * (k0 + k), tt = t0 - 30 + i;
              if (i < nrow) { float v0, v1;
                  if (tt >= 0 || !smp) { v0 = bf2f(ra[k] & 0xffffu) * sigmoidf_(bf2f(rgt[k] & 0xffffu)); v1 = bf2f(ra[k] >> 16) * sigmoidf_(bf2f(rgt[k] >> 16)); }
                  else { const float* sp = sc + ((size_t)(l * 32 + b) * 30 + (30 + tt)) * 256 + ch2; v0 = sp[0]; v1 = sp[1]; }
                  *(LAS unsigned*)(cs + i * 256 + ch2) = pk2(v0, v1); } } } }
        LBAR();
        { const int ch = tid & 255, gsel = tid >> 8; float w[31]; const GAS1 float* cwp = (const GAS1 float*)(cw + ch); asm volatile("" : "+v"(cwp));
#pragma unroll
          for (int j = 0; j < 31; ++j) w[j] = cwp[j * 256];
          const float bias = cb[ch];
          for (int g = gsel; g < (ntok >> 3); g += 2) { float win[38];
#pragma unroll
              for (int i = 0; i < 38; ++i) win[i] = bf2f(cs[(8 * g + i) * 256 + ch]);
#pragma unroll
              for (int t = 0; t < 8; ++t) { float acc = bias;
#pragma unroll
                  for (int j = 0; j < 31; ++j) acc += w[j] * win[t + j];
                  os[(8 * g + t) * 256 + ch] = acc; } } }
        LBAR();
        for (int t = wave; t < ntok; t += 8) {
            float v[4]; float sm = 0.f;
#pragma unroll
            for (int i = 0; i < 4; ++i) { v[i] = os[t * 256 + lane + 64 * i]; sm += v[i]; }
            const float mu = wave_sum(sm) * (1.0f / 256.0f); float q = 0.f;
#pragma unroll
            for (int i = 0; i < 4; ++i) { const float d = v[i] - mu; q += d * d; }
            const float rstd = rsqrtf(wave_sum(q) * (1.0f / 256.0f) + 1e-5f);
#pragma unroll
            for (int i = 0; i < 4; ++i) { const int ch = lane + 64 * i; const float y = (v[i] - mu) * rstd * lg[ch] + lb[ch]; MIX[(row0 + t) * 1024 + 768 + ch] = (bf16)f2bf(siluf_(y)); }
        }
        LBAR();
    }
}

__device__ __forceinline__ void g1_phase(const PP P, int l, LAS unsigned char* lds) {
    const int tid = P.tid, grp = tid >> 8, gt = tid & 255, G = P.G;
    const bf16* H = (const bf16*)(P.ws + WS_H);
    LAS float* qs = (LAS float*)(lds + grp * G1_GRP); LAS float* ks = qs + 64 * 65; LAS float* vs = ks + 64 * 65; LAS float* As = vs + 64 * 65;
    LAS float* Gs = As + 64 * 64; LAS float* bs = Gs + 64; LAS float* gs = bs + 64;
    const float* gcw = KIN(13) + (size_t)l * 4 * 768;
    const int rounds = (NGU + 2 * G - 1) / (2 * G);
    for (int it = 0; it < rounds; ++it) {
        const int u = (it * G + P.bid) * 2 + grp; const bool act = u < NGU;
        int b, h, ch, L; bool smp; size_t seq0;
        if (u < 2048) { const int bh = u >> 5; ch = u & 31; b = bh >> 2; h = bh & 3; L = 64; smp = false; seq0 = (size_t)b * 2048; }
        else { const int bh = u - 2048; b = bh >> 2; h = bh & 3; L = 16; smp = true; ch = 0; seq0 = (size_t)MP + b * 16; }
        unsigned char* ub = P.ws + WS_GSCR + (size_t)(act ? u : 0) * GUNIT;
        bf16* Wd = (bf16*)ub; bf16* QKd = (bf16*)(ub + 8192); bf16* KdT = (bf16*)(ub + 16384); bf16* QG = (bf16*)(ub + 24576); float* Uv = (float*)(ub + 32768);
#ifdef PROBE_SOLVE
        for (int pass_ = 0; pass_ < 2; ++pass_) {
#endif
        if (act) {
            if (gt < 192) { const int part = gt >> 6, cc = gt & 63, qcol = part * 256 + h * 64 + cc;
                const float w0 = gcw[qcol], w1 = gcw[768 + qcol], w2 = gcw[2 * 768 + qcol], w3 = gcw[3 * 768 + qcol];
                LAS float* dst = (part == 0 ? qs : (part == 1 ? ks : vs)) + cc;
                const bf16* hp = H + (seq0 + (size_t)ch * 64) * HLD + C_QKV + qcol;
                float x0 = 0.f, x1 = 0.f, x2 = 0.f;
                if (ch > 0) { x0 = bf2f(*(hp - 3 * HLD)); x1 = bf2f(*(hp - 2 * HLD)); x2 = bf2f(*(hp - HLD)); }
                else if (smp) { const float* sp = KIN(5) + (size_t)(l * 32 + b) * 3 * 768 + qcol; x0 = sp[0]; x1 = sp[768]; x2 = sp[2 * 768]; }
                const GAS1 bf16* pr = (const GAS1 bf16*)hp;
                if (L == 64) {
                  for (int tb = 0; tb < 64; tb += 32) { float xv[32];
#pragma unroll
                    for (int i = 0; i < 32; ++i) { xv[i] = bf2f(*pr); pr += HLD; asm volatile("" : "+v"(pr)); }
#pragma unroll
                    for (int i = 0; i < 32; ++i) { const float y = w0 * x0 + w1 * x1 + w2 * x2 + w3 * xv[i]; dst[(tb + i) * 65] = siluf_(y); x0 = x1; x1 = x2; x2 = xv[i]; } }
                } else { float xv[16];
#pragma unroll
                    for (int i = 0; i < 16; ++i) { xv[i] = bf2f(*pr); pr += HLD; asm volatile("" : "+v"(pr)); }
#pragma unroll
                    for (int i = 0; i < 16; ++i) { const float y = w0 * x0 + w1 * x1 + w2 * x2 + w3 * xv[i]; dst[i * 65] = siluf_(y); x0 = x1; x1 = x2; x2 = xv[i]; } }
                for (int t = L; t < 64; ++t) dst[t * 65] = 0.f;
            }
        }
        LBAR();
        if (act) {
            { const int rowid = gt >> 1, t = rowid & 63, part = rowid >> 6, half = gt & 1; LAS float* base = (part == 0 ? qs : ks) + t * 65 + half * 32; float ss = 0.f;
#pragma unroll
              for (int i = 0; i < 32; ++i) ss += base[i] * base[i];
              ss += dpp_f<0xB1>(ss); const float rinv = rsqrtf(ss + 1e-6f) * (part == 0 ? 0.125f : 1.0f);
#pragma unroll
              for (int i = 0; i < 32; ++i) base[i] *= rinv; }
            if (gt < 64) { const int t = gt; float beta = 0.f, g = 0.f;
                if (t < L) { const bf16* hr = H + (seq0 + (size_t)ch * 64 + t) * HLD; const float braw = bf2f(hr[C_B + h]), araw = bf2f(hr[C_A + h]);
                    beta = sigmoidf_(braw); const float x = araw + KIN(15)[l * 4 + h]; const float sp = x > 20.f ? x : __logf(1.0f + __expf(x)); g = -__expf(KIN(14)[l * 4 + h]) * sp; }
                bs[t] = beta; gs[t] = g; }
        }
        LBAR();
#ifdef PROBE_SOLVE
        if (pass_ == 0) {
#endif
        if (act && gt == 0) { float gg[64];
#pragma unroll
            for (int t = 0; t < 64; ++t) gg[t] = gs[t];
            float run = 0.f;
#pragma unroll
            for (int t = 0; t < 64; ++t) { run += gg[t]; Gs[t] = run; } }
        LBAR();
        if (act) {
            { const int mi = gt >> 6, ln = gt & 63, fr = ln & 15, fq = ln >> 4;
              bf16x8 ak[2], aq[2];
#pragma unroll
              for (int kk = 0; kk < 2; ++kk) { const LAS float* pk = ks + (16 * mi + fr) * 65 + 32 * kk + fq * 8; const LAS float* pq = qs + (16 * mi + fr) * 65 + 32 * kk + fq * 8;
                  u32x4 wk, wq; wk.x = pk2(pk[0], pk[1]); wk.y = pk2(pk[2], pk[3]); wk.z = pk2(pk[4], pk[5]); wk.w = pk2(pk[6], pk[7]);
                  wq.x = pk2(pq[0], pq[1]); wq.y = pk2(pq[2], pq[3]); wq.z = pk2(pq[4], pq[5]); wq.w = pk2(pq[6], pq[7]);
                  ak[kk] = __builtin_bit_cast(bf16x8, wk); aq[kk] = __builtin_bit_cast(bf16x8, wq); }
#pragma unroll
              for (int nj = 0; nj < 4; ++nj) { f32x4 ckk = {0.f, 0.f, 0.f, 0.f}, cqk = {0.f, 0.f, 0.f, 0.f};
                  if (nj <= mi && 16 * mi < L) {
#pragma unroll
                      for (int kk = 0; kk < 2; ++kk) { const LAS float* pb = ks + (16 * nj + fr) * 65 + 32 * kk + fq * 8;
                          u32x4 wb; wb.x = pk2(pb[0], pb[1]); wb.y = pk2(pb[2], pb[3]); wb.z = pk2(pb[4], pb[5]); wb.w = pk2(pb[6], pb[7]);
                          const bf16x8 bfr = __builtin_bit_cast(bf16x8, wb); ckk = mfma16(ak[kk], bfr, ckk); cqk = mfma16(aq[kk], bfr, cqk); } }
                  const int jc = 16 * nj + fr; const float gj = Gs[jc];
#pragma unroll
                  for (int j = 0; j < 4; ++j) { const int i = 16 * mi + fq * 4 + j; const float dec = (i >= jc) ? __expf(Gs[i] - gj) : 0.f;
                      As[i * 64 + jc] = (i > jc) ? bs[i] * ckk[j] * dec : 0.f; QKd[i * 64 + jc] = (bf16)f2bf(cqk[j] * dec); } } }
        }
        LBAR();
        if (act) {
            const float glast = Gs[63];
            for (int e = gt; e < 4096; e += 256) { const int hi = e >> 6, lo = e & 63;
                KdT[e] = (bf16)f2bf(ks[lo * 65 + hi] * __expf(glast - Gs[lo]));
                QG[e] = (bf16)f2bf(qs[hi * 65 + lo] * __expf(Gs[hi])); }
            if (gt == 0) *(float*)(ub + 49152) = __expf(glast);
        }
        LBAR();
#ifdef PROBE_SOLVE
        }
#endif
        if (act) {
            for (int e = gt; e < 8192; e += 256) { const int i = e >> 7, c = e & 127; LAS float* p = ((c < 64) ? ks : vs) + i * 65 + (c & 63);
                *p = *p * bs[i] * ((c < 64) ? __expf(Gs[i]) : 1.0f); }
        }
        LBAR();
#pragma unroll 1
        for (int R = 0; R < 4; ++R) {
            if (act && R > 0 && 16 * R < L) {
                const int wv = gt >> 6, ln = gt & 63, fr = ln & 15, fq = ln >> 4, nkk = (16 * R + 31) >> 5;
                bf16x8 af[2];
#pragma unroll
                for (int kk = 0; kk < 2; ++kk) { u32x4 w = {0u, 0u, 0u, 0u};
                    if (kk < nkk && 32 * kk + fq * 8 < 16 * R) { const LAS float* pa = As + (16 * R + fr) * 64 + 32 * kk + fq * 8; const f32x4 a0 = *(const LAS f32x4*)pa, a1 = *(const LAS f32x4*)(pa + 4);
                        w.x = pk2(a0[0], a0[1]); w.y = pk2(a0[2], a0[3]); w.z = pk2(a1[0], a1[1]); w.w = pk2(a1[2], a1[3]); }
                    af[kk] = __builtin_bit_cast(bf16x8, w); }
#pragma unroll
                for (int t = 0; t < 2; ++t) { const int nt = 2 * wv + t; LAS float* xb = ((nt < 4) ? ks : vs) + 16 * (nt & 3) + fr;
                    f32x4 acc = {0.f, 0.f, 0.f, 0.f};
#pragma unroll
                    for (int kk = 0; kk < 2; ++kk) if (kk < nkk) { const LAS float* pb = xb + (32 * kk + fq * 8) * 65;
                        u32x4 w; w.x = pk2(pb[0], pb[65]); w.y = pk2(pb[130], pb[195]); w.z = pk2(pb[260], pb[325]); w.w = pk2(pb[390], pb[455]);
                        acc = mfma16(af[kk], __builtin_bit_cast(bf16x8, w), acc); }
#pragma unroll
                    for (int j = 0; j < 4; ++j) xb[(16 * R + fq * 4 + j) * 65] -= acc[j]; }
            }
            LBAR();
            if (act && gt < 128) { const int c = gt; LAS float* col = ((c < 64) ? ks : vs) + (c & 63) + (16 * R) * 65; const LAS float* Dg = As + (16 * R) * 64 + 16 * R;
                float x[16];
                if (16 * R >= L) {
#pragma unroll
                    for (int a = 0; a < 16; ++a) x[a] = 0.f;
                } else {
#pragma unroll
                for (int a = 0; a < 16; ++a) { float v = col[a * 65];
                    f32x4 d[4];
#pragma unroll
                    for (int q4 = 0; q4 < 4; ++q4) if (4 * q4 < a) d[q4] = *(const LAS f32x4*)(Dg + a * 64 + 4 * q4);
#pragma unroll
                    for (int q = 0; q < a; ++q) v -= d[q >> 2][q & 3] * x[q];
                    x[a] = v; if ((a & 3) == 3) __builtin_amdgcn_sched_barrier(0); } }
#pragma unroll
                for (int a = 0; a < 16; ++a) { col[a * 65] = x[a];
                    if (c < 64) Wd[(16 * R + a) * 64 + c] = (bf16)f2bf(x[a]); else Uv[(16 * R + a) * 64 + (c - 64)] = x[a]; }
            }
            LBAR();
        }
#ifdef PROBE_SOLVE
        }
#endif
    }
}

__device__ __forceinline__ bf16x8 ldA2(const bf16* Mx, int row, int kk, int fq) {
    const bf16* p = Mx + row * 64 + 32 * kk + fq * 4; const s16x4 a = *(const s16x4*)p, b = *(const s16x4*)(p + 16);
    bf16x8 r; r[0] = a[0]; r[1] = a[1]; r[2] = a[2]; r[3] = a[3]; r[4] = b[0]; r[5] = b[1]; r[6] = b[2]; r[7] = b[3]; return r;
}
__device__ __forceinline__ void split8(const f32x4& lo4, const f32x4& hi4, bf16x8& h, bf16x8& lw) {
    u32x4 hw; hw.x = pk2(lo4[0], lo4[1]); hw.y = pk2(lo4[2], lo4[3]); hw.z = pk2(hi4[0], hi4[1]); hw.w = pk2(hi4[2], hi4[3]);
    h = __builtin_bit_cast(bf16x8, hw);
    if (GDN_SPLIT) {
        u32x4 lo; lo.x = pk2(lo4[0] - bf2f(hw.x & 0xffffu), lo4[1] - __builtin_bit_cast(float, hw.x & 0xffff0000u)); lo.y = pk2(lo4[2] - bf2f(hw.y & 0xffffu), lo4[3] - __builtin_bit_cast(float, hw.y & 0xffff0000u));
        lo.z = pk2(hi4[0] - bf2f(hw.z & 0xffffu), hi4[1] - __builtin_bit_cast(float, hw.z & 0xffff0000u)); lo.w = pk2(hi4[2] - bf2f(hw.w & 0xffffu), hi4[3] - __builtin_bit_cast(float, hw.w & 0xffff0000u));
        lw = __builtin_bit_cast(bf16x8, lo);
    } else lw = h;
}
constexpr int G2_MAT = 9216, G2_UV = 4 * G2_MAT, G2_Z = G2_UV + 64 * 272, G2_GAM = G2_Z + 9216, G2_BUF = G2_GAM + 16, G2_RED = 2 * G2_BUF;
static_assert(G2_RED + 2048 <= LDS_BYTES, "g2 lds");
__device__ __forceinline__ bf16x8 ldA2s(const LAS unsigned char* mat, int row, int kk, int fq) {
    const LAS unsigned char* p = mat + row * 144 + 64 * kk + fq * 8; const s16x4 a = *(const LAS s16x4*)p, b = *(const LAS s16x4*)(p + 32);
    bf16x8 r; r[0] = a[0]; r[1] = a[1]; r[2] = a[2]; r[3] = a[3]; r[4] = b[0]; r[5] = b[1]; r[6] = b[2]; r[7] = b[3]; return r;
}
__device__ __forceinline__ void g2_stage(LAS unsigned char* buf, const unsigned char* ub, const bf16* zsrc  , int ht, int nthr) {
    for (int c = ht; c < 2048; c += nthr) { const int mat = c >> 9, w = c & 511, row = w >> 3, seg = w & 7;
        *(LAS u32x4*)(buf + mat * G2_MAT + row * 144 + seg * 16) = *(const u32x4*)(ub + mat * 8192 + row * 128 + seg * 16); }
    for (int c = ht; c < 1024; c += nthr) { const int row = c >> 4, seg = c & 15;
        *(LAS u32x4*)(buf + G2_UV + row * 272 + seg * 16) = *(const u32x4*)(ub + 32768 + row * 256 + seg * 16); }
    for (int c = ht; c < 512; c += nthr) { const int row = c >> 3, seg = c & 7;
        *(LAS u32x4*)(buf + G2_Z + row * 144 + seg * 16) = *(const u32x4*)((const unsigned char*)(zsrc + (size_t)row * HLD) + seg * 16); }
    if (ht == 0) *(LAS float*)(buf + G2_GAM) = *(const float*)(ub + 49152);
}
__device__ __forceinline__ void g2_load(u32x4 (&r)[14], float& gam, const unsigned char* ub, const bf16* zsrc, int ht) {
    const unsigned go = 16u * ht, gz = (ht >> 3) * (HLD * 2) + (ht & 7) * 16;
#pragma unroll
    for (int i = 0; i < 8; ++i) r[i] = *(const u32x4*)(ub + i * 4096 + go);
#pragma unroll
    for (int i = 0; i < 4; ++i) r[8 + i] = *(const u32x4*)(ub + 32768 + i * 4096 + go);
#pragma unroll
    for (int i = 0; i < 2; ++i) r[12 + i] = *(const u32x4*)((const unsigned char*)zsrc + (size_t)i * 32 * HLD * 2 + gz);
    gam = *(const float*)(ub + 49152);
}
__device__ __forceinline__ void g2_store(LAS unsigned char* buf, const u32x4 (&r)[14], float gam, int ht) {
    LAS unsigned char* lm = buf + (ht >> 3) * 144 + (ht & 7) * 16; LAS unsigned char* lu = buf + G2_UV + (ht >> 4) * 272 + (ht & 15) * 16;
#pragma unroll
    for (int i = 0; i < 8; ++i) *(LAS u32x4*)(lm + (i >> 1) * G2_MAT + (i & 1) * 32 * 144) = r[i];
#pragma unroll
    for (int i = 0; i < 4; ++i) *(LAS u32x4*)(lu + i * 16 * 272) = r[8 + i];
#pragma unroll
    for (int i = 0; i < 2; ++i) *(LAS u32x4*)(lm + G2_Z + i * 32 * 144) = r[12 + i];
    if (ht == 0) *(LAS float*)(buf + G2_GAM) = gam;
}
#define G2_BAR() asm volatile("s_waitcnt lgkmcnt(0)\n\ts_barrier" ::: "memory")
__device__ __forceinline__ void g2_phase(const PP P, int l, LAS unsigned char* lds) {
    const int tid = P.tid, lane = tid & 63, wave = tid >> 6, fr = lane & 15, fq = lane >> 4, G = P.G;
    LAS float* red = (LAS float*)(lds + G2_RED);
    const bf16* H = (const bf16*)(P.ws + WS_H); bf16* MIX = (bf16*)(P.ws + WS_MIX);
    for (int u = P.bid; u < 192; u += G) {
        const bool smp = u >= 64; const int bh = smp ? u - 64 : u, b = bh >> 2, h = bh & 3, nch = smp ? 1 : 32, L = smp ? 16 : 64;
        const size_t seq0 = smp ? (size_t)MP + b * 16 : (size_t)b * 2048; const int gu0 = smp ? 2048 + bh : bh * 32;
        const bool act = wave < 4; const int dv = 16 * (wave & 3) + fr;
        const unsigned char* gs0 = P.ws + WS_GSCR + (size_t)gu0 * GUNIT; const bf16* z0 = H + seq0 * HLD + C_Z + h * 64;
        f32x4 S[4];
#pragma unroll
        for (int m = 0; m < 4; ++m)
#pragma unroll
            for (int j = 0; j < 4; ++j) S[m][j] = (smp && act) ? KIN(4)[(((size_t)(l * 32 + b) * 4 + h) * 64 + (16 * m + fq * 4 + j)) * 64 + dv] : 0.f;
        const float gnw = KIN(16)[l * 64 + dv];
        g2_stage(lds, gs0, z0, tid, 512);
        u32x4 hr_[14]; float hgam = 0.f;
#pragma unroll
        for (int i = 0; i < 14; ++i) hr_[i] = (u32x4){0u, 0u, 0u, 0u};
        if (!act && nch > 1) g2_load(hr_, hgam, gs0 + GUNIT, z0 + (size_t)64 * HLD, tid - 256);
        G2_BAR();
        for (int n = 0; n < nch; ++n) {
            LAS unsigned char* buf = lds + (n & 1) * G2_BUF;
            f32x4 O[4]; float zr[4][4];
            if (!act) {
                if (n + 1 < nch) g2_store(lds + ((n + 1) & 1) * G2_BUF, hr_, hgam, tid - 256);
                if (n + 2 < nch) g2_load(hr_, hgam, gs0 + (size_t)(n + 2) * GUNIT, z0 + (size_t)(n + 2) * 64 * HLD, tid - 256);
            } else {
                bf16x8 Sh[2], Sl[2]; split8(S[0], S[1], Sh[0], Sl[0]); split8(S[2], S[3], Sh[1], Sl[1]);
                f32x4 U[4];
#pragma unroll
                for (int mi = 0; mi < 4; ++mi) { f32x4 acc = {0.f, 0.f, 0.f, 0.f};
#pragma unroll
                    for (int kk = 0; kk < 2; ++kk) { const bf16x8 a = ldA2s(buf, 16 * mi + fr, kk, fq); acc = mfma16(a, Sh[kk], acc); if (GDN_SPLIT) acc = mfma16(a, Sl[kk], acc); }
#pragma unroll
                    for (int j = 0; j < 4; ++j) { const int i = 16 * mi + fq * 4 + j; U[mi][j] = *(const LAS float*)(buf + G2_UV + i * 272 + dv * 4) - acc[j];
                        zr[mi][j] = bf2f(*(const LAS bf16*)(buf + G2_Z + i * 144 + dv * 2)); } }
                bf16x8 Uh[2], Ul[2]; split8(U[0], U[1], Uh[0], Ul[0]); split8(U[2], U[3], Uh[1], Ul[1]);
#pragma unroll
                for (int mi = 0; mi < 4; ++mi) { f32x4 acc = {0.f, 0.f, 0.f, 0.f};
#pragma unroll
                    for (int kk = 0; kk < 2; ++kk) { const bf16x8 a = ldA2s(buf + 3 * G2_MAT, 16 * mi + fr, kk, fq); acc = mfma16(a, Sh[kk], acc); if (GDN_SPLIT) acc = mfma16(a, Sl[kk], acc);
                        const bf16x8 a2 = ldA2s(buf + G2_MAT, 16 * mi + fr, kk, fq); acc = mfma16(a2, Uh[kk], acc); if (GDN_SPLIT) acc = mfma16(a2, Ul[kk], acc); }
                    O[mi] = acc; }
                const float gamL = *(const LAS float*)(buf + G2_GAM);
#pragma unroll
                for (int m = 0; m < 4; ++m) { f32x4 acc = S[m] * gamL;
#pragma unroll
                    for (int kk = 0; kk < 2; ++kk) { const bf16x8 a = ldA2s(buf + 2 * G2_MAT, 16 * m + fr, kk, fq); acc = mfma16(a, Uh[kk], acc); if (GDN_SPLIT) acc = mfma16(a, Ul[kk], acc); }
                    S[m] = acc; }
#pragma unroll
                for (int mi = 0; mi < 4; ++mi)
#pragma unroll
                    for (int j = 0; j < 4; ++j) { const float s = row16_sum(O[mi][j] * O[mi][j]);
                        if (fr == 0) red[(n & 1) * 256 + wave * 64 + 16 * mi + fq * 4 + j] = s; }
            }
            G2_BAR();
            if (act) {
#pragma unroll
                for (int mi = 0; mi < 4; ++mi)
#pragma unroll
                    for (int j = 0; j < 4; ++j) { const int i = 16 * mi + fq * 4 + j; LAS float* rp = red + (n & 1) * 256 + i;
                        const float tot = rp[0] + rp[64] + rp[128] + rp[192]; const float rinv = rsqrtf(tot * (1.0f / 64.0f) + 1e-6f);
                        if (i < L) { const size_t row = seq0 + (size_t)n * 64 + i;
                            MIX[row * 1024 + 512 + h * 64 + dv] = (bf16)f2bf(O[mi][j] * rinv * gnw * siluf_(zr[mi][j])); } }
            }
        }
        if (act) { float* so = smp ? P.out + O_GDNS + ((size_t)(l * 32 + b) * 4 + h) * 4096 : P.out + O_GDNP + ((size_t)(l * 16 + b) * 4 + h) * 4096;
#pragma unroll
            for (int m = 0; m < 4; ++m)
#pragma unroll
                for (int j = 0; j < 4; ++j) so[(16 * m + fq * 4 + j) * 64 + dv] = S[m][j]; }
        __syncthreads();
    }
}

constexpr int AT_KROW = 208, AT_VROW = 144, AT_V = 64 * AT_KROW, AT_STAGE = AT_V + 64 * AT_VROW, AT_COMB = 2 * AT_STAGE;
static_assert(AT_COMB + 8 * 64 * 18 * 4 <= LDS_BYTES, "attn lds");
__device__ __forceinline__ void attn_prompt_unit(const PP P, LAS unsigned char* lds, int b, int h, int qt) {
    const int tid = P.tid, lane = tid & 63, wave = tid >> 6, fr = lane & 15, fq = lane >> 4;
    const bf16* Q = (const bf16*)(P.ws + WS_XB); const bf16* KN = (const bf16*)(P.ws + WS_KN); const bf16* VT = (const bf16*)(P.ws + WS_VT);
    const bf16* KPEB = (const bf16*)(P.ws + WS_KPEB); bf16* MIX = (bf16*)(P.ws + WS_MIX);
    const int qrow0 = b * 2048 + 256 * qt + 32 * wave, keybase = b * 2048;
    const int nt_blk = 4 * qt + 4, nt_w = 4 * qt + (wave >> 1) + 1;
    bf16x8 Qb[2][3];
#pragma unroll
    for (int g = 0; g < 2; ++g)
#pragma unroll
        for (int ks = 0; ks < 3; ++ks) Qb[g][ks] = *(const bf16x8*)(Q + (size_t)(qrow0 + 16 * g + fr) * 768 + h * 96 + 32 * ks + fq * 8);
    float m[2] = {-INFINITY, -INFINITY}, lsum[2] = {0.f, 0.f}; f32x4 O[2][4];
#pragma unroll
    for (int g = 0; g < 2; ++g)
#pragma unroll
        for (int nt = 0; nt < 4; ++nt) O[g][nt] = (f32x4){0.f, 0.f, 0.f, 0.f};
    const int r8 = tid >> 3, s8 = tid & 7, r4 = (tid & 255) >> 2, s4 = tid & 3;
    const bf16* gk = KN + (size_t)(keybase + r8) * 512 + h * 64 + s8 * 8;
    const bf16* gp = KPEB + (size_t)(keybase + r4) * 32 + s4 * 8;
    const bf16* gv = VT + (size_t)(h * 64 + r8) * NK + keybase + s8 * 8;
    const int lk = r8 * AT_KROW + s8 * 16, lp = r4 * AT_KROW + 128 + s4 * 16, lv = AT_V + r8 * AT_VROW + s8 * 16;
    u32x4 rk = *(const u32x4*)gk, rv = *(const u32x4*)gv, rp = {0u, 0u, 0u, 0u}; if (tid < 256) rp = *(const u32x4*)gp;
    *(LAS u32x4*)(lds + lk) = rk; *(LAS u32x4*)(lds + lv) = rv; if (tid < 256) *(LAS u32x4*)(lds + lp) = rp;
    __syncthreads();
    for (int kt = 0; kt < nt_blk; ++kt) {
        const bool more = kt + 1 < nt_blk;
        if (more) { rk = *(const u32x4*)(gk + (size_t)(kt + 1) * 64 * 512); rv = *(const u32x4*)(gv + (kt + 1) * 64); if (tid < 256) rp = *(const u32x4*)(gp + (size_t)(kt + 1) * 64 * 32); }
        if (kt < nt_w) {
            const LAS unsigned char* kb = lds + (kt & 1) * AT_STAGE; const LAS unsigned char* vb = kb + AT_V;
            f32x4 s[2][4];
#pragma unroll
            for (int sb = 0; sb < 4; ++sb) { s[0][sb] = (f32x4){0.f, 0.f, 0.f, 0.f}; s[1][sb] = (f32x4){0.f, 0.f, 0.f, 0.f};
#pragma unroll
                for (int ks = 0; ks < 3; ++ks) { const bf16x8 kf = *(const LAS bf16x8*)(kb + (16 * sb + fr) * AT_KROW + ks * 64 + fq * 16);
                    s[0][sb] = mfma16(kf, Qb[0][ks], s[0][sb]); s[1][sb] = mfma16(kf, Qb[1][ks], s[1][sb]); } }
            bf16x8 Pb[2][2];
#pragma unroll
            for (int g = 0; g < 2; ++g) {
                float mx = -INFINITY;
#pragma unroll
                for (int sb = 0; sb < 4; ++sb) mx = fmaxf(mx, fmaxf(fmaxf(s[g][sb][0], s[g][sb][1]), fmaxf(s[g][sb][2], s[g][sb][3])));
                mx = fmaxf(mx, xor16_get(mx)); mx = xor32_max(mx);
                const float mnew = fmaxf(m[g], mx), alpha = __builtin_amdgcn_exp2f(m[g] - mnew); m[g] = mnew;
                float ps = 0.f; float p[4][4];
#pragma unroll
                for (int sb = 0; sb < 4; ++sb)
#pragma unroll
                    for (int j = 0; j < 4; ++j) { p[sb][j] = __builtin_amdgcn_exp2f(s[g][sb][j] - mnew); ps += p[sb][j]; }
                lsum[g] = lsum[g] * alpha + ps;
#pragma unroll
                for (int kk = 0; kk < 2; ++kk) { u32x4 pw; pw.x = pk2(p[2 * kk][0], p[2 * kk][1]); pw.y = pk2(p[2 * kk][2], p[2 * kk][3]); pw.z = pk2(p[2 * kk + 1][0], p[2 * kk + 1][1]); pw.w = pk2(p[2 * kk + 1][2], p[2 * kk + 1][3]);
                    Pb[g][kk] = __builtin_bit_cast(bf16x8, pw); }
#pragma unroll
                for (int nt = 0; nt < 4; ++nt) O[g][nt] = O[g][nt] * alpha;
            }
#pragma unroll
            for (int nt = 0; nt < 4; ++nt)
#pragma unroll
                for (int kk = 0; kk < 2; ++kk) { const LAS unsigned char* vp = vb + (16 * nt + fr) * AT_VROW + kk * 64 + fq * 8;
                    const s16x4 a = *(const LAS s16x4*)vp, c = *(const LAS s16x4*)(vp + 32);
                    bf16x8 vf; vf[0] = a[0]; vf[1] = a[1]; vf[2] = a[2]; vf[3] = a[3]; vf[4] = c[0]; vf[5] = c[1]; vf[6] = c[2]; vf[7] = c[3];
                    O[0][nt] = mfma16(vf, Pb[0][kk], O[0][nt]); O[1][nt] = mfma16(vf, Pb[1][kk], O[1][nt]); }
        }
        if (more) { LAS unsigned char* nb = lds + ((kt + 1) & 1) * AT_STAGE; *(LAS u32x4*)(nb + lk) = rk; *(LAS u32x4*)(nb + lv) = rv; if (tid < 256) *(LAS u32x4*)(nb + lp) = rp; }
        __syncthreads();
    }
#pragma unroll
    for (int g = 0; g < 2; ++g) { float lt = lsum[g]; lt += xor16_get(lt); lt = xor32_sum(lt); const float inv = 1.0f / lt;
#pragma unroll
        for (int nt = 0; nt < 4; ++nt) { u32x2 w; w.x = pk2(O[g][nt][0] * inv, O[g][nt][1] * inv); w.y = pk2(O[g][nt][2] * inv, O[g][nt][3] * inv);
            *(u32x2*)(MIX + (size_t)(qrow0 + 16 * g + fr) * 1024 + h * 64 + 16 * nt + fq * 4) = w; } }
}
__device__ __forceinline__ void attn_sample_unit(const PP P, LAS unsigned char* lds, int b, int h) {
    const int tid = P.tid, lane = tid & 63, wave = tid >> 6, fr = lane & 15, fq = lane >> 4;
    const bf16* Q = (const bf16*)(P.ws + WS_XB); const bf16* KN = (const bf16*)(P.ws + WS_KN); const bf16* VT = (const bf16*)(P.ws + WS_VT);
    const bf16* KPEB = (const bf16*)(P.ws + WS_KPEB); bf16* MIX = (bf16*)(P.ws + WS_MIX);
    const int qrow0 = MP + b * 16, keybase = MP, nkeys = SKS;
    const bf16* qp = Q + (size_t)(qrow0 + fr) * 768 + h * 96 + fq * 8;
    bf16x8 Qb[3];
#pragma unroll
    for (int ks = 0; ks < 3; ++ks) Qb[ks] = *(const bf16x8*)(qp + 32 * ks);
    float m = -INFINITY, lsum = 0.f; f32x4 O[4];
#pragma unroll
    for (int nt = 0; nt < 4; ++nt) O[nt] = (f32x4){0.f, 0.f, 0.f, 0.f};
    const int nblk = (nkeys + 31) >> 5, kb0 = (wave * nblk) >> 3, kb1 = ((wave + 1) * nblk) >> 3;
    for (int kb = kb0; kb < kb1; ++kb) {
        f32x4 s[2]; int kof[2];
#pragma unroll
        for (int sub = 0; sub < 2; ++sub) { const int key0 = kb * 32 + sub * 16; const bool valid = key0 < nkeys; kof[sub] = (valid && key0 >= 2048) ? 65536 + b * 16 + (key0 - 2048) : b * 2048 + (valid ? key0 : 0);
            const size_t kr = (size_t)keybase + kof[sub] + fr;
            const bf16x8 a0 = *(const bf16x8*)(KN + kr * 512 + h * 64 + fq * 8), a1 = *(const bf16x8*)(KN + kr * 512 + h * 64 + 32 + fq * 8), a2 = *(const bf16x8*)(KPEB + kr * 32 + fq * 8);
            f32x4 acc = {0.f, 0.f, 0.f, 0.f}; acc = mfma16(a0, Qb[0], acc); acc = mfma16(a1, Qb[1], acc); acc = mfma16(a2, Qb[2], acc);
            if (!valid) acc = (f32x4){-INFINITY, -INFINITY, -INFINITY, -INFINITY};
            s[sub] = acc; }
        float mx = fmaxf(fmaxf(fmaxf(s[0][0], s[0][1]), fmaxf(s[0][2], s[0][3])), fmaxf(fmaxf(s[1][0], s[1][1]), fmaxf(s[1][2], s[1][3])));
        mx = fmaxf(mx, xor16_get(mx)); mx = xor32_max(mx);
        const float mnew = fmaxf(m, mx); const float alpha = __builtin_amdgcn_exp2f(m - mnew); m = mnew;
        float p[8]; float ps = 0.f;
#pragma unroll
        for (int j = 0; j < 4; ++j) { p[j] = __builtin_amdgcn_exp2f(s[0][j] - mnew); p[4 + j] = __builtin_amdgcn_exp2f(s[1][j] - mnew); ps += p[j] + p[4 + j]; }
        lsum = lsum * alpha + ps;
        u32x4 pw; pw.x = pk2(p[0], p[1]); pw.y = pk2(p[2], p[3]); pw.z = pk2(p[4], p[5]); pw.w = pk2(p[6], p[7]);
        const bf16x8 Pb = __builtin_bit_cast(bf16x8, pw);
#pragma unroll
        for (int nt = 0; nt < 4; ++nt) { const bf16* vrow = VT + (size_t)(h * 64 + 16 * nt + fr) * NK + keybase + fq * 4;
            const s16x4 a = *(const s16x4*)(vrow + kof[0]), c = *(const s16x4*)(vrow + kof[1]);
            bf16x8 va; va[0] = a[0]; va[1] = a[1]; va[2] = a[2]; va[3] = a[3]; va[4] = c[0]; va[5] = c[1]; va[6] = c[2]; va[7] = c[3];
            O[nt] = mfma16(va, Pb, O[nt] * alpha); }
    }
    float lt = lsum; lt += xor16_get(lt); lt = xor32_sum(lt);
    LAS float* cb = (LAS float*)(lds + AT_COMB) + (wave * 64 + lane) * 18;
#pragma unroll
    for (int nt = 0; nt < 4; ++nt)
#pragma unroll
        for (int j = 0; j < 4; ++j) cb[nt * 4 + j] = O[nt][j];
    cb[16] = m; cb[17] = lt;
    __syncthreads();
    if (wave == 0) {
        float mm = -INFINITY;
#pragma unroll
        for (int w = 0; w < 8; ++w) mm = fmaxf(mm, ((LAS float*)(lds + AT_COMB))[(w * 64 + lane) * 18 + 16]);
        float L = 0.f; float acc[16];
#pragma unroll
        for (int i = 0; i < 16; ++i) acc[i] = 0.f;
#pragma unroll
        for (int w = 0; w < 8; ++w) { const LAS float* pp = (LAS float*)(lds + AT_COMB) + (w * 64 + lane) * 18; const float sc = __builtin_amdgcn_exp2f(pp[16] - mm); L += pp[17] * sc;
#pragma unroll
            for (int i = 0; i < 16; ++i) acc[i] += pp[i] * sc; }
        const float inv = 1.0f / L;
#pragma unroll
        for (int nt = 0; nt < 4; ++nt) { u32x2 w; w.x = pk2(acc[nt * 4] * inv, acc[nt * 4 + 1] * inv); w.y = pk2(acc[nt * 4 + 2] * inv, acc[nt * 4 + 3] * inv);
            *(u32x2*)(MIX + (size_t)(qrow0 + fr) * 1024 + h * 64 + 16 * nt + fq * 4) = w; }
    }
    __syncthreads();
}
__device__ __forceinline__ void attn_phase(const PP P, LAS unsigned char* lds) {
    const int G = P.G;
    for (int u = P.bid; u < 256 + 1024; u += G) {
        if (u < 256) { attn_sample_unit(P, lds, u >> 3, u & 7); }
        else { const int v = u - 256, bh = v & 127, half = (v >> 7) & 1, k = v >> 8;
            const int qt = (k == 0) ? 7 - half : (k == 1) ? half : (k == 2) ? 5 - half : 2 + half;
            attn_prompt_unit(P, lds, bh >> 3, bh & 7, qt); }
    }
}

__device__ __forceinline__ void ln_phase(const PP P, const float* g, const float* bta) {
    const int tid = P.tid, lane = tid & 63, wave = tid >> 6, G = P.G;
    float* X = P.out; bf16* XB = (bf16*)(P.ws + WS_XB);
    for (int row = P.bid * 8 + wave; row < MT; row += G * 8) {
        float* p = X + (size_t)row * 1024; f32x4 v[4]; float s = 0.f;
#pragma unroll
        for (int i = 0; i < 4; ++i) { v[i] = *(const f32x4*)(p + 256 * i + lane * 4); s += (v[i][0] + v[i][1]) + (v[i][2] + v[i][3]); }
        const float mu = wave_sum(s) * (1.0f / 1024.0f); float q = 0.f;
#pragma unroll
        for (int i = 0; i < 4; ++i) { const f32x4 d = v[i] - mu; q += (d[0] * d[0] + d[1] * d[1]) + (d[2] * d[2] + d[3] * d[3]); }
        const float rstd = rsqrtf(wave_sum(q) * (1.0f / 1024.0f) + 1e-5f);
#pragma unroll
        for (int i = 0; i < 4; ++i) { const int col = 256 * i + lane * 4; const f32x4 gg = *(const f32x4*)(g + col), bb = *(const f32x4*)(bta + col);
            const f32x4 y = (v[i] - mu) * rstd * gg + bb; *(f32x4*)(p + col) = y;
            u32x2 w; w.x = pk2(y[0], y[1]); w.y = pk2(y[2], y[3]); *(u32x2*)(XB + (size_t)row * 1024 + col) = w; }
    }
}

__device__ __forceinline__ void sample_gemm_res(const PP P, LAS unsigned char* lds, const bf16* A  , const bf16* Bt, int K, const float* xin  , float* Xs  ) {
    const int tid = P.tid, lane = tid & 63, wave = tid >> 6, fr = lane & 15, fq = lane >> 4;
    LAS float* part = (LAS float*)lds;
    for (int t = P.bid; t < 256; t += P.G) {
        const int r0 = (t >> 4) * 32, c0 = (t & 15) * 64, kw = K >> 3, kb = wave * kw;
        f32x4 acc[2][4];
#pragma unroll
        for (int a = 0; a < 2; ++a)
#pragma unroll
            for (int n = 0; n < 4; ++n) acc[a][n] = (f32x4){0.f, 0.f, 0.f, 0.f};
        const bf16* ap = A + (size_t)(r0 + fr) * K + kb + fq * 8; const bf16* bp = Bt + (size_t)(c0 + fr) * K + kb + fq * 8;
#pragma unroll 2
        for (int k0 = 0; k0 < kw; k0 += 32) {
            bf16x8 af[2], bf_[4];
#pragma unroll
            for (int a = 0; a < 2; ++a) af[a] = *(const bf16x8*)(ap + (size_t)(16 * a) * K + k0);
#pragma unroll
            for (int n = 0; n < 4; ++n) bf_[n] = *(const bf16x8*)(bp + (size_t)(16 * n) * K + k0);
#pragma unroll
            for (int a = 0; a < 2; ++a)
#pragma unroll
                for (int n = 0; n < 4; ++n) acc[a][n] = mfma16(af[a], bf_[n], acc[a][n]);
        }
        LAS float* mp = part + (wave * 64 + lane) * 33;
#pragma unroll
        for (int a = 0; a < 2; ++a)
#pragma unroll
            for (int n = 0; n < 4; ++n)
#pragma unroll
                for (int j = 0; j < 4; ++j) mp[(a * 4 + n) * 4 + j] = acc[a][n][j];
        __syncthreads();
        { const int grp = wave;
          float sum[4] = {0.f, 0.f, 0.f, 0.f};
#pragma unroll
          for (int w = 0; w < 8; ++w)
#pragma unroll
              for (int j = 0; j < 4; ++j) sum[j] += part[(w * 64 + lane) * 33 + 4 * grp + j];
          const int a = grp >> 2, n = grp & 3, col = c0 + 16 * n + fr;
#pragma unroll
          for (int j = 0; j < 4; ++j) { const int row = r0 + 16 * a + fq * 4 + j; Xs[(size_t)row * 1024 + col] = DN_ALPHA * xin[(size_t)row * 1024 + col] + sum[j]; } }
        __syncthreads();
    }
}

#define GB_LD(p) __hip_atomic_load((p), __ATOMIC_RELAXED, __HIP_MEMORY_SCOPE_AGENT)
#define GB_ADD(p) __hip_atomic_fetch_add((p), 1u, __ATOMIC_RELAXED, __HIP_MEMORY_SCOPE_AGENT)
#define GB_ST(p, v) __hip_atomic_store((p), (v), __ATOMIC_RELAXED, __HIP_MEMORY_SCOPE_AGENT)
__device__ __forceinline__ void fast_grid_bar(unsigned* bar, unsigned k  , int tid, int bid, int G) {
    asm volatile("s_waitcnt vmcnt(0)" ::: "memory");
    __syncthreads();
    if (tid == 0) {
        const unsigned ng = (G < 8) ? (unsigned)G : 8u, g = (unsigned)bid % ng, gsize = ((unsigned)G - g + ng - 1u) / ng;
        unsigned* sub = bar + 64 * g; unsigned* gen = bar + 64 * (8 + g); unsigned* top = bar + 64 * 16; unsigned* topgen = bar + 64 * 17;
        __builtin_amdgcn_fence(__ATOMIC_RELEASE, "agent");
        asm volatile("s_waitcnt vmcnt(0)" ::: "memory");
        const unsigned old = GB_ADD(sub); unsigned sp = 0;
        if (old + 1u == k * gsize) { const unsigned o2 = GB_ADD(top); if (o2 + 1u == k * ng) GB_ST(topgen, k); }
        while (GB_LD(topgen) < k) { __builtin_amdgcn_s_sleep(1); if (++sp > (1u << 24)) break; }
        __builtin_amdgcn_fence(__ATOMIC_ACQUIRE, "agent");
        asm volatile("s_waitcnt vmcnt(0)" ::: "memory");
    }
    __syncthreads();
}

__global__ void __launch_bounds__(512) mega(Params P) {
    extern __shared__ __attribute__((aligned(16))) unsigned char lds_raw[];
    LAS unsigned char* lds = (LAS unsigned char*)lds_raw;
    cg::grid_group grid = cg::this_grid();
    const int lo_ = P.lo, hi_ = P.hi; const int wave_s = __builtin_amdgcn_readfirstlane((int)(threadIdx.x >> 6));
    for (int step = lo_; step < hi_; ++step) {
        PP pp; pp.ws = KWS(); pp.out = KOUT(); unsigned char* ws = pp.ws;
        { int t_, b_ = blockIdx.x, g_ = gridDim.x; asm volatile("v_mbcnt_lo_u32_b32 %0, -1, 0\n\tv_mbcnt_hi_u32_b32 %0, -1, %0\n\tv_lshl_add_u32 %0, %3, 6, %0" : "=&v"(t_), "+s"(b_), "+s"(g_) : "s"(wave_s)); pp.tid = t_; pp.bid = b_; pp.G = g_; }
        int l = 0, kind = 0;
        if (REPK == 0) { if (step > 0) { l = (step - 1) / 10; kind = 1 + (step - 1) % 10; } }
        else if (step > 0) { l = (step - 1) / 11; const int kidx = (step - 1) % 11; kind = (kidx < REPK) ? kidx + 1 : kidx; if (kind == 6 && l == 1 && kidx == REPK) kind = 11; }
        const bf16* WB = (const bf16*)(ws + WS_W) + (size_t)l * W_LAYER;
        int nj = 0;
        PP pp2 = pp; const bool split = pp.G > 64; if (split) { pp2.bid = pp.bid - 64; pp2.G = pp.G - 64; }
        const bool shadow = !split || pp.bid >= 64;
        switch (kind) {
            case 0: prep_phase(pp, lds, 0, true); break;
            case 2: tok_phase(pp, l); g1_phase(pp, l, lds); break;
            case 3: g2_phase(pp, l, lds);
                     if (shadow) { conv_phase(pp2, l, lds); cache_phase(pp2, l); if (l == 0) prep_phase(pp2, lds, 1, false); nj = 1; }
                     break;
            case 5: attn_phase(pp, lds); break;
            case 7: ln_phase(pp, KIN(22) + l * 1024, KIN(23) + l * 1024); break;
            case 10: ln_phase(pp, KIN(27) + l * 1024, KIN(28) + l * 1024); break;
            case 4: nj = 3; break;
            case 11: break;
            default: nj = 1; break;
        }
        if (kind == 6 || kind == 9) {
            const float* xs_ = (kind == 6 && l == 0) ? KIN(1) : pp.out + (size_t)MP * 1024;
            if (kind == 6) sample_gemm_res(pp, lds, (const bf16*)(ws + WS_MIX) + (size_t)MP * 1024, WB + W_OUT, 1024, xs_, pp.out + (size_t)MP * 1024);
            else           sample_gemm_res(pp, lds, (const bf16*)(ws + WS_F) + (size_t)MP * DFF, WB + W_DN, DFF, xs_, pp.out + (size_t)MP * 1024);
        }
        for (int j = 0; j < nj; ++j) {
            pg8::Gemm g; bool perm; int mode; bf16* O = nullptr; size_t ldc = 0;
            if (kind == 1)      { g = pg8::Gemm{(const bf16*)(ws + WS_XB), WB + W_IN, MT, HLD, 1024}; perm = true; mode = 0; O = (bf16*)(ws + WS_H); ldc = HLD; }
            else if (kind == 3) { g = pg8::Gemm{(const bf16*)(ws + WS_CQN), WB + W_UQ, MT, 768, 384}; perm = false; mode = 2; O = (bf16*)(ws + WS_XB); ldc = 768; }
            else if (kind == 4 && j == 2 && pp.bid < 4) { g = pg8::Gemm{(const bf16*)(ws + WS_CKVB) + (size_t)NKM * 256, WB + W_UK, 512, 512, 256}; perm = true; mode = 0; O = (bf16*)(ws + WS_KN) + (size_t)NKM * 512; ldc = 512; }
            else if (kind == 4 && j == 2) { g = pg8::Gemm{WB + W_UVT, (const bf16*)(ws + WS_CKVB) + (size_t)NKM * 256, 512, 512, 256}; perm = true; mode = 0; O = (bf16*)(ws + WS_VT) + NKM; ldc = NK; }
            else if (kind == 4 && j == 0) { g = pg8::Gemm{(const bf16*)(ws + WS_CKVB), WB + W_UK, NKM, 512, 256}; perm = true; mode = 0; O = (bf16*)(ws + WS_KN); ldc = 512; }
            else if (kind == 4)           { g = pg8::Gemm{WB + W_UVT, (const bf16*)(ws + WS_CKVB), 512, NKM, 256}; perm = true; mode = 0; O = (bf16*)(ws + WS_VT); ldc = NK; }
            else if (kind == 6) { g = pg8::Gemm{(const bf16*)(ws + WS_MIX), WB + W_OUT, MP, 1024, 1024}; perm = false; mode = 3; }
            else if (kind == 8) { g = pg8::Gemm{(const bf16*)(ws + WS_XB), WB + W_GU, MT, 5632, 1024}; perm = true; mode = 1; O = (bf16*)(ws + WS_F); ldc = DFF; }
            else                { g = pg8::Gemm{(const bf16*)(ws + WS_F), WB + W_DN, MP, 1024, DFF}; perm = false; mode = 3; }
            const float* xp = pp.out; const float* xs = pp.out + (size_t)MP * 1024; if (kind == 6 && l == 0) { xp = KIN(0); xs = KIN(1); }
            pg8::StaticOrder S; if (kind == 3) S.init(g.M, g.N, pp2.G, pp2.bid); else if (kind == 4 && j == 2) S.init(g.M, g.N, pp.G, (pp.bid < 4) ? pp.bid : ((pp.bid - 4 + pp.G) % pp.G)); else S.init(g.M, g.N, pp.G, pp.bid);
            if (perm) { EpiT<true> E{mode, O, ldc, xp, xs, pp.out, (const float2*)(ws + WS_ROPE)}; pg8::gemm_phase<EpiT<true>, pg8::StaticOrder, true, true>(lds, g, S, E, pp.tid); }
            else      { EpiT<false> E{mode, O, ldc, xp, xs, pp.out, (const float2*)(ws + WS_ROPE)}; pg8::gemm_phase<EpiT<false>, pg8::StaticOrder, true, true>(lds, g, S, E, pp.tid); }
            __syncthreads();
        }
        if (step + 1 < hi_) {
            if (step == lo_) grid.sync();
            else fast_grid_bar((unsigned*)(ws + WS_BAR), (unsigned)(step - lo_), pp.tid, pp.bid, pp.G);
        }
    }
}

extern "C" void kernel_launch(void* const* d_in, const int* in_sizes, int n_in, void* d_out, int out_size, void* d_ws, size_t ws_size, hipStream_t stream) {
    static int grid_blocks = 0;
    if (!grid_blocks) {
        if (hipFuncSetAttribute((const void*)mega, hipFuncAttributeMaxDynamicSharedMemorySize, LDS_BYTES) != hipSuccess) { fprintf(stderr, "kernel_launch: hipFuncSetAttribute failed\n"); grid_blocks = -1; }
        else { int dev = 0, cus = 0, per_cu = 0; hipGetDevice(&dev); hipDeviceGetAttribute(&cus, hipDeviceAttributeMultiprocessorCount, dev);
            hipOccupancyMaxActiveBlocksPerMultiprocessor(&per_cu, mega, 512, LDS_BYTES);
            if (per_cu < 1) { fprintf(stderr, "kernel_launch: occupancy query says %d\n", per_cu); per_cu = 1; }
            grid_blocks = cus; }
    }
    if (grid_blocks <= 0) return;
    if (ws_size < WS_TOTAL || n_in < 29) { fprintf(stderr, "kernel_launch: workspace too small (%zu < %zu) or n_in %d\n", ws_size, (size_t)WS_TOTAL, n_in); return; }
    Params p{};
    for (int i = 0; i < 29; ++i) p.in[i] = (const float*)d_in[i];
    p.out = (float*)d_out; p.ws = (unsigned char*)d_ws;
#if COOP
    p.lo = 0; p.hi = (REPK == 0) ? 21 : 23; void* args[] = {&p};
    hipMemsetAsync((unsigned char*)d_ws + WS_BAR, 0, 8192, stream);
    hipError_t e = hipLaunchCooperativeKernel((const void*)mega, dim3(grid_blocks), dim3(512), args, LDS_BYTES, stream);
    if (e != hipSuccess) fprintf(stderr, "cooperative launch failed: %s (grid %d)\n", hipGetErrorString(e), grid_blocks);
#else
    for (int s = 0; s < 21; ++s) { p.lo = s; p.hi = s + 1; hipLaunchKernelGGL(mega, dim3(grid_blocks), dim3(512), LDS_BYTES, stream, p); }
#endif
}
```

```cpp
#include <hip/hip_runtime.h>
#include <hip/hip_cooperative_groups.h>
#include <cstdio>
#include <cstdint>
namespace cg = cooperative_groups;
namespace pg8 {
#define PG8_LAS __attribute__((address_space(3)))
typedef unsigned short bf16_t;
typedef short bf16x8 __attribute__((ext_vector_type(8)));
typedef float f32x4 __attribute__((ext_vector_type(4)));
typedef unsigned u32x4 __attribute__((ext_vector_type(4)));
constexpr int BM = 256, BK = 64, HALF = 128, HTB = HALF * BK * 2  , STAGE_BYTES = 8 * HTB, NXCD = 8, WGM = 8;

__host__ __device__ __forceinline__ int lds_byte(int r, int c) { const int st = (r >> 4) * 2 + (c >> 5), rr = r & 15, cc = c & 31, ob = rr * 64 + cc * 2; return st * 1024 + (ob ^ (((ob >> 9) & 1) << 5)); }
__host__ __device__ __forceinline__ void stage_rc(int b, int& R, int& C) { const int st = b / 1024, sb = b % 1024, swz = sb ^ (((sb >> 9) & 1) << 5); R = (st >> 1) * 16 + swz / 64; C = (st & 1) * 32 + (swz % 64) / 2; }
__host__ __device__ __forceinline__ int perm32(int rho) { const int n = rho >> 4, i = rho & 15; return 8 * (i >> 2) + 4 * n + (i & 3); }

struct Unit { int pm, pn; };
struct Gemm { const bf16_t* A; const bf16_t* Bt; int M, N, K; };

struct StaticOrder {
    int nM, nN, nwg, G, c;
    __host__ __device__ void init(int M, int N, int G_, int c_) { nM = M / BM; nN = N / BM; nwg = nM * nN; G = G_; c = c_; }
    __host__ __device__ bool next(int i, Unit& u) const {
        const long L = (long)i * G + c; if (L >= nwg) return false;
        int wgid = (int)L; { const int q = nwg / NXCD, r = nwg % NXCD, xcd = wgid % NXCD, off = wgid / NXCD; wgid = (xcd < r ? xcd * (q + 1) : r * (q + 1) + (xcd - r) * q) + off; }
        const int nig = WGM * nN, gid = wgid / nig, fm = gid * WGM, gsz = (nM - fm) < WGM ? (nM - fm) : WGM;
        u.pm = fm + ((wgid % nig) % gsz); u.pn = (wgid % nig) / gsz; return true;
    }
    __device__ __forceinline__ void a_ready(const Unit&) const {}
    __device__ __forceinline__ void done(const Unit&) const {}
};
__device__ __forceinline__ unsigned cvt_pk_bf16(float lo, float hi) { unsigned r; asm volatile("v_cvt_pk_bf16_f32 %0, %1, %2" : "=v"(r) : "v"(lo), "v"(hi)); return r; }
template <class Epi, class Sched, bool ALIGN_EPI = false, bool SP2 = false>
__device__ __forceinline__ void gemm_phase(PG8_LAS unsigned char* lds, const Gemm g, const Sched& S, const Epi& E, const int tid) {
    const int  wid = __builtin_amdgcn_readfirstlane(tid >> 6), lane = tid & 63, wr = wid >> 2, wc = wid & 3, fr = lane & 15, fq = lane >> 4;
    const int K = g.K, nt = K / BK;
    unsigned voffA[2], voffB[2];
#pragma unroll
    for (int i = 0; i < 2; ++i) { int R, C; stage_rc(tid * 16 + i * 8192, R, C); const int Rb = Epi::PERM ? ((R & ~31) + perm32(R & 31)) : R;
        voffA[i] = (unsigned)(R * K + C) * 2u; voffB[i] = (unsigned)(Rb * K + C) * 2u; }
    const size_t kstep = (size_t)(BK * 2);
    const size_t hstep = (size_t)HALF * K * 2;
    const size_t tstep = 2 * hstep;
    const unsigned ldsw = (unsigned)wid * 1024u;
    const int aoff = lds_byte(wr * 64 + fr, fq * 8), boff = lds_byte(wc * 32 + fr, fq * 8);
#define PG8_SA(b, h) (((b) * 2 + (h)) * HTB)
#define PG8_SB(b, h) ((4 + (b) * 2 + (h)) * HTB)
#define PG8_STAGE(bufoff, gbase, voff) do { _Pragma("unroll") for (int _i = 0; _i < 2; ++_i) \
        __builtin_amdgcn_global_load_lds((const unsigned*)((const char*)(gbase) + (voff)[_i]), (PG8_LAS unsigned*)(lds + (bufoff) + ldsw + _i * 8192), 16, 0, 0); } while (0)
#define PG8_LDA(dst, b, h) do { _Pragma("unroll") for (int m = 0; m < 4; ++m) _Pragma("unroll") for (int k = 0; k < 2; ++k) dst[m][k] = *(const PG8_LAS bf16x8*)(lds + PG8_SA(b, h) + aoff + m * 2048 + k * 1024); } while (0)
#define PG8_LDB(dst, b, h) do { _Pragma("unroll") for (int n = 0; n < 2; ++n) _Pragma("unroll") for (int k = 0; k < 2; ++k) dst[n][k] = *(const PG8_LAS bf16x8*)(lds + PG8_SB(b, h) + boff + n * 2048 + k * 1024); } while (0)
#define PG8_MMA(ai, bj, At, Bt) do { __builtin_amdgcn_s_setprio(1); _Pragma("unroll") for (int m = 0; m < 4; ++m) _Pragma("unroll") for (int n = 0; n < 2; ++n) _Pragma("unroll") for (int k = 0; k < 2; ++k) \
        acc[ai][bj][m][n] = __builtin_amdgcn_mfma_f32_16x16x32_bf16(Bt[n][k], At[m][k], acc[ai][bj][m][n], 0, 0, 0); __builtin_amdgcn_s_setprio(0); } while (0)
#define PG8_WAIT_V(n) asm volatile("s_waitcnt vmcnt(" #n ")" ::: "memory")
#define PG8_WAIT_L(n) asm volatile("s_waitcnt lgkmcnt(" #n ")" ::: "memory")
#define PG8_BAR __builtin_amdgcn_s_barrier()
#define PG8_SCHED __builtin_amdgcn_sched_barrier(0)
    Unit cur, nxt; int ui = 0;
    if (!S.next(0, cur)) return;
    f32x4 acc[2][2][4][2];
#pragma unroll
    for (int a = 0; a < 2; ++a)
#pragma unroll
        for (int b = 0; b < 2; ++b)
#pragma unroll
            for (int m = 0; m < 4; ++m)
#pragma unroll
                for (int n = 0; n < 2; ++n) acc[a][b][m][n] = (f32x4){0.f, 0.f, 0.f, 0.f};
    bf16x8 At[4][2], B0[2][2], B1[2][2];
    const char* cA = (const char*)g.A + (size_t)cur.pm * tstep; const char* cB = (const char*)g.Bt + (size_t)cur.pn * tstep;
    S.a_ready(cur);
    if constexpr (SP2) {
        PG8_STAGE(PG8_SB(0, 0), cB, voffB); PG8_STAGE(PG8_SB(0, 1), cB + hstep, voffB); PG8_STAGE(PG8_SA(0, 0), cA, voffA); PG8_STAGE(PG8_SA(0, 1), cA + hstep, voffA);
        if (wr == 1) PG8_BAR;
        PG8_WAIT_V(2); PG8_BAR;
        PG8_STAGE(PG8_SB(1, 0), cB + kstep, voffB); PG8_STAGE(PG8_SA(1, 0), cA + kstep, voffA); PG8_STAGE(PG8_SB(1, 1), cB + hstep + kstep, voffB);
        PG8_WAIT_V(6); PG8_BAR;
    } else {
        PG8_STAGE(PG8_SB(0, 0), cB, voffB); PG8_STAGE(PG8_SA(0, 0), cA, voffA); PG8_STAGE(PG8_SB(0, 1), cB + hstep, voffB); PG8_STAGE(PG8_SA(0, 1), cA + hstep, voffA);
        if (wr == 1) PG8_BAR;
        PG8_WAIT_V(4); PG8_BAR;
        PG8_STAGE(PG8_SB(1, 0), cB + kstep, voffB); PG8_STAGE(PG8_SA(1, 0), cA + kstep, voffA); PG8_STAGE(PG8_SB(1, 1), cB + hstep + kstep, voffB);
        PG8_WAIT_V(6); PG8_BAR;
    }
    for (;;) {
        const bool has_next = S.next(ui + 1, nxt);
        const char* nA = has_next ? (const char*)g.A + (size_t)nxt.pm * tstep : cA; const char* nB = has_next ? (const char*)g.Bt + (size_t)nxt.pn * tstep : cB;
        for (int t = 0; t < nt; t += 2) {
            const bool last = (t == nt - 2);
            const char* a1 = cA + (size_t)(t + 1) * kstep;
            const char* a2 = last ? nA : cA + (size_t)(t + 2) * kstep; const char* b2 = last ? nB : cB + (size_t)(t + 2) * kstep;
            const char* a3 = a2 + kstep; const char* b3 = b2 + kstep;
            if (last && has_next) S.a_ready(nxt);
            if constexpr (SP2) {
            PG8_LDB(B0, 0, 0); PG8_LDB(B1, 0, 1); PG8_SCHED; PG8_LDA(At, 0, 0); PG8_STAGE(PG8_SA(1, 1), a1 + hstep, voffA);
            PG8_WAIT_V(8); PG8_WAIT_L(0); PG8_BAR; PG8_MMA(0, 0, At, B0); PG8_MMA(0, 1, At, B1); PG8_BAR; PG8_SCHED;
            PG8_LDA(At, 0, 1); PG8_STAGE(PG8_SB(0, 0), b2, voffB); PG8_STAGE(PG8_SB(0, 1), b2 + hstep, voffB); PG8_STAGE(PG8_SA(0, 0), a2, voffA);
            PG8_WAIT_V(8); PG8_WAIT_L(0); PG8_BAR; PG8_MMA(1, 0, At, B0); PG8_MMA(1, 1, At, B1); PG8_BAR; PG8_SCHED;
            PG8_LDB(B0, 1, 0); PG8_LDB(B1, 1, 1); PG8_SCHED; PG8_LDA(At, 1, 0); PG8_STAGE(PG8_SA(0, 1), a2 + hstep, voffA);
            PG8_WAIT_V(8); PG8_WAIT_L(0); PG8_BAR; PG8_MMA(0, 0, At, B0); PG8_MMA(0, 1, At, B1); PG8_BAR; PG8_SCHED;
            PG8_LDA(At, 1, 1); PG8_STAGE(PG8_SB(1, 0), b3, voffB); PG8_STAGE(PG8_SB(1, 1), b3 + hstep, voffB); PG8_STAGE(PG8_SA(1, 0), a3, voffA);
            PG8_WAIT_V(8); PG8_WAIT_L(0); PG8_BAR; PG8_MMA(1, 0, At, B0); PG8_MMA(1, 1, At, B1); PG8_BAR; PG8_SCHED;
            } else {
            PG8_LDB(B0, 0, 0); PG8_SCHED; PG8_LDA(At, 0, 0); PG8_STAGE(PG8_SA(1, 1), a1 + hstep, voffA);
            PG8_WAIT_L(8); PG8_BAR; PG8_WAIT_L(0); PG8_MMA(0, 0, At, B0); PG8_BAR; PG8_SCHED;
            PG8_LDB(B1, 0, 1); PG8_STAGE(PG8_SB(0, 0), b2, voffB);
            PG8_BAR; PG8_WAIT_L(0); PG8_MMA(0, 1, At, B1); PG8_BAR;
            PG8_LDA(At, 0, 1); PG8_STAGE(PG8_SA(0, 0), a2, voffA);
            PG8_BAR; PG8_WAIT_L(0); PG8_MMA(1, 0, At, B0); PG8_BAR; PG8_SCHED;
            PG8_STAGE(PG8_SB(0, 1), b2 + hstep, voffB);
            PG8_WAIT_V(6); PG8_BAR; PG8_MMA(1, 1, At, B1); PG8_BAR;
            PG8_LDB(B0, 1, 0); PG8_SCHED; PG8_LDA(At, 1, 0); PG8_STAGE(PG8_SA(0, 1), a2 + hstep, voffA);
            PG8_WAIT_L(8); PG8_BAR; PG8_WAIT_L(0); PG8_MMA(0, 0, At, B0); PG8_BAR; PG8_SCHED;
            PG8_LDB(B1, 1, 1); PG8_STAGE(PG8_SB(1, 0), b3, voffB);
            PG8_BAR; PG8_WAIT_L(0); PG8_MMA(0, 1, At, B1); PG8_BAR;
            PG8_LDA(At, 1, 1); PG8_STAGE(PG8_SA(1, 0), a3, voffA);
            PG8_BAR; PG8_WAIT_L(0); PG8_MMA(1, 0, At, B0); PG8_BAR; PG8_SCHED;
            PG8_STAGE(PG8_SB(1, 1), b3 + hstep, voffB);
            PG8_WAIT_V(6); PG8_BAR; PG8_MMA(1, 1, At, B1); PG8_BAR;
            }
        }
        if constexpr (ALIGN_EPI) { if (wr == 0) PG8_BAR; }
        if constexpr (!Epi::AFTER_DRAIN) { E(acc, cur, wr, wc, fr, fq); S.done(cur); }
        if (!has_next) break;
#pragma unroll
        for (int a = 0; a < 2; ++a)
#pragma unroll
            for (int b = 0; b < 2; ++b)
#pragma unroll
                for (int m = 0; m < 4; ++m)
#pragma unroll
                    for (int n = 0; n < 2; ++n) acc[a][b][m][n] = (f32x4){0.f, 0.f, 0.f, 0.f};
        cur = nxt; cA = nA; cB = nB; ++ui;
        if constexpr (ALIGN_EPI) { if (wr == 1) PG8_BAR; }
    }
    PG8_WAIT_V(0);
    if constexpr (!ALIGN_EPI) { if (wr == 0) PG8_BAR; }
    PG8_BAR;
    if constexpr (Epi::AFTER_DRAIN) { E.fused(acc, cur, wr, wc, fr, fq, lds, wid, lane); S.done(cur); }
#undef PG8_SA
#undef PG8_SB
#undef PG8_STAGE
#undef PG8_LDA
#undef PG8_LDB
#undef PG8_MMA
#undef PG8_WAIT_V
#undef PG8_WAIT_L
#undef PG8_BAR
#undef PG8_SCHED
}
}

#define LAS __attribute__((address_space(3)))
typedef unsigned short bf16;
typedef short bf16x8 __attribute__((ext_vector_type(8)));
typedef short s16x4 __attribute__((ext_vector_type(4)));
typedef float f32x4 __attribute__((ext_vector_type(4)));
typedef unsigned u32x4 __attribute__((ext_vector_type(4)));
typedef unsigned u32x2 __attribute__((ext_vector_type(2)));

#ifndef COOP
#define COOP 1
#endif
#ifndef REPK
#define REPK 0
#endif
#ifndef REPG1
#define REPG1 0
#endif
#ifndef REP2
#define REP2 0
#endif
#ifndef GDN_SPLIT
#define GDN_SPLIT 0
#endif

constexpr int MP = 32768, MS = 512, MT = MP + MS;
constexpr int SKS = 2064;
constexpr int NK = MP + 32 * SKS;
constexpr int NKM = MP + 65536;
constexpr int HLD = 2304;
constexpr int C_CKV = 384, C_KPE = 640, C_QKV = 672, C_B = 1440, C_A = 1444, C_Z = 1448, C_GA = 1704, C_GG = 1960;
constexpr int DFF = 2816;
constexpr float DN_ALPHA = 1.41421356237f;
constexpr float QSCALE = 0.10206207261596577f * 1.4426950408889634f;

constexpr size_t O_YP = 0, O_YS = 33554432, O_CKVP = 34078720, O_KPEP = 50855936, O_GDNP = 52953088, O_GCP = 53477376,
                 O_CVP = 53551104, O_CKVS = 53796864, O_KPES = 54059008, O_GDNS = 54091776, O_GCS = 55140352, O_CVS = 55287808;

constexpr size_t W_IN = 0, W_UQ = W_IN + 2304 * 1024, W_UK = W_UQ + 768 * 384, W_UVT = W_UK + 512 * 256, W_OUT = W_UVT + 512 * 256,
                 W_GU = W_OUT + 1024 * 1024, W_DN = W_GU + 5632 * 1024, W_LAYER = W_DN + 1024 * 2816;
constexpr size_t WS_W = 0, WS_ROPE = WS_W + 2 * W_LAYER * 2, WS_XB = WS_ROPE + 2064 * 16 * 8, WS_MIX = WS_XB + (size_t)MT * 1024 * 2,
                 WS_CQN = WS_MIX + (size_t)MT * 1024 * 2, WS_CKVB = WS_CQN + (size_t)MT * 384 * 2, WS_KPEB = WS_CKVB + (size_t)NK * 256 * 2,
                 WS_BIG = WS_KPEB + (size_t)NK * 32 * 2;
constexpr size_t GUNIT = 49408;
constexpr int NGU = 2176;
constexpr size_t WS_H = WS_BIG, WS_GSCR = WS_H + (size_t)MT * HLD * 2, BIG1 = (size_t)MT * HLD * 2 + (size_t)NGU * GUNIT;
constexpr size_t WS_Q = WS_BIG, WS_KN = WS_Q + (size_t)MT * 768 * 2, WS_VT = WS_KN + (size_t)NK * 512 * 2, BIG2 = (size_t)MT * 768 * 2 + 2 * (size_t)NK * 512 * 2;
constexpr size_t WS_F = WS_BIG, BIG3 = (size_t)MT * DFF * 2;
constexpr size_t BIGSZ = BIG1 > BIG2 ? (BIG1 > BIG3 ? BIG1 : BIG3) : (BIG2 > BIG3 ? BIG2 : BIG3);
constexpr size_t WS_BAR = WS_BIG + BIGSZ;
constexpr size_t WS_TOTAL = WS_BAR + 8192;
static_assert(WS_TOTAL <= 536870912ull, "workspace map exceeds 512 MiB");
static_assert(WS_XB % 256 == 0 && WS_BIG % 256 == 0 && WS_GSCR % 256 == 0 && WS_KN % 256 == 0 && WS_VT % 256 == 0, "alignment");

constexpr int LDS_BYTES = 139264;
constexpr int G1_GRP = 67584;

struct Params { const float* in[29]; float* out; unsigned char* ws; int lo, hi; };
template <int OFF> __device__ __forceinline__ unsigned long long karg_u64() {
    unsigned long long v; const unsigned long long kp = (unsigned long long)__builtin_amdgcn_kernarg_segment_ptr();
    asm volatile("s_load_dwordx2 %0, %1, %2\n\ts_waitcnt lgkmcnt(0)" : "=s"(v) : "s"(kp), "n"(OFF));
    return v;
}
#define GAS1 __attribute__((address_space(1)))
#define KIN(i) ((const float*)(const GAS1 float*)karg_u64<8 * (i)>())
#define KOUT() ((float*)(GAS1 float*)karg_u64<232>())
#define KWS() ((unsigned char*)(GAS1 unsigned char*)karg_u64<240>())
struct PP { unsigned char* ws; float* out; int tid, bid, G; };

typedef float f32x2_ __attribute__((ext_vector_type(2))); typedef __bf16 bf16x2_ __attribute__((ext_vector_type(2)));
__device__ __forceinline__ unsigned f2bf(float f) { const f32x2_ v = {f, 0.f}; const bf16x2_ b = __builtin_convertvector(v, bf16x2_); return __builtin_bit_cast(unsigned, b) & 0xffffu; }
__device__ __forceinline__ float bf2f(unsigned b) { return __builtin_bit_cast(float, b << 16); }
__device__ __forceinline__ unsigned pk2(float lo, float hi) { return pg8::cvt_pk_bf16(lo, hi); }
__device__ __forceinline__ float sigmoidf_(float x) { return __builtin_amdgcn_rcpf(1.0f + __expf(-x)); }
__device__ __forceinline__ float siluf_(float x) { return x * sigmoidf_(x); }

template <int CTRL> __device__ __forceinline__ float dpp_f(float v) { return __builtin_bit_cast(float, __builtin_amdgcn_update_dpp(0, __builtin_bit_cast(int, v), CTRL, 0xf, 0xf, false)); }
__device__ __forceinline__ float row16_sum(float v) { v += dpp_f<0xB1>(v); v += dpp_f<0x4E>(v); v += dpp_f<0x141>(v); v += dpp_f<0x140>(v); return v; }
__device__ __forceinline__ float max3f(float a, float b, float c) { float r; asm("v_max3_f32 %0, %1, %2, %3" : "=v"(r) : "v"(a), "v"(b), "v"(c)); return r; }
__device__ __forceinline__ float max2f(float a, float b) { float r; asm("v_max_f32_e32 %0, %1, %2" : "=v"(r) : "v"(a), "v"(b)); return r; }
__device__ __forceinline__ float xor16_get(float v) { return __builtin_bit_cast(float, __builtin_amdgcn_ds_swizzle(__builtin_bit_cast(int, v), 0x401F)); }
__device__ __forceinline__ float xor32_max(float v) { const unsigned u = __builtin_bit_cast(unsigned, v); auto r = __builtin_amdgcn_permlane32_swap(u, u, false, false); return max2f(__builtin_bit_cast(float, (unsigned)r[0]), __builtin_bit_cast(float, (unsigned)r[1])); }
__device__ __forceinline__ float xor32_sum(float v) { const unsigned u = __builtin_bit_cast(unsigned, v); auto r = __builtin_amdgcn_permlane32_swap(u, u, false, false); return __builtin_bit_cast(float, (unsigned)r[0]) + __builtin_bit_cast(float, (unsigned)r[1]); }
__device__ __forceinline__ float wave_sum(float v) {
    v = row16_sum(v); const int iv = __builtin_bit_cast(int, v);
    const float s0 = __builtin_bit_cast(float, __builtin_amdgcn_readlane(iv, 0)), s1 = __builtin_bit_cast(float, __builtin_amdgcn_readlane(iv, 16));
    const float s2 = __builtin_bit_cast(float, __builtin_amdgcn_readlane(iv, 32)), s3 = __builtin_bit_cast(float, __builtin_amdgcn_readlane(iv, 48));
    return (s0 + s1) + (s2 + s3);
}
#define LBAR() asm volatile("s_waitcnt lgkmcnt(0)\n\ts_barrier" ::: "memory")
__device__ __forceinline__ f32x4 mfma16(bf16x8 a, bf16x8 b, f32x4 c) { return __builtin_amdgcn_mfma_f32_16x16x32_bf16(a, b, c, 0, 0, 0); }

template <bool P> struct EpiT {
    static constexpr bool PERM = P, AFTER_DRAIN = false;
    int mode;
    bf16* O; size_t ldc;
    const float* xp; const float* xs; float* X;
    const float2* rope;
    __device__ __forceinline__ void operator()(const f32x4 (&acc)[2][2][4][2], const pg8::Unit& u, int wr, int wc, int fr, int fq) const {
        const int row0 = u.pm * 256 + wr * 64 + fr;
        if constexpr (P) {
            if (mode == 0) {
                const int col0 = u.pn * 256 + wc * 32 + 8 * fq;
#pragma unroll
                for (int ai = 0; ai < 2; ++ai)
#pragma unroll
                    for (int m = 0; m < 4; ++m) { bf16* rowp = O + (size_t)(row0 + ai * 128 + m * 16) * ldc + col0;
#pragma unroll
                        for (int bj = 0; bj < 2; ++bj) { const f32x4 v0 = acc[ai][bj][m][0], v1 = acc[ai][bj][m][1]; u32x4 w;
                            w.x = pk2(v0[0], v0[1]); w.y = pk2(v0[2], v0[3]); w.z = pk2(v1[0], v1[1]); w.w = pk2(v1[2], v1[3]);
                            *(u32x4*)(rowp + bj * 128) = w; } }
            } else {
                const int col0 = u.pn * 128 + wc * 32 + 8 * fq;
#pragma unroll
                for (int ai = 0; ai < 2; ++ai)
#pragma unroll
                    for (int m = 0; m < 4; ++m) { bf16* rowp = O + (size_t)(row0 + ai * 128 + m * 16) * ldc + col0;
                        float f[8];
#pragma unroll
                        for (int n = 0; n < 2; ++n)
#pragma unroll
                            for (int j = 0; j < 4; ++j) { const float g = acc[ai][0][m][n][j], up = acc[ai][1][m][n][j]; f[n * 4 + j] = siluf_(g) * up; }
                        u32x4 w; w.x = pk2(f[0], f[1]); w.y = pk2(f[2], f[3]); w.z = pk2(f[4], f[5]); w.w = pk2(f[6], f[7]);
                        *(u32x4*)rowp = w; }
            }
        } else {
            if (mode == 3) {
#pragma unroll
                for (int ai = 0; ai < 2; ++ai)
#pragma unroll
                    for (int m = 0; m < 4; ++m) { const int row = row0 + ai * 128 + m * 16;
                        const float* src = (row < MP) ? xp + (size_t)row * 1024 : xs + (size_t)(row - MP) * 1024;
                        float* dst = X + (size_t)row * 1024;
#pragma unroll
                        for (int bj = 0; bj < 2; ++bj)
#pragma unroll
                            for (int n = 0; n < 2; ++n) { const int col = u.pn * 256 + bj * 128 + wc * 32 + n * 16 + 4 * fq;
                                const f32x4 xi = *(const f32x4*)(src + col); f32x4 o = xi * DN_ALPHA + acc[ai][bj][m][n];
                                *(f32x4*)(dst + col) = o; }
                        __builtin_amdgcn_sched_barrier(0); }
            } else {
#pragma unroll
                for (int ai = 0; ai < 2; ++ai)
#pragma unroll
                    for (int m = 0; m < 4; ++m) { const int row = row0 + ai * 128 + m * 16;
                        const int pos = (row < MP) ? (row & 2047) : (2048 + ((row - MP) & 15));
                        bf16* rowp = O + (size_t)row * 768;
#pragma unroll
                        for (int bj = 0; bj < 2; ++bj) { const int g32 = u.pn * 256 + bj * 128 + wc * 32;
                            f32x4 a = acc[ai][bj][m][0], b = acc[ai][bj][m][1];
                            if ((g32 % 96) == 64) {
                                const float2* rp = rope + pos * 16 + 4 * fq;
#pragma unroll
                                for (int j = 0; j < 4; ++j) { const float2 cs = rp[j]; const float x1 = a[j], x2 = b[j]; a[j] = x1 * cs.x - x2 * cs.y; b[j] = x1 * cs.y + x2 * cs.x; }
                            }
                            a = a * QSCALE; b = b * QSCALE;
                            u32x2 w0, w1; w0.x = pk2(a[0], a[1]); w0.y = pk2(a[2], a[3]); w1.x = pk2(b[0], b[1]); w1.y = pk2(b[2], b[3]);
                            *(u32x2*)(rowp + g32 + 4 * fq) = w0; *(u32x2*)(rowp + g32 + 16 + 4 * fq) = w1; }
                        __builtin_amdgcn_sched_barrier(0); }
            }
        }
    }
};

__device__ __forceinline__ void prep_phase(const PP P, LAS unsigned char* lds, const int wl, const bool do_rest) {
    const int tid = P.tid, G = P.G;
    LAS float* tile = (LAS float*)lds;
    bf16* WB = (bf16*)(P.ws + WS_W);
    const int tx = tid & 63, ty = tid >> 6;
    for (int it = P.bid; it < 3080; it += G) {
        const int l = wl, r = it;
        const float* src; int ld, K, kt_n, tt; bf16* dst; int kind;
        if (r < 576)       { kind = 0; tt = r;        src = KIN(7) + (size_t)l * 1024 * 2216;  ld = 2216; K = 1024; kt_n = 16; dst = WB + l * W_LAYER + W_IN; }
        else if (r < 648)  { kind = 1; tt = r - 576;  src = KIN(9) + (size_t)l * 384 * 768;    ld = 768;  K = 384;  kt_n = 6;  dst = WB + l * W_LAYER + W_UQ; }
        else if (r < 680)  { kind = 1; tt = r - 648;  src = KIN(11) + (size_t)l * 256 * 512;   ld = 512;  K = 256;  kt_n = 4;  dst = WB + l * W_LAYER + W_UK; }
        else if (r < 712)  { kind = 1; tt = r - 680;  src = KIN(12) + (size_t)l * 256 * 512;   ld = 512;  K = 256;  kt_n = 4;  dst = WB + l * W_LAYER + W_UVT; }
        else if (r < 968)  { kind = 1; tt = r - 712;  src = KIN(21) + (size_t)l * 1024 * 1024; ld = 1024; K = 1024; kt_n = 16; dst = WB + l * W_LAYER + W_OUT; }
        else if (r < 2376) { kind = 2; tt = r - 968;  src = nullptr;                            ld = 2816; K = 1024; kt_n = 16; dst = WB + l * W_LAYER + W_GU; }
        else               { kind = 1; tt = r - 2376; src = KIN(26) + (size_t)l * 2816 * 1024; ld = 1024; K = 2816; kt_n = 44; dst = WB + l * W_LAYER + W_DN; }
        const int n0 = (tt / kt_n) * 64, k0 = (tt % kt_n) * 64;
        int col0 = n0; bool valid = true;
        if (kind == 0) valid = (n0 + tx) < 2216;
        if (kind == 2) { src = (((n0 >> 7) & 1) ? KIN(25) : KIN(24)) + (size_t)l * 1024 * 2816; col0 = (n0 >> 8) * 128 + (n0 & 127); }
#pragma unroll
        for (int kk = ty; kk < 64; kk += 8) tile[kk * 65 + tx] = valid ? src[(size_t)(k0 + kk) * ld + col0 + tx] : 0.f;
        __syncthreads();
#pragma unroll
        for (int nn = ty; nn < 64; nn += 8) dst[(size_t)(n0 + nn) * K + k0 + tx] = (bf16)f2bf(tile[tx * 65 + nn]);
        __syncthreads();
    }
    if (!do_rest) return;
    bf16* XB = (bf16*)(P.ws + WS_XB);
    for (int g = P.bid * 512 + tid; g < MT * 128; g += G * 512) {
        const int row = g >> 7, c8 = g & 127;
        const float* s = (row < MP) ? KIN(0) + (size_t)row * 1024 + c8 * 8 : KIN(1) + (size_t)(row - MP) * 1024 + c8 * 8;
        const f32x4 a = *(const f32x4*)s, b = *(const f32x4*)(s + 4);
        u32x4 w; w.x = pk2(a[0], a[1]); w.y = pk2(a[2], a[3]); w.z = pk2(b[0], b[1]); w.w = pk2(b[2], b[3]);
        *(u32x4*)(XB + (size_t)g * 8) = w;
    }
    float2* rope = (float2*)(P.ws + WS_ROPE);
    for (int idx = P.bid * 512 + tid; idx < 2064 * 16; idx += G * 512) {
        const int pos = idx >> 4, i = idx & 15;
        const float inv = __expf(-9.210340371976184f * (float)i / 16.0f);
        const float ang = (float)pos * inv;
        const float k = rintf(ang * 0.15915494309189535f);
        float rr = fmaf(-k, 6.2831854820251465f, ang); rr = fmaf(k, 1.7484555e-7f, rr);
        rope[idx] = make_float2(__cosf(rr), __sinf(rr));
    }
}

__device__ __forceinline__ void tok_phase(const PP P, int l) {
    const int tid = P.tid, lane = tid & 63, wave = tid >> 6, G = P.G;
    const bf16* H = (const bf16*)(P.ws + WS_H);
    bf16* CQN = (bf16*)(P.ws + WS_CQN); bf16* CKVB = (bf16*)(P.ws + WS_CKVB); bf16* KPEB = (bf16*)(P.ws + WS_KPEB);
    const float2* rope = (const float2*)(P.ws + WS_ROPE);
    const float* qn = KIN(8) + l * 384; const float* kvn = KIN(10) + l * 256;
    float* out = P.out;
    for (int row = P.bid * 8 + wave; row < MT; row += G * 8) {
        const bf16* hr = H + (size_t)row * HLD;
        const bool smp = row >= MP; int b, t, pos;
        if (!smp) { b = row >> 11; t = row & 2047; pos = t; } else { const int rr = row - MP; b = rr >> 4; t = rr & 15; pos = 2048 + t; }
        const size_t krow = smp ? (size_t)MP + 65536 + (size_t)b * 16 + t : (size_t)row;
        { float v[6]; float ss = 0.f;
#pragma unroll
          for (int i = 0; i < 3; ++i) { const unsigned w = *(const unsigned*)(hr + 128 * i + lane * 2); v[2 * i] = bf2f(w & 0xffffu); v[2 * i + 1] = bf2f(w >> 16); ss += v[2 * i] * v[2 * i] + v[2 * i + 1] * v[2 * i + 1]; }
          ss = wave_sum(ss); const float rinv = rsqrtf(ss * (1.0f / 384.0f) + 1e-6f);
#pragma unroll
          for (int i = 0; i < 3; ++i) { const int col = 128 * i + lane * 2; *(unsigned*)(CQN + (size_t)row * 384 + col) = pk2(v[2 * i] * rinv * qn[col], v[2 * i + 1] * rinv * qn[col + 1]); } }
        { const u32x2 w = *(const u32x2*)(hr + C_CKV + lane * 4);
          float v0 = bf2f(w.x & 0xffffu), v1 = bf2f(w.x >> 16), v2 = bf2f(w.y & 0xffffu), v3 = bf2f(w.y >> 16);
          float ss = wave_sum(v0 * v0 + v1 * v1 + v2 * v2 + v3 * v3); const float rinv = rsqrtf(ss * (1.0f / 256.0f) + 1e-6f);
          const f32x4 gn = *(const f32x4*)(kvn + lane * 4);
          f32x4 o; o[0] = v0 * rinv * gn[0]; o[1] = v1 * rinv * gn[1]; o[2] = v2 * rinv * gn[2]; o[3] = v3 * rinv * gn[3];
          float* op = smp ? out + O_CKVS + ((size_t)(l * 32 + b) * 16 + t) * 256 : out + O_CKVP + ((size_t)(l * 16 + b) * 2048 + t) * 256;
          *(f32x4*)(op + lane * 4) = o;
          u32x2 pw; pw.x = pk2(o[0], o[1]); pw.y = pk2(o[2], o[3]); *(u32x2*)(CKVB + krow * 256 + lane * 4) = pw; }
        if (lane < 16) { const float x1 = bf2f(hr[C_KPE + lane]), x2 = bf2f(hr[C_KPE + 16 + lane]); const float2 cs = rope[pos * 16 + lane];
          const float o1 = x1 * cs.x - x2 * cs.y, o2 = x1 * cs.y + x2 * cs.x;
          float* op = smp ? out + O_KPES + ((size_t)(l * 32 + b) * 16 + t) * 32 : out + O_KPEP + ((size_t)(l * 16 + b) * 2048 + t) * 32;
          op[lane] = o1; op[16 + lane] = o2; KPEB[krow * 32 + lane] = (bf16)f2bf(o1); KPEB[krow * 32 + 16 + lane] = (bf16)f2bf(o2); }
        { const int T = smp ? 16 : 2048;
          if (t >= T - 3) { const int j = t - (T - 3);
            float* op = smp ? out + O_GCS + ((size_t)(l * 32 + b) * 3 + j) * 768 : out + O_GCP + ((size_t)(l * 16 + b) * 3 + j) * 768;
#pragma unroll
            for (int i = 0; i < 12; ++i) op[lane + 64 * i] = bf2f(hr[C_QKV + lane + 64 * i]); } }
        if (smp || t >= 2018) {
            float* op = smp ? out + O_CVS + ((size_t)(l * 32 + b) * 30 + 14 + t) * 256 : out + O_CVP + ((size_t)(l * 16 + b) * 30 + (t - 2018)) * 256;
#pragma unroll
            for (int i = 0; i < 4; ++i) { const int ch = lane + 64 * i; op[ch] = bf2f(hr[C_GA + ch]) * sigmoidf_(bf2f(hr[C_GG + ch])); }
            if (smp && t == 0) {
                const float* sc = KIN(6) + ((size_t)(l * 32 + b) * 30 + 16) * 256; float* o2 = out + O_CVS + (size_t)(l * 32 + b) * 30 * 256;
                for (int e = lane; e < 14 * 256; e += 64) o2[e] = sc[e];
            }
        }
    }
}

__device__ __forceinline__ void cache_phase(const PP P, int l) {
    const int tid = P.tid, G = P.G;
    bf16* CKVB = (bf16*)(P.ws + WS_CKVB); bf16* KPEB = (bf16*)(P.ws + WS_KPEB);
    const float* cckv = KIN(2) + (size_t)l * 32 * 2048 * 256; const float* ckpe = KIN(3) + (size_t)l * 32 * 2048 * 32;
    for (int g = P.bid * 512 + tid; g < 65536 * 32; g += G * 512) {
        const int prow = g >> 5, c8 = g & 31, b = prow >> 11, s = prow & 2047;
        const float* sp = cckv + (size_t)prow * 256 + c8 * 8; const f32x4 a = *(const f32x4*)sp, c = *(const f32x4*)(sp + 4);
        u32x4 w; w.x = pk2(a[0], a[1]); w.y = pk2(a[2], a[3]); w.z = pk2(c[0], c[1]); w.w = pk2(c[2], c[3]);
        *(u32x4*)(CKVB + ((size_t)MP + (size_t)b * 2048 + s) * 256 + c8 * 8) = w;
    }
    for (int g = P.bid * 512 + tid; g < 65536 * 4; g += G * 512) {
        const int prow = g >> 2, c8 = g & 3, b = prow >> 11, s = prow & 2047;
        const float* sp = ckpe + (size_t)prow * 32 + c8 * 8; const f32x4 a = *(const f32x4*)sp, c = *(const f32x4*)(sp + 4);
        u32x4 w; w.x = pk2(a[0], a[1]); w.y = pk2(a[2], a[3]); w.z = pk2(c[0], c[1]); w.w = pk2(c[2], c[3]);
        *(u32x4*)(KPEB + ((size_t)MP + (size_t)b * 2048 + s) * 32 + c8 * 8) = w;
    }
}

__device__ __forceinline__ void conv_phase(const PP P, int l, LAS unsigned char* lds) {
    const int tid = P.tid, lane = tid & 63, wave = tid >> 6, G = P.G;
    const bf16* H = (const bf16*)(P.ws + WS_H); bf16* MIX = (bf16*)(P.ws + WS_MIX);
    LAS bf16* cs = (LAS bf16*)lds;
    LAS float* os = (LAS float*)(lds + 48128);
    const float* cw = KIN(17) + (size_t)l * 31 * 256; const float* cb = KIN(18) + l * 256;
    const float* lg = KIN(19) + l * 256; const float* lb = KIN(20) + l * 256; const float* sc = KIN(6);
    for (int u = P.bid; u < 544; u += G) {
        const bool smp = u < 32; int b, t0, ntok; size_t row0;
        if (!smp) { const int v = u - 32; b = v >> 5; t0 = (v & 31) * 64; ntok = 64; row0 = (size_t)b * 2048 + t0; } else { b = u; t0 = 0; ntok = 16; row0 = (size_t)MP + b * 16; }
        { const int ch2 = (tid & 127) * 2, rg = tid >> 7; const int nrow = 30 + ntok;
          const GAS1 bf16* hb = (const GAS1 bf16*)(H + ((long long)row0 - 30 + rg) * HLD + ch2);
          for (int k0 = 0; k0 < 24; k0 += 12) {
          unsigned ra[12], rgt[12];
#pragma unroll
          for (int k = 0; k < 12; ++k) { const int i = rg + 4 * (k0 + k), tt = t0 - 30 + i; ra[k] = 0u; rgt[k] = 0u;
              if (i < nrow && tt >= 0) { ra[k] = *(const GAS1 unsigned*)(hb + C_GA); rgt[k] = *(const GAS1 unsigned*)(hb + C_GG); }
              hb += 4 * HLD; asm volatile("" : "+v"(hb)); }
#pragma unroll
          for (int k = 0; k < 12; ++k) { const int i = rg + 4 * (k0 + k), tt = t0 - 30 + i;
              if (i < nrow) { float v0, v1;
                  if (tt >= 0 || !smp) { v0 = bf2f(ra[k] & 0xffffu) * sigmoidf_(bf2f(rgt[k] & 0xffffu)); v1 = bf2f(ra[k] >> 16) * sigmoidf_(bf2f(rgt[k] >> 16)); }
                  else { const float* sp = sc + ((size_t)(l * 32 + b) * 30 + (30 + tt)) * 256 + ch2; v0 = sp[0]; v1 = sp[1]; }
                  *(LAS unsigned*)(cs + i * 256 + ch2) = pk2(v0, v1); } } } }
        LBAR();
        { const int ch = tid & 255, gsel = tid >> 8; float w[31]; const GAS1 float* cwp = (const GAS1 float*)(cw + ch); asm volatile("" : "+v"(cwp));
#pragma unroll
          for (int j = 0; j < 31; ++j) w[j] = cwp[j * 256];
          const float bias = cb[ch];
          for (int g = gsel; g < (ntok >> 3); g += 2) { float win[38];
#pragma unroll
              for (int i = 0; i < 38; ++i) win[i] = bf2f(cs[(8 * g + i) * 256 + ch]);
#pragma unroll
              for (int t = 0; t < 8; ++t) { float acc = bias;
#pragma unroll
                  for (int j = 0; j < 31; ++j) acc += w[j] * win[t + j];
                  os[(8 * g + t) * 256 + ch] = acc; } } }
        LBAR();
        for (int t = wave; t < ntok; t += 8) {
            float v[4]; float sm = 0.f;
#pragma unroll
            for (int i = 0; i < 4; ++i) { v[i] = os[t * 256 + lane + 64 * i]; sm += v[i]; }
            const float mu = wave_sum(sm) * (1.0f / 256.0f); float q = 0.f;
#pragma unroll
            for (int i = 0; i < 4; ++i) { const float d = v[i] - mu; q += d * d; }
            const float rstd = rsqrtf(wave_sum(q) * (1.0f / 256.0f) + 1e-5f);
#pragma unroll
            for (int i = 0; i < 4; ++i) { const int ch = lane + 64 * i; const float y = (v[i] - mu) * rstd * lg[ch] + lb[ch]; MIX[(row0 + t) * 1024 + 768 + ch] = (bf16)f2bf(siluf_(y)); }
        }
        LBAR();
    }
}

__device__ __forceinline__ void g1_phase(const PP P, int l, LAS unsigned char* lds) {
    const int tid = P.tid, grp = tid >> 8, gt = tid & 255, G = P.G;
    const bf16* H = (const bf16*)(P.ws + WS_H);
    LAS float* qs = (LAS float*)(lds + grp * G1_GRP); LAS float* ks = qs + 64 * 65; LAS float* vs = ks + 64 * 65; LAS float* As = vs + 64 * 65;
    LAS float* Gs = As + 64 * 64; LAS float* bs = Gs + 64; LAS float* gs = bs + 64;
    const float* gcw = KIN(13) + (size_t)l * 4 * 768;
    const int rounds = (NGU + 2 * G - 1) / (2 * G);
    for (int it = 0; it < rounds; ++it) {
        const int u = (it * G + P.bid) * 2 + grp; const bool act = u < NGU;
        int b, h, ch, L; bool smp; size_t seq0;
        if (u < 2048) { const int bh = u >> 5; ch = u & 31; b = bh >> 2; h = bh & 3; L = 64; smp = false; seq0 = (size_t)b * 2048; }
        else { const int bh = u - 2048; b = bh >> 2; h = bh & 3; L = 16; smp = true; ch = 0; seq0 = (size_t)MP + b * 16; }
        unsigned char* ub = P.ws + WS_GSCR + (size_t)(act ? u : 0) * GUNIT;
        bf16* Wd = (bf16*)ub; bf16* QKd = (bf16*)(ub + 8192); bf16* KdT = (bf16*)(ub + 16384); bf16* QG = (bf16*)(ub + 24576); float* Uv = (float*)(ub + 32768);
#ifdef PROBE_SOLVE
        for (int pass_ = 0; pass_ < 2; ++pass_) {
#endif
        if (act) {
            if (gt < 192) { const int part = gt >> 6, cc = gt & 63, qcol = part * 256 + h * 64 + cc;
                const float w0 = gcw[qcol], w1 = gcw[768 + qcol], w2 = gcw[2 * 768 + qcol], w3 = gcw[3 * 768 + qcol];
                LAS float* dst = (part == 0 ? qs : (part == 1 ? ks : vs)) + cc;
                const bf16* hp = H + (seq0 + (size_t)ch * 64) * HLD + C_QKV + qcol;
                float x0 = 0.f, x1 = 0.f, x2 = 0.f;
                if (ch > 0) { x0 = bf2f(*(hp - 3 * HLD)); x1 = bf2f(*(hp - 2 * HLD)); x2 = bf2f(*(hp - HLD)); }
                else if (smp) { const float* sp = KIN(5) + (size_t)(l * 32 + b) * 3 * 768 + qcol; x0 = sp[0]; x1 = sp[768]; x2 = sp[2 * 768]; }
                const GAS1 bf16* pr = (const GAS1 bf16*)hp;
                if (L == 64) {
                  for (int tb = 0; tb < 64; tb += 32) { float xv[32];
#pragma unroll
                    for (int i = 0; i < 32; ++i) { xv[i] = bf2f(*pr); pr += HLD; asm volatile("" : "+v"(pr)); }
#pragma unroll
                    for (int i = 0; i < 32; ++i) { const float y = w0 * x0 + w1 * x1 + w2 * x2 + w3 * xv[i]; dst[(tb + i) * 65] = siluf_(y); x0 = x1; x1 = x2; x2 = xv[i]; } }
                } else { float xv[16];
#pragma unroll
                    for (int i = 0; i < 16; ++i) { xv[i] = bf2f(*pr); pr += HLD; asm volatile("" : "+v"(pr)); }
#pragma unroll
                    for (int i = 0; i < 16; ++i) { const float y = w0 * x0 + w1 * x1 + w2 * x2 + w3 * xv[i]; dst[i * 65] = siluf_(y); x0 = x1; x1 = x2; x2 = xv[i]; } }
                for (int t = L; t < 64; ++t) dst[t * 65] = 0.f;
            }
        }
        LBAR();
        if (act) {
            { const int rowid = gt >> 1, t = rowid & 63, part = rowid >> 6, half = gt & 1; LAS float* base = (part == 0 ? qs : ks) + t * 65 + half * 32; float ss = 0.f;
#pragma unroll
              for (int i = 0; i < 32; ++i) ss += base[i] * base[i];
              ss += dpp_f<0xB1>(ss); const float rinv = rsqrtf(ss + 1e-6f) * (part == 0 ? 0.125f : 1.0f);
#pragma unroll
              for (int i = 0; i < 32; ++i) base[i] *= rinv; }
            if (gt < 64) { const int t = gt; float beta = 0.f, g = 0.f;
                if (t < L) { const bf16* hr = H + (seq0 + (size_t)ch * 64 + t) * HLD; const float braw = bf2f(hr[C_B + h]), araw = bf2f(hr[C_A + h]);
                    beta = sigmoidf_(braw); const float x = araw + KIN(15)[l * 4 + h]; const float sp = x > 20.f ? x : __logf(1.0f + __expf(x)); g = -__expf(KIN(14)[l * 4 + h]) * sp; }
                bs[t] = beta; gs[t] = g; }
        }
        LBAR();
#ifdef PROBE_SOLVE
        if (pass_ == 0) {
#endif
        if (act && gt == 0) { float gg[64];
#pragma unroll
            for (int t = 0; t < 64; ++t) gg[t] = gs[t];
            float run = 0.f;
#pragma unroll
            for (int t = 0; t < 64; ++t) { run += gg[t]; Gs[t] = run; } }
        LBAR();
        if (act) {
            { const int mi = gt >> 6, ln = gt & 63, fr = ln & 15, fq = ln >> 4;
              bf16x8 ak[2], aq[2];
#pragma unroll
              for (int kk = 0; kk < 2; ++kk) { const LAS float* pk = ks + (16 * mi + fr) * 65 + 32 * kk + fq * 8; const LAS float* pq = qs + (16 * mi + fr) * 65 + 32 * kk + fq * 8;
                  u32x4 wk, wq; wk.x = pk2(pk[0], pk[1]); wk.y = pk2(pk[2], pk[3]); wk.z = pk2(pk[4], pk[5]); wk.w = pk2(pk[6], pk[7]);
                  wq.x = pk2(pq[0], pq[1]); wq.y = pk2(pq[2], pq[3]); wq.z = pk2(pq[4], pq[5]); wq.w = pk2(pq[6], pq[7]);
                  ak[kk] = __builtin_bit_cast(bf16x8, wk); aq[kk] = __builtin_bit_cast(bf16x8, wq); }
#pragma unroll
              for (int nj = 0; nj < 4; ++nj) { f32x4 ckk = {0.f, 0.f, 0.f, 0.f}, cqk = {0.f, 0.f, 0.f, 0.f};
                  if (nj <= mi && 16 * mi < L) {
#pragma unroll
                      for (int kk = 0; kk < 2; ++kk) { const LAS float* pb = ks + (16 * nj + fr) * 65 + 32 * kk + fq * 8;
                          u32x4 wb; wb.x = pk2(pb[0], pb[1]); wb.y = pk2(pb[2], pb[3]); wb.z = pk2(pb[4], pb[5]); wb.w = pk2(pb[6], pb[7]);
                          const bf16x8 bfr = __builtin_bit_cast(bf16x8, wb); ckk = mfma16(ak[kk], bfr, ckk); cqk = mfma16(aq[kk], bfr, cqk); } }
                  const int jc = 16 * nj + fr; const float gj = Gs[jc];
#pragma unroll
                  for (int j = 0; j < 4; ++j) { const int i = 16 * mi + fq * 4 + j; const float dec = (i >= jc) ? __expf(Gs[i] - gj) : 0.f;
                      As[i * 64 + jc] = (i > jc) ? bs[i] * ckk[j] * dec : 0.f; QKd[i * 64 + jc] = (bf16)f2bf(cqk[j] * dec); } } }
        }
        LBAR();
        if (act) {
            const float glast = Gs[63];
            for (int e = gt; e < 4096; e += 256) { const int hi = e >> 6, lo = e & 63;
                KdT[e] = (bf16)f2bf(ks[lo * 65 + hi] * __expf(glast - Gs[lo]));
                QG[e] = (bf16)f2bf(qs[hi * 65 + lo] * __expf(Gs[hi])); }
            if (gt == 0) *(float*)(ub + 49152) = __expf(glast);
        }
        LBAR();
#ifdef PROBE_SOLVE
        }
#endif
        if (act) {
            for (int e = gt; e < 8192; e += 256) { const int i = e >> 7, c = e & 127; LAS float* p = ((c < 64) ? ks : vs) + i * 65 + (c & 63);
                *p = *p * bs[i] * ((c < 64) ? __expf(Gs[i]) : 1.0f); }
        }
        LBAR();
#pragma unroll 1
        for (int R = 0; R < 4; ++R) {
            if (act && R > 0 && 16 * R < L) {
                const int wv = gt >> 6, ln = gt & 63, fr = ln & 15, fq = ln >> 4, nkk = (16 * R + 31) >> 5;
                bf16x8 af[2];
#pragma unroll
                for (int kk = 0; kk < 2; ++kk) { u32x4 w = {0u, 0u, 0u, 0u};
                    if (kk < nkk && 32 * kk + fq * 8 < 16 * R) { const LAS float* pa = As + (16 * R + fr) * 64 + 32 * kk + fq * 8; const f32x4 a0 = *(const LAS f32x4*)pa, a1 = *(const LAS f32x4*)(pa + 4);
                        w.x = pk2(a0[0], a0[1]); w.y = pk2(a0[2], a0[3]); w.z = pk2(a1[0], a1[1]); w.w = pk2(a1[2], a1[3]); }
                    af[kk] = __builtin_bit_cast(bf16x8, w); }
#pragma unroll
                for (int t = 0; t < 2; ++t) { const int nt = 2 * wv + t; LAS float* xb = ((nt < 4) ? ks : vs) + 16 * (nt & 3) + fr;
                    f32x4 acc = {0.f, 0.f, 0.f, 0.f};
#pragma unroll
                    for (int kk = 0; kk < 2; ++kk) if (kk < nkk) { const LAS float* pb = xb + (32 * kk + fq * 8) * 65;
                        u32x4 w; w.x = pk2(pb[0], pb[65]); w.y = pk2(pb[130], pb[195]); w.z = pk2(pb[260], pb[325]); w.w = pk2(pb[390], pb[455]);
                        acc = mfma16(af[kk], __builtin_bit_cast(bf16x8, w), acc); }
#pragma unroll
                    for (int j = 0; j < 4; ++j) xb[(16 * R + fq * 4 + j) * 65] -= acc[j]; }
            }
            LBAR();
            if (act && gt < 128) { const int c = gt; LAS float* col = ((c < 64) ? ks : vs) + (c & 63) + (16 * R) * 65; const LAS float* Dg = As + (16 * R) * 64 + 16 * R;
                float x[16];
                if (16 * R >= L) {
#pragma unroll
                    for (int a = 0; a < 16; ++a) x[a] = 0.f;
                } else {
#pragma unroll
                for (int a = 0; a < 16; ++a) { float v = col[a * 65];
                    f32x4 d[4];
#pragma unroll
                    for (int q4 = 0; q4 < 4; ++q4) if (4 * q4 < a) d[q4] = *(const LAS f32x4*)(Dg + a * 64 + 4 * q4);
#pragma unroll
                    for (int q = 0; q < a; ++q) v -= d[q >> 2][q & 3] * x[q];
                    x[a] = v; if ((a & 3) == 3) __builtin_amdgcn_sched_barrier(0); } }
#pragma unroll
                for (int a = 0; a < 16; ++a) { col[a * 65] = x[a];
                    if (c < 64) Wd[(16 * R + a) * 64 + c] = (bf16)f2bf(x[a]); else Uv[(16 * R + a) * 64 + (c - 64)] = x[a]; }
            }
            LBAR();
        }
#ifdef PROBE_SOLVE
        }
#endif
    }
}

__device__ __forceinline__ bf16x8 ldA2(const bf16* Mx, int row, int kk, int fq) {
    const bf16* p = Mx + row * 64 + 32 * kk + fq * 4; const s16x4 a = *(const s16x4*)p, b = *(const s16x4*)(p + 16);
    bf16x8 r; r[0] = a[0]; r[1] = a[1]; r[2] = a[2]; r[3] = a[3]; r[4] = b[0]; r[5] = b[1]; r[6] = b[2]; r[7] = b[3]; return r;
}
__device__ __forceinline__ void split8(const f32x4& lo4, const f32x4& hi4, bf16x8& h, bf16x8& lw) {
    u32x4 hw; hw.x = pk2(lo4[0], lo4[1]); hw.y = pk2(lo4[2], lo4[3]); hw.z = pk2(hi4[0], hi4[1]); hw.w = pk2(hi4[2], hi4[3]);
    h = __builtin_bit_cast(bf16x8, hw);
    if (GDN_SPLIT) {
        u32x4 lo; lo.x = pk2(lo4[0] - bf2f(hw.x & 0xffffu), lo4[1] - __builtin_bit_cast(float, hw.x & 0xffff0000u)); lo.y = pk2(lo4[2] - bf2f(hw.y & 0xffffu), lo4[3] - __builtin_bit_cast(float, hw.y & 0xffff0000u));
        lo.z = pk2(hi4[0] - bf2f(hw.z & 0xffffu), hi4[1] - __builtin_bit_cast(float, hw.z & 0xffff0000u)); lo.w = pk2(hi4[2] - bf2f(hw.w & 0xffffu), hi4[3] - __builtin_bit_cast(float, hw.w & 0xffff0000u));
        lw = __builtin_bit_cast(bf16x8, lo);
    } else lw = h;
}
constexpr int G2_MAT = 9216, G2_UV = 4 * G2_MAT, G2_Z = G2_UV + 64 * 272, G2_GAM = G2_Z + 9216, G2_BUF = G2_GAM + 16, G2_RED = 2 * G2_BUF;
static_assert(G2_RED + 2048 <= LDS_BYTES, "g2 lds");
__device__ __forceinline__ bf16x8 ldA2s(const LAS unsigned char* mat, int row, int kk, int fq) {
    const LAS unsigned char* p = mat + row * 144 + 64 * kk + fq * 8; const s16x4 a = *(const LAS s16x4*)p, b = *(const LAS s16x4*)(p + 32);
    bf16x8 r; r[0] = a[0]; r[1] = a[1]; r[2] = a[2]; r[3] = a[3]; r[4] = b[0]; r[5] = b[1]; r[6] = b[2]; r[7] = b[3]; return r;
}
__device__ __forceinline__ void g2_stage(LAS unsigned char* buf, const unsigned char* ub, const bf16* zsrc  , int ht, int nthr) {
    for (int c = ht; c < 2048; c += nthr) { const int mat = c >> 9, w = c & 511, row = w >> 3, seg = w & 7;
        *(LAS u32x4*)(buf + mat * G2_MAT + row * 144 + seg * 16) = *(const u32x4*)(ub + mat * 8192 + row * 128 + seg * 16); }
    for (int c = ht; c < 1024; c += nthr) { const int row = c >> 4, seg = c & 15;
        *(LAS u32x4*)(buf + G2_UV + row * 272 + seg * 16) = *(const u32x4*)(ub + 32768 + row * 256 + seg * 16); }
    for (int c = ht; c < 512; c += nthr) { const int row = c >> 3, seg = c & 7;
        *(LAS u32x4*)(buf + G2_Z + row * 144 + seg * 16) = *(const u32x4*)((const unsigned char*)(zsrc + (size_t)row * HLD) + seg * 16); }
    if (ht == 0) *(LAS float*)(buf + G2_GAM) = *(const float*)(ub + 49152);
}
__device__ __forceinline__ void g2_load(u32x4 (&r)[14], float& gam, const unsigned char* ub, const bf16* zsrc, int ht) {
    const unsigned go = 16u * ht, gz = (ht >> 3) * (HLD * 2) + (ht & 7) * 16;
#pragma unroll
    for (int i = 0; i < 8; ++i) r[i] = *(const u32x4*)(ub + i * 4096 + go);
#pragma unroll
    for (int i = 0; i < 4; ++i) r[8 + i] = *(const u32x4*)(ub + 32768 + i * 4096 + go);
#pragma unroll
    for (int i = 0; i < 2; ++i) r[12 + i] = *(const u32x4*)((const unsigned char*)zsrc + (size_t)i * 32 * HLD * 2 + gz);
    gam = *(const float*)(ub + 49152);
}
__device__ __forceinline__ void g2_store(LAS unsigned char* buf, const u32x4 (&r)[14], float gam, int ht) {
    LAS unsigned char* lm = buf + (ht >> 3) * 144 + (ht & 7) * 16; LAS unsigned char* lu = buf + G2_UV + (ht >> 4) * 272 + (ht & 15) * 16;
#pragma unroll
    for (int i = 0; i < 8; ++i) *(LAS u32x4*)(lm + (i >> 1) * G2_MAT + (i & 1) * 32 * 144) = r[i];
#pragma unroll
    for (int i = 0; i < 4; ++i) *(LAS u32x4*)(lu + i * 16 * 272) = r[8 + i];
#pragma unroll
    for (int i = 0; i < 2; ++i) *(LAS u32x4*)(lm + G2_Z + i * 32 * 144) = r[12 + i];
    if (ht == 0) *(LAS float*)(buf + G2_GAM) = gam;
}
#define G2_BAR() asm volatile("s_waitcnt lgkmcnt(0)\n\ts_barrier" ::: "memory")
__device__ __forceinline__ void g2_phase(const PP P, int l, LAS unsigned char* lds) {
    const int tid = P.tid, lane = tid & 63, wave = tid >> 6, fr = lane & 15, fq = lane >> 4, G = P.G;
    LAS float* red = (LAS float*)(lds + G2_RED);
    const bf16* H = (const bf16*)(P.ws + WS_H); bf16* MIX = (bf16*)(P.ws + WS_MIX);
    for (int u = P.bid; u < 192; u += G) {
        const bool smp = u >= 64; const int bh = smp ? u - 64 : u, b = bh >> 2, h = bh & 3, nch = smp ? 1 : 32, L = smp ? 16 : 64;
        const size_t seq0 = smp ? (size_t)MP + b * 16 : (size_t)b * 2048; const int gu0 = smp ? 2048 + bh : bh * 32;
        const bool act = wave < 4; const int dv = 16 * (wave & 3) + fr;
        const unsigned char* gs0 = P.ws + WS_GSCR + (size_t)gu0 * GUNIT; const bf16* z0 = H + seq0 * HLD + C_Z + h * 64;
        f32x4 S[4];
#pragma unroll
        for (int m = 0; m < 4; ++m)
#pragma unroll
            for (int j = 0; j < 4; ++j) S[m][j] = (smp && act) ? KIN(4)[(((size_t)(l * 32 + b) * 4 + h) * 64 + (16 * m + fq * 4 + j)) * 64 + dv] : 0.f;
        const float gnw = KIN(16)[l * 64 + dv];
        g2_stage(lds, gs0, z0, tid, 512);
        u32x4 hr_[14]; float hgam = 0.f;
#pragma unroll
        for (int i = 0; i < 14; ++i) hr_[i] = (u32x4){0u, 0u, 0u, 0u};
        if (!act && nch > 1) g2_load(hr_, hgam, gs0 + GUNIT, z0 + (size_t)64 * HLD, tid - 256);
        G2_BAR();
        for (int n = 0; n < nch; ++n) {
            LAS unsigned char* buf = lds + (n & 1) * G2_BUF;
            f32x4 O[4]; float zr[4][4];
            if (!act) {
                if (n + 1 < nch) g2_store(lds + ((n + 1) & 1) * G2_BUF, hr_, hgam, tid - 256);
                if (n + 2 < nch) g2_load(hr_, hgam, gs0 + (size_t)(n + 2) * GUNIT, z0 + (size_t)(n + 2) * 64 * HLD, tid - 256);
            } else {
                bf16x8 Sh[2], Sl[2]; split8(S[0], S[1], Sh[0], Sl[0]); split8(S[2], S[3], Sh[1], Sl[1]);
                f32x4 U[4];
#pragma unroll
                for (int mi = 0; mi < 4; ++mi) { f32x4 acc = {0.f, 0.f, 0.f, 0.f};
#pragma unroll
                    for (int kk = 0; kk < 2; ++kk) { const bf16x8 a = ldA2s(buf, 16 * mi + fr, kk, fq); acc = mfma16(a, Sh[kk], acc); if (GDN_SPLIT) acc = mfma16(a, Sl[kk], acc); }
#pragma unroll
                    for (int j = 0; j < 4; ++j) { const int i = 16 * mi + fq * 4 + j; U[mi][j] = *(const LAS float*)(buf + G2_UV + i * 272 + dv * 4) - acc[j];
                        zr[mi][j] = bf2f(*(const LAS bf16*)(buf + G2_Z + i * 144 + dv * 2)); } }
                bf16x8 Uh[2], Ul[2]; split8(U[0], U[1], Uh[0], Ul[0]); split8(U[2], U[3], Uh[1], Ul[1]);
#pragma unroll
                for (int mi = 0; mi < 4; ++mi) { f32x4 acc = {0.f, 0.f, 0.f, 0.f};
#pragma unroll
                    for (int kk = 0; kk < 2; ++kk) { const bf16x8 a = ldA2s(buf + 3 * G2_MAT, 16 * mi + fr, kk, fq); acc = mfma16(a, Sh[kk], acc); if (GDN_SPLIT) acc = mfma16(a, Sl[kk], acc);
                        const bf16x8 a2 = ldA2s(buf + G2_MAT, 16 * mi + fr, kk, fq); acc = mfma16(a2, Uh[kk], acc); if (GDN_SPLIT) acc = mfma16(a2, Ul[kk], acc); }
                    O[mi] = acc; }
                const float gamL = *(const LAS float*)(buf + G2_GAM);
#pragma unroll
                for (int m = 0; m < 4; ++m) { f32x4 acc = S[m] * gamL;
#pragma unroll
                    for (int kk = 0; kk < 2; ++kk) { const bf16x8 a = ldA2s(buf + 2 * G2_MAT, 16 * m + fr, kk, fq); acc = mfma16(a, Uh[kk], acc); if (GDN_SPLIT) acc = mfma16(a, Ul[kk], acc); }
                    S[m] = acc; }
#pragma unroll
                for (int mi = 0; mi < 4; ++mi)
#pragma unroll
                    for (int j = 0; j < 4; ++j) { const float s = row16_sum(O[mi][j] * O[mi][j]);
                        if (fr == 0) red[(n & 1) * 256 + wave * 64 + 16 * mi + fq * 4 + j] = s; }
            }
            G2_BAR();
            if (act) {
#pragma unroll
                for (int mi = 0; mi < 4; ++mi)
#pragma unroll
                    for (int j = 0; j < 4; ++j) { const int i = 16 * mi + fq * 4 + j; LAS float* rp = red + (n & 1) * 256 + i;
                        const float tot = rp[0] + rp[64] + rp[128] + rp[192]; const float rinv = rsqrtf(tot * (1.0f / 64.0f) + 1e-6f);
                        if (i < L) { const size_t row = seq0 + (size_t)n * 64 + i;
                            MIX[row * 1024 + 512 + h * 64 + dv] = (bf16)f2bf(O[mi][j] * rinv * gnw * siluf_(zr[mi][j])); } }
            }
        }
        if (act) { float* so = smp ? P.out + O_GDNS + ((size_t)(l * 32 + b) * 4 + h) * 4096 : P.out + O_GDNP + ((size_t)(l * 16 + b) * 4 + h) * 4096;
#pragma unroll
            for (int m = 0; m < 4; ++m)
#pragma unroll
                for (int j = 0; j < 4; ++j) so[(16 * m + fq * 4 + j) * 64 + dv] = S[m][j]; }
        __syncthreads();
    }
}

constexpr int AT_KROW = 208, AT_VROW = 144, AT_V = 64 * AT_KROW, AT_STAGE = AT_V + 64 * AT_VROW, AT_COMB = 2 * AT_STAGE;
static_assert(AT_COMB + 8 * 64 * 18 * 4 <= LDS_BYTES, "attn lds");
__device__ __forceinline__ void attn_prompt_unit(const PP P, LAS unsigned char* lds, int b, int h, int qt) {
    const int tid = P.tid, lane = tid & 63, wave = tid >> 6, fr = lane & 15, fq = lane >> 4;
    const bf16* Q = (const bf16*)(P.ws + WS_XB); const bf16* KN = (const bf16*)(P.ws + WS_KN); const bf16* VT = (const bf16*)(P.ws + WS_VT);
    const bf16* KPEB = (const bf16*)(P.ws + WS_KPEB); bf16* MIX = (bf16*)(P.ws + WS_MIX);
    const int qrow0 = b * 2048 + 256 * qt + 32 * wave, keybase = b * 2048;
    const int nt_blk = 4 * qt + 4, nt_w = 4 * qt + (wave >> 1) + 1;
    bf16x8 Qb[2][3];
#pragma unroll
    for (int g = 0; g < 2; ++g)
#pragma unroll
        for (int ks = 0; ks < 3; ++ks) Qb[g][ks] = *(const bf16x8*)(Q + (size_t)(qrow0 + 16 * g + fr) * 768 + h * 96 + 32 * ks + fq * 8);
    float m[2] = {-INFINITY, -INFINITY}, lsum[2] = {0.f, 0.f}; f32x4 O[2][4];
#pragma unroll
    for (int g = 0; g < 2; ++g)
#pragma unroll
        for (int nt = 0; nt < 4; ++nt) O[g][nt] = (f32x4){0.f, 0.f, 0.f, 0.f};
    const int r8 = tid >> 3, s8 = tid & 7, r4 = (tid & 255) >> 2, s4 = tid & 3;
    const bf16* gk = KN + (size_t)(keybase + r8) * 512 + h * 64 + s8 * 8;
    const bf16* gp = KPEB + (size_t)(keybase + r4) * 32 + s4 * 8;
    const bf16* gv = VT + (size_t)(h * 64 + r8) * NK + keybase + s8 * 8;
    const int lk = r8 * AT_KROW + s8 * 16, lp = r4 * AT_KROW + 128 + s4 * 16, lv = AT_V + r8 * AT_VROW + s8 * 16;
    u32x4 rk = *(const u32x4*)gk, rv = *(const u32x4*)gv, rp = {0u, 0u, 0u, 0u}; if (tid < 256) rp = *(const u32x4*)gp;
    *(LAS u32x4*)(lds + lk) = rk; *(LAS u32x4*)(lds + lv) = rv; if (tid < 256) *(LAS u32x4*)(lds + lp) = rp;
    __syncthreads();
    for (int kt = 0; kt < nt_blk; ++kt) {
        const bool more = kt + 1 < nt_blk;
        if (more) { rk = *(const u32x4*)(gk + (size_t)(kt + 1) * 64 * 512); rv = *(const u32x4*)(gv + (kt + 1) * 64); if (tid < 256) rp = *(const u32x4*)(gp + (size_t)(kt + 1) * 64 * 32); }
        if (kt < nt_w) {
            const LAS unsigned char* kb = lds + (kt & 1) * AT_STAGE; const LAS unsigned char* vb = kb + AT_V;
            f32x4 s[2][4];
#pragma unroll
            for (int sb = 0; sb < 4; ++sb) { s[0][sb] = (f32x4){0.f, 0.f, 0.f, 0.f}; s[1][sb] = (f32x4){0.f, 0.f, 0.f, 0.f};
#pragma unroll
                for (int ks = 0; ks < 3; ++ks) { const bf16x8 kf = *(const LAS bf16x8*)(kb + (16 * sb + fr) * AT_KROW + ks * 64 + fq * 16);
                    s[0][sb] = mfma16(kf, Qb[0][ks], s[0][sb]); s[1][sb] = mfma16(kf, Qb[1][ks], s[1][sb]); } }
            bf16x8 Pb[2][2];
#pragma unroll
            for (int g = 0; g < 2; ++g) {
                float mx = -INFINITY;
#pragma unroll
                for (int sb = 0; sb < 4; ++sb) { mx = max3f(mx, s[g][sb][0], s[g][sb][1]); mx = max3f(mx, s[g][sb][2], s[g][sb][3]); }
                mx = max2f(mx, xor16_get(mx)); mx = xor32_max(mx);
                const float mnew = max2f(m[g], mx), alpha = __builtin_amdgcn_exp2f(m[g] - mnew); m[g] = mnew;
                float ps = 0.f; float p[4][4];
#pragma unroll
                for (int sb = 0; sb < 4; ++sb)
#pragma unroll
                    for (int j = 0; j < 4; ++j) { p[sb][j] = __builtin_amdgcn_exp2f(s[g][sb][j] - mnew); ps += p[sb][j]; }
                lsum[g] = lsum[g] * alpha + ps;
#pragma unroll
                for (int kk = 0; kk < 2; ++kk) { u32x4 pw; pw.x = pk2(p[2 * kk][0], p[2 * kk][1]); pw.y = pk2(p[2 * kk][2], p[2 * kk][3]); pw.z = pk2(p[2 * kk + 1][0], p[2 * kk + 1][1]); pw.w = pk2(p[2 * kk + 1][2], p[2 * kk + 1][3]);
                    Pb[g][kk] = __builtin_bit_cast(bf16x8, pw); }
#pragma unroll
                for (int nt = 0; nt < 4; ++nt) O[g][nt] = O[g][nt] * alpha;
            }
#pragma unroll
            for (int nt = 0; nt < 4; ++nt)
#pragma unroll
                for (int kk = 0; kk < 2; ++kk) { const LAS unsigned char* vp = vb + (16 * nt + fr) * AT_VROW + kk * 64 + fq * 8;
                    const s16x4 a = *(const LAS s16x4*)vp, c = *(const LAS s16x4*)(vp + 32);
                    bf16x8 vf; vf[0] = a[0]; vf[1] = a[1]; vf[2] = a[2]; vf[3] = a[3]; vf[4] = c[0]; vf[5] = c[1]; vf[6] = c[2]; vf[7] = c[3];
                    O[0][nt] = mfma16(vf, Pb[0][kk], O[0][nt]); O[1][nt] = mfma16(vf, Pb[1][kk], O[1][nt]); }
        }
        if (more) { LAS unsigned char* nb = lds + ((kt + 1) & 1) * AT_STAGE; *(LAS u32x4*)(nb + lk) = rk; *(LAS u32x4*)(nb + lv) = rv; if (tid < 256) *(LAS u32x4*)(nb + lp) = rp; }
        __syncthreads();
    }
#pragma unroll
    for (int g = 0; g < 2; ++g) { float lt = lsum[g]; lt += xor16_get(lt); lt = xor32_sum(lt); const float inv = 1.0f / lt;
#pragma unroll
        for (int nt = 0; nt < 4; ++nt) { u32x2 w; w.x = pk2(O[g][nt][0] * inv, O[g][nt][1] * inv); w.y = pk2(O[g][nt][2] * inv, O[g][nt][3] * inv);
            *(u32x2*)(MIX + (size_t)(qrow0 + 16 * g + fr) * 1024 + h * 64 + 16 * nt + fq * 4) = w; } }
}
__device__ __forceinline__ void attn_sample_unit(const PP P, LAS unsigned char* lds, int b, int h) {
    const int tid = P.tid, lane = tid & 63, wave = tid >> 6, fr = lane & 15, fq = lane >> 4;
    const bf16* Q = (const bf16*)(P.ws + WS_XB); const bf16* KN = (const bf16*)(P.ws + WS_KN); const bf16* VT = (const bf16*)(P.ws + WS_VT);
    const bf16* KPEB = (const bf16*)(P.ws + WS_KPEB); bf16* MIX = (bf16*)(P.ws + WS_MIX);
    const int qrow0 = MP + b * 16, keybase = MP, nkeys = SKS;
    const bf16* qp = Q + (size_t)(qrow0 + fr) * 768 + h * 96 + fq * 8;
    bf16x8 Qb[3];
#pragma unroll
    for (int ks = 0; ks < 3; ++ks) Qb[ks] = *(const bf16x8*)(qp + 32 * ks);
    float m = -INFINITY, lsum = 0.f; f32x4 O[4];
#pragma unroll
    for (int nt = 0; nt < 4; ++nt) O[nt] = (f32x4){0.f, 0.f, 0.f, 0.f};
    const int nblk = (nkeys + 31) >> 5, kb0 = (wave * nblk) >> 3, kb1 = ((wave + 1) * nblk) >> 3;
    for (int kb = kb0; kb < kb1; ++kb) {
        f32x4 s[2]; int kof[2];
#pragma unroll
        for (int sub = 0; sub < 2; ++sub) { const int key0 = kb * 32 + sub * 16; const bool valid = key0 < nkeys; kof[sub] = (valid && key0 >= 2048) ? 65536 + b * 16 + (key0 - 2048) : b * 2048 + (valid ? key0 : 0);
            const size_t kr = (size_t)keybase + kof[sub] + fr;
            const bf16x8 a0 = *(const bf16x8*)(KN + kr * 512 + h * 64 + fq * 8), a1 = *(const bf16x8*)(KN + kr * 512 + h * 64 + 32 + fq * 8), a2 = *(const bf16x8*)(KPEB + kr * 32 + fq * 8);
            f32x4 acc = {0.f, 0.f, 0.f, 0.f}; acc = mfma16(a0, Qb[0], acc); acc = mfma16(a1, Qb[1], acc); acc = mfma16(a2, Qb[2], acc);
            if (!valid) acc = (f32x4){-INFINITY, -INFINITY, -INFINITY, -INFINITY};
            s[sub] = acc; }
        float mx = max3f(s[0][0], s[0][1], s[0][2]); mx = max3f(mx, s[0][3], s[1][0]); mx = max3f(mx, s[1][1], s[1][2]); mx = max2f(mx, s[1][3]);
        mx = max2f(mx, xor16_get(mx)); mx = xor32_max(mx);
        const float mnew = max2f(m, mx); const float alpha = __builtin_amdgcn_exp2f(m - mnew); m = mnew;
        float p[8]; float ps = 0.f;
#pragma unroll
        for (int j = 0; j < 4; ++j) { p[j] = __builtin_amdgcn_exp2f(s[0][j] - mnew); p[4 + j] = __builtin_amdgcn_exp2f(s[1][j] - mnew); ps += p[j] + p[4 + j]; }
        lsum = lsum * alpha + ps;
        u32x4 pw; pw.x = pk2(p[0], p[1]); pw.y = pk2(p[2], p[3]); pw.z = pk2(p[4], p[5]); pw.w = pk2(p[6], p[7]);
        const bf16x8 Pb = __builtin_bit_cast(bf16x8, pw);
#pragma unroll
        for (int nt = 0; nt < 4; ++nt) { const bf16* vrow = VT + (size_t)(h * 64 + 16 * nt + fr) * NK + keybase + fq * 4;
            const s16x4 a = *(const s16x4*)(vrow + kof[0]), c = *(const s16x4*)(vrow + kof[1]);
            bf16x8 va; va[0] = a[0]; va[1] = a[1]; va[2] = a[2]; va[3] = a[3]; va[4] = c[0]; va[5] = c[1]; va[6] = c[2]; va[7] = c[3];
            O[nt] = mfma16(va, Pb, O[nt] * alpha); }
    }
    float lt = lsum; lt += xor16_get(lt); lt = xor32_sum(lt);
    LAS float* cb = (LAS float*)(lds + AT_COMB) + (wave * 64 + lane) * 18;
#pragma unroll
    for (int nt = 0; nt < 4; ++nt)
#pragma unroll
        for (int j = 0; j < 4; ++j) cb[nt * 4 + j] = O[nt][j];
    cb[16] = m; cb[17] = lt;
    __syncthreads();
    if (wave == 0) {
        float mm = -INFINITY;
#pragma unroll
        for (int w = 0; w < 8; ++w) mm = fmaxf(mm, ((LAS float*)(lds + AT_COMB))[(w * 64 + lane) * 18 + 16]);
        float L = 0.f; float acc[16];
#pragma unroll
        for (int i = 0; i < 16; ++i) acc[i] = 0.f;
#pragma unroll
        for (int w = 0; w < 8; ++w) { const LAS float* pp = (LAS float*)(lds + AT_COMB) + (w * 64 + lane) * 18; const float sc = __builtin_amdgcn_exp2f(pp[16] - mm); L += pp[17] * sc;
#pragma unroll
            for (int i = 0; i < 16; ++i) acc[i] += pp[i] * sc; }
        const float inv = 1.0f / L;
#pragma unroll
        for (int nt = 0; nt < 4; ++nt) { u32x2 w; w.x = pk2(acc[nt * 4] * inv, acc[nt * 4 + 1] * inv); w.y = pk2(acc[nt * 4 + 2] * inv, acc[nt * 4 + 3] * inv);
            *(u32x2*)(MIX + (size_t)(qrow0 + fr) * 1024 + h * 64 + 16 * nt + fq * 4) = w; }
    }
    __syncthreads();
}
__device__ __forceinline__ void attn_phase(const PP P, LAS unsigned char* lds) {
    const int G = P.G;
    for (int u = P.bid; u < 256 + 1024; u += G) {
        if (u < 256) { attn_sample_unit(P, lds, u >> 3, u & 7); }
        else { const int v = u - 256, bh = v & 127, half = (v >> 7) & 1, k = v >> 8;
            const int qt = (k == 0) ? 7 - half : (k == 1) ? half : (k == 2) ? 5 - half : 2 + half;
            attn_prompt_unit(P, lds, bh >> 3, bh & 7, qt); }
    }
}

__device__ __forceinline__ void ln_phase(const PP P, const float* g, const float* bta) {
    const int tid = P.tid, lane = tid & 63, wave = tid >> 6, G = P.G;
    float* X = P.out; bf16* XB = (bf16*)(P.ws + WS_XB);
    for (int row = P.bid * 8 + wave; row < MT; row += G * 8) {
        float* p = X + (size_t)row * 1024; f32x4 v[4]; float s = 0.f;
#pragma unroll
        for (int i = 0; i < 4; ++i) { v[i] = *(const f32x4*)(p + 256 * i + lane * 4); s += (v[i][0] + v[i][1]) + (v[i][2] + v[i][3]); }
        const float mu = wave_sum(s) * (1.0f / 1024.0f); float q = 0.f;
#pragma unroll
        for (int i = 0; i < 4; ++i) { const f32x4 d = v[i] - mu; q += (d[0] * d[0] + d[1] * d[1]) + (d[2] * d[2] + d[3] * d[3]); }
        const float rstd = rsqrtf(wave_sum(q) * (1.0f / 1024.0f) + 1e-5f);
#pragma unroll
        for (int i = 0; i < 4; ++i) { const int col = 256 * i + lane * 4; const f32x4 gg = *(const f32x4*)(g + col), bb = *(const f32x4*)(bta + col);
            const f32x4 y = (v[i] - mu) * rstd * gg + bb; *(f32x4*)(p + col) = y;
            u32x2 w; w.x = pk2(y[0], y[1]); w.y = pk2(y[2], y[3]); *(u32x2*)(XB + (size_t)row * 1024 + col) = w; }
    }
}

__device__ __forceinline__ void sample_gemm_res(const PP P, LAS unsigned char* lds, const bf16* A  , const bf16* Bt, int K, const float* xin  , float* Xs  ) {
    const int tid = P.tid, lane = tid & 63, wave = tid >> 6, fr = lane & 15, fq = lane >> 4;
    LAS float* part = (LAS float*)lds;
    for (int t = P.bid; t < 256; t += P.G) {
        const int r0 = (t >> 4) * 32, c0 = (t & 15) * 64, kw = K >> 3, kb = wave * kw;
        f32x4 acc[2][4];
#pragma unroll
        for (int a = 0; a < 2; ++a)
#pragma unroll
            for (int n = 0; n < 4; ++n) acc[a][n] = (f32x4){0.f, 0.f, 0.f, 0.f};
        const bf16* ap = A + (size_t)(r0 + fr) * K + kb + fq * 8; const bf16* bp = Bt + (size_t)(c0 + fr) * K + kb + fq * 8;
#pragma unroll 2
        for (int k0 = 0; k0 < kw; k0 += 32) {
            bf16x8 af[2], bf_[4];
#pragma unroll
            for (int a = 0; a < 2; ++a) af[a] = *(const bf16x8*)(ap + (size_t)(16 * a) * K + k0);
#pragma unroll
            for (int n = 0; n < 4; ++n) bf_[n] = *(const bf16x8*)(bp + (size_t)(16 * n) * K + k0);
#pragma unroll
            for (int a = 0; a < 2; ++a)
#pragma unroll
                for (int n = 0; n < 4; ++n) acc[a][n] = mfma16(af[a], bf_[n], acc[a][n]);
        }
        LAS float* mp = part + (wave * 64 + lane) * 33;
#pragma unroll
        for (int a = 0; a < 2; ++a)
#pragma unroll
            for (int n = 0; n < 4; ++n)
#pragma unroll
                for (int j = 0; j < 4; ++j) mp[(a * 4 + n) * 4 + j] = acc[a][n][j];
        __syncthreads();
        { const int grp = wave;
          float sum[4] = {0.f, 0.f, 0.f, 0.f};
#pragma unroll
          for (int w = 0; w < 8; ++w)
#pragma unroll
              for (int j = 0; j < 4; ++j) sum[j] += part[(w * 64 + lane) * 33 + 4 * grp + j];
          const int a = grp >> 2, n = grp & 3, col = c0 + 16 * n + fr;
#pragma unroll
          for (int j = 0; j < 4; ++j) { const int row = r0 + 16 * a + fq * 4 + j; Xs[(size_t)row * 1024 + col] = DN_ALPHA * xin[(size_t)row * 1024 + col] + sum[j]; } }
        __syncthreads();
    }
}

#define GB_LD(p) __hip_atomic_load((p), __ATOMIC_RELAXED, __HIP_MEMORY_SCOPE_AGENT)
#define GB_ADD(p) __hip_atomic_fetch_add((p), 1u, __ATOMIC_RELAXED, __HIP_MEMORY_SCOPE_AGENT)
#define GB_ST(p, v) __hip_atomic_store((p), (v), __ATOMIC_RELAXED, __HIP_MEMORY_SCOPE_AGENT)
__device__ __forceinline__ void fast_grid_bar(unsigned* bar, unsigned k  , int tid, int bid, int G) {
    asm volatile("s_waitcnt vmcnt(0)" ::: "memory");
    __syncthreads();
    if (tid == 0) {
        const unsigned ng = (G < 8) ? (unsigned)G : 8u, g = (unsigned)bid % ng, gsize = ((unsigned)G - g + ng - 1u) / ng;
        unsigned* sub = bar + 64 * g; unsigned* gen = bar + 64 * (8 + g); unsigned* top = bar + 64 * 16; unsigned* topgen = bar + 64 * 17;
        __builtin_amdgcn_fence(__ATOMIC_RELEASE, "agent");
        asm volatile("s_waitcnt vmcnt(0)" ::: "memory");
        const unsigned old = GB_ADD(sub); unsigned sp = 0;
        if (old + 1u == k * gsize) { const unsigned o2 = GB_ADD(top); if (o2 + 1u == k * ng) GB_ST(topgen, k); }
        while (GB_LD(topgen) < k) { __builtin_amdgcn_s_sleep(1); if (++sp > (1u << 24)) break; }
        __builtin_amdgcn_fence(__ATOMIC_ACQUIRE, "agent");
        asm volatile("s_waitcnt vmcnt(0)" ::: "memory");
    }
    __syncthreads();
}

__global__ void __launch_bounds__(512) mega(Params P) {
    extern __shared__ __attribute__((aligned(16))) unsigned char lds_raw[];
    LAS unsigned char* lds = (LAS unsigned char*)lds_raw;
    cg::grid_group grid = cg::this_grid();
    const int lo_ = P.lo, hi_ = P.hi; const int wave_s = __builtin_amdgcn_readfirstlane((int)(threadIdx.x >> 6));
    for (int step = lo_; step < hi_; ++step) {
        PP pp; pp.ws = KWS(); pp.out = KOUT(); unsigned char* ws = pp.ws;
        { int t_, b_ = blockIdx.x, g_ = gridDim.x; asm volatile("v_mbcnt_lo_u32_b32 %0, -1, 0\n\tv_mbcnt_hi_u32_b32 %0, -1, %0\n\tv_lshl_add_u32 %0, %3, 6, %0" : "=&v"(t_), "+s"(b_), "+s"(g_) : "s"(wave_s)); pp.tid = t_; pp.bid = b_; pp.G = g_; }
        int l = 0, kind = 0;
        if (REPK == 0) { if (step > 0) { l = (step - 1) / 10; kind = 1 + (step - 1) % 10; } }
        else if (step > 0) { l = (step - 1) / 11; const int kidx = (step - 1) % 11; kind = (kidx < REPK) ? kidx + 1 : kidx; if (kind == 6 && l == 1 && kidx == REPK) kind = 11; }
        const bf16* WB = (const bf16*)(ws + WS_W) + (size_t)l * W_LAYER;
        int nj = 0;
        PP pp2 = pp; const bool split = pp.G > 64; if (split) { pp2.bid = pp.bid - 64; pp2.G = pp.G - 64; }
        const bool shadow = !split || pp.bid >= 64;
        switch (kind) {
            case 0: prep_phase(pp, lds, 0, true); break;
            case 2: tok_phase(pp, l); g1_phase(pp, l, lds); break;
            case 3: g2_phase(pp, l, lds);
                     if (shadow) { conv_phase(pp2, l, lds); cache_phase(pp2, l); if (l == 0) prep_phase(pp2, lds, 1, false); nj = 1; }
                     break;
            case 5: attn_phase(pp, lds); break;
            case 7: ln_phase(pp, KIN(22) + l * 1024, KIN(23) + l * 1024); break;
            case 10: ln_phase(pp, KIN(27) + l * 1024, KIN(28) + l * 1024); break;
            case 4: nj = 3; break;
            case 11: break;
            default: nj = 1; break;
        }
        if (kind == 6 || kind == 9) {
            const float* xs_ = (kind == 6 && l == 0) ? KIN(1) : pp.out + (size_t)MP * 1024;
            if (kind == 6) sample_gemm_res(pp, lds, (const bf16*)(ws + WS_MIX) + (size_t)MP * 1024, WB + W_OUT, 1024, xs_, pp.out + (size_t)MP * 1024);
            else           sample_gemm_res(pp, lds, (const bf16*)(ws + WS_F) + (size_t)MP * DFF, WB + W_DN, DFF, xs_, pp.out + (size_t)MP * 1024);
        }
        for (int j = 0; j < nj; ++j) {
            pg8::Gemm g; bool perm; int mode; bf16* O = nullptr; size_t ldc = 0;
            if (kind == 1)      { g = pg8::Gemm{(const bf16*)(ws + WS_XB), WB + W_IN, MT, HLD, 1024}; perm = true; mode = 0; O = (bf16*)(ws + WS_H); ldc = HLD; }
            else if (kind == 3) { g = pg8::Gemm{(const bf16*)(ws + WS_CQN), WB + W_UQ, MT, 768, 384}; perm = false; mode = 2; O = (bf16*)(ws + WS_XB); ldc = 768; }
            else if (kind == 4 && j == 2 && pp.bid < 4) { g = pg8::Gemm{(const bf16*)(ws + WS_CKVB) + (size_t)NKM * 256, WB + W_UK, 512, 512, 256}; perm = true; mode = 0; O = (bf16*)(ws + WS_KN) + (size_t)NKM * 512; ldc = 512; }
            else if (kind == 4 && j == 2) { g = pg8::Gemm{WB + W_UVT, (const bf16*)(ws + WS_CKVB) + (size_t)NKM * 256, 512, 512, 256}; perm = true; mode = 0; O = (bf16*)(ws + WS_VT) + NKM; ldc = NK; }
            else if (kind == 4 && j == 0) { g = pg8::Gemm{(const bf16*)(ws + WS_CKVB), WB + W_UK, NKM, 512, 256}; perm = true; mode = 0; O = (bf16*)(ws + WS_KN); ldc = 512; }
            else if (kind == 4)           { g = pg8::Gemm{WB + W_UVT, (const bf16*)(ws + WS_CKVB), 512, NKM, 256}; perm = true; mode = 0; O = (bf16*)(ws + WS_VT); ldc = NK; }
            else if (kind == 6) { g = pg8::Gemm{(const bf16*)(ws + WS_MIX), WB + W_OUT, MP, 1024, 1024}; perm = false; mode = 3; }
            else if (kind == 8) { g = pg8::Gemm{(const bf16*)(ws + WS_XB), WB + W_GU, MT, 5632, 1024}; perm = true; mode = 1; O = (bf16*)(ws + WS_F); ldc = DFF; }
            else                { g = pg8::Gemm{(const bf16*)(ws + WS_F), WB + W_DN, MP, 1024, DFF}; perm = false; mode = 3; }
            const float* xp = pp.out; const float* xs = pp.out + (size_t)MP * 1024; if (kind == 6 && l == 0) { xp = KIN(0); xs = KIN(1); }
            pg8::StaticOrder S; if (kind == 3) S.init(g.M, g.N, pp2.G, pp2.bid); else if (kind == 4 && j == 2) S.init(g.M, g.N, pp.G, (pp.bid < 4) ? pp.bid : ((pp.bid - 4 + pp.G) % pp.G)); else S.init(g.M, g.N, pp.G, pp.bid);
            if (perm) { EpiT<true> E{mode, O, ldc, xp, xs, pp.out, (const float2*)(ws + WS_ROPE)}; pg8::gemm_phase<EpiT<true>, pg8::StaticOrder, true, true>(lds, g, S, E, pp.tid); }
            else      { EpiT<false> E{mode, O, ldc, xp, xs, pp.out, (const float2*)(ws + WS_ROPE)}; pg8::gemm_phase<EpiT<false>, pg8::StaticOrder, true, true>(lds, g, S, E, pp.tid); }
            __syncthreads();
        }
        if (step + 1 < hi_) {
            if (step == lo_) grid.sync();
            else fast_grid_bar((unsigned*)(ws + WS_BAR), (unsigned)(step - lo_), pp.tid, pp.bid, pp.G);
        }
    }
}

extern "C" void kernel_launch(void* const* d_in, const int* in_sizes, int n_in, void* d_out, int out_size, void* d_ws, size_t ws_size, hipStream_t stream) {
    static int grid_blocks = 0;
    if (!grid_blocks) {
        if (hipFuncSetAttribute((const void*)mega, hipFuncAttributeMaxDynamicSharedMemorySize, LDS_BYTES) != hipSuccess) { fprintf(stderr, "kernel_launch: hipFuncSetAttribute failed\n"); grid_blocks = -1; }
        else { int dev = 0, cus = 0, per_cu = 0; hipGetDevice(&dev); hipDeviceGetAttribute(&cus, hipDeviceAttributeMultiprocessorCount, dev);
            hipOccupancyMaxActiveBlocksPerMultiprocessor(&per_cu, mega, 512, LDS_BYTES);
            if (per_cu < 1) { fprintf(stderr, "kernel_launch: occupancy query says %d\n", per_cu); per_cu = 1; }
            grid_blocks = cus; }
    }
    if (grid_blocks <= 0) return;
    if (ws_size < WS_TOTAL || n_in < 29) { fprintf(stderr, "kernel_launch: workspace too small (%zu < %zu) or n_in %d\n", ws_size, (size_t)WS_TOTAL, n_in); return; }
    Params p{};
    for (int i = 0; i < 29; ++i) p.in[i] = (const float*)d_in[i];
    p.out = (float*)d_out; p.ws = (unsigned char*)d_ws;
#if COOP
    p.lo = 0; p.hi = (REPK == 0) ? 21 : 23; void* args[] = {&p};
    hipMemsetAsync((unsigned char*)d_ws + WS_BAR, 0, 8192, stream);
    hipError_t e = hipLaunchCooperativeKernel((const void*)mega, dim3(grid_blocks), dim3(512), args, LDS_BYTES, stream);
    if (e != hipSuccess) fprintf(stderr, "cooperative launch failed: %s (grid %d)\n", hipGetErrorString(e), grid_blocks);
#else
    for (int s = 0; s < 21; ++s) { p.lo = s; p.hi = s + 1; hipLaunchKernelGGL(mega, dim3(grid_blocks), dim3(512), LDS_BYTES, stream, p); }
#endif
}
```

```cpp
#include <hip/hip_runtime.h>
#include <hip/hip_cooperative_groups.h>
#include <cstdio>
#include <cstdint>
namespace cg = cooperative_groups;
namespace pg8 {
#define PG8_LAS __attribute__((address_space(3)))
typedef unsigned short bf16_t;
typedef short bf16x8 __attribute__((ext_vector_type(8)));
typedef float f32x4 __attribute__((ext_vector_type(4)));
typedef unsigned u32x4 __attribute__((ext_vector_type(4)));
constexpr int BM = 256, BK = 64, HALF = 128, HTB = HALF * BK * 2  , STAGE_BYTES = 8 * HTB, NXCD = 8, WGM = 8;

__host__ __device__ __forceinline__ int lds_byte(int r, int c) { const int st = (r >> 4) * 2 + (c >> 5), rr = r & 15, cc = c & 31, ob = rr * 64 + cc * 2; return st * 1024 + (ob ^ (((ob >> 9) & 1) << 5)); }
__host__ __device__ __forceinline__ void stage_rc(int b, int& R, int& C) { const int st = b / 1024, sb = b % 1024, swz = sb ^ (((sb >> 9) & 1) << 5); R = (st >> 1) * 16 + swz / 64; C = (st & 1) * 32 + (swz % 64) / 2; }
__host__ __device__ __forceinline__ int perm32(int rho) { const int n = rho >> 4, i = rho & 15; return 8 * (i >> 2) + 4 * n + (i & 3); }

struct Unit { int pm, pn; };
struct Gemm { const bf16_t* A; const bf16_t* Bt; int M, N, K; };

struct StaticOrder {
    int nM, nN, nwg, G, c;
    __host__ __device__ void init(int M, int N, int G_, int c_) { nM = M / BM; nN = N / BM; nwg = nM * nN; G = G_; c = c_; }
    __host__ __device__ bool next(int i, Unit& u) const {
        const long L = (long)i * G + c; if (L >= nwg) return false;
        int wgid = (int)L; { const int q = nwg / NXCD, r = nwg % NXCD, xcd = wgid % NXCD, off = wgid / NXCD; wgid = (xcd < r ? xcd * (q + 1) : r * (q + 1) + (xcd - r) * q) + off; }
        const int nig = WGM * nN, gid = wgid / nig, fm = gid * WGM, gsz = (nM - fm) < WGM ? (nM - fm) : WGM;
        u.pm = fm + ((wgid % nig) % gsz); u.pn = (wgid % nig) / gsz; return true;
    }
    __device__ __forceinline__ void a_ready(const Unit&) const {}
    __device__ __forceinline__ void done(const Unit&) const {}
};
__device__ __forceinline__ unsigned cvt_pk_bf16(float lo, float hi) { unsigned r; asm volatile("v_cvt_pk_bf16_f32 %0, %1, %2" : "=v"(r) : "v"(lo), "v"(hi)); return r; }
template <class Epi, class Sched, bool ALIGN_EPI = false, bool SP2 = false>
__device__ __forceinline__ void gemm_phase(PG8_LAS unsigned char* lds, const Gemm g, const Sched& S, const Epi& E, const int tid) {
    const int  wid = __builtin_amdgcn_readfirstlane(tid >> 6), lane = tid & 63, wr = wid >> 2, wc = wid & 3, fr = lane & 15, fq = lane >> 4;
    const int K = g.K, nt = K / BK;
    unsigned voffA[2], voffB[2];
#pragma unroll
    for (int i = 0; i < 2; ++i) { int R, C; stage_rc(tid * 16 + i * 8192, R, C); const int Rb = Epi::PERM ? ((R & ~31) + perm32(R & 31)) : R;
        voffA[i] = (unsigned)(R * K + C) * 2u; voffB[i] = (unsigned)(Rb * K + C) * 2u; }
    const size_t kstep = (size_t)(BK * 2);
    const size_t hstep = (size_t)HALF * K * 2;
    const size_t tstep = 2 * hstep;
    const unsigned ldsw = (unsigned)wid * 1024u;
    const int aoff = lds_byte(wr * 64 + fr, fq * 8), boff = lds_byte(wc * 32 + fr, fq * 8);
#define PG8_SA(b, h) (((b) * 2 + (h)) * HTB)
#define PG8_SB(b, h) ((4 + (b) * 2 + (h)) * HTB)
#define PG8_STAGE(bufoff, gbase, voff) do { _Pragma("unroll") for (int _i = 0; _i < 2; ++_i) \
        __builtin_amdgcn_global_load_lds((const unsigned*)((const char*)(gbase) + (voff)[_i]), (PG8_LAS unsigned*)(lds + (bufoff) + ldsw + _i * 8192), 16, 0, 0); } while (0)
#define PG8_LDA(dst, b, h) do { _Pragma("unroll") for (int m = 0; m < 4; ++m) _Pragma("unroll") for (int k = 0; k < 2; ++k) dst[m][k] = *(const PG8_LAS bf16x8*)(lds + PG8_SA(b, h) + aoff + m * 2048 + k * 1024); } while (0)
#define PG8_LDB(dst, b, h) do { _Pragma("unroll") for (int n = 0; n < 2; ++n) _Pragma("unroll") for (int k = 0; k < 2; ++k) dst[n][k] = *(const PG8_LAS bf16x8*)(lds + PG8_SB(b, h) + boff + n * 2048 + k * 1024); } while (0)
#define PG8_MMA(ai, bj, At, Bt) do { __builtin_amdgcn_s_setprio(1); _Pragma("unroll") for (int m = 0; m < 4; ++m) _Pragma("unroll") for (int n = 0; n < 2; ++n) _Pragma("unroll") for (int k = 0; k < 2; ++k) \
        acc[ai][bj][m][n] = __builtin_amdgcn_mfma_f32_16x16x32_bf16(Bt[n][k], At[m][k], acc[ai][bj][m][n], 0, 0, 0); __builtin_amdgcn_s_setprio(0); } while (0)
#define PG8_WAIT_V(n) asm volatile("s_waitcnt vmcnt(" #n ")" ::: "memory")
#define PG8_WAIT_L(n) asm volatile("s_waitcnt lgkmcnt(" #n ")" ::: "memory")
#define PG8_BAR __builtin_amdgcn_s_barrier()
#define PG8_SCHED __builtin_amdgcn_sched_barrier(0)
    Unit cur, nxt; int ui = 0;
    if (!S.next(0, cur)) return;
    f32x4 acc[2][2][4][2];
#pragma unroll
    for (int a = 0; a < 2; ++a)
#pragma unroll
        for (int b = 0; b < 2; ++b)
#pragma unroll
            for (int m = 0; m < 4; ++m)
#pragma unroll
                for (int n = 0; n < 2; ++n) acc[a][b][m][n] = (f32x4){0.f, 0.f, 0.f, 0.f};
    bf16x8 At[4][2], B0[2][2], B1[2][2];
    const char* cA = (const char*)g.A + (size_t)cur.pm * tstep; const char* cB = (const char*)g.Bt + (size_t)cur.pn * tstep;
    S.a_ready(cur);
    if constexpr (SP2) {
        PG8_STAGE(PG8_SB(0, 0), cB, voffB); PG8_STAGE(PG8_SB(0, 1), cB + hstep, voffB); PG8_STAGE(PG8_SA(0, 0), cA, voffA); PG8_STAGE(PG8_SA(0, 1), cA + hstep, voffA);
        if (wr == 1) PG8_BAR;
        PG8_WAIT_V(2); PG8_BAR;
        PG8_STAGE(PG8_SB(1, 0), cB + kstep, voffB); PG8_STAGE(PG8_SA(1, 0), cA + kstep, voffA); PG8_STAGE(PG8_SB(1, 1), cB + hstep + kstep, voffB);
        PG8_WAIT_V(6); PG8_BAR;
    } else {
        PG8_STAGE(PG8_SB(0, 0), cB, voffB); PG8_STAGE(PG8_SA(0, 0), cA, voffA); PG8_STAGE(PG8_SB(0, 1), cB + hstep, voffB); PG8_STAGE(PG8_SA(0, 1), cA + hstep, voffA);
        if (wr == 1) PG8_BAR;
        PG8_WAIT_V(4); PG8_BAR;
        PG8_STAGE(PG8_SB(1, 0), cB + kstep, voffB); PG8_STAGE(PG8_SA(1, 0), cA + kstep, voffA); PG8_STAGE(PG8_SB(1, 1), cB + hstep + kstep, voffB);
        PG8_WAIT_V(6); PG8_BAR;
    }
    for (;;) {
        const bool has_next = S.next(ui + 1, nxt);
        const char* nA = has_next ? (const char*)g.A + (size_t)nxt.pm * tstep : cA; const char* nB = has_next ? (const char*)g.Bt + (size_t)nxt.pn * tstep : cB;
        for (int t = 0; t < nt; t += 2) {
            const bool last = (t == nt - 2);
            const char* a1 = cA + (size_t)(t + 1) * kstep;
            const char* a2 = last ? nA : cA + (size_t)(t + 2) * kstep; const char* b2 = last ? nB : cB + (size_t)(t + 2) * kstep;
            const char* a3 = a2 + kstep; const char* b3 = b2 + kstep;
            if (last && has_next) S.a_ready(nxt);
            if constexpr (SP2) {
            PG8_LDB(B0, 0, 0); PG8_LDB(B1, 0, 1); PG8_SCHED; PG8_LDA(At, 0, 0); PG8_STAGE(PG8_SA(1, 1), a1 + hstep, voffA);
            PG8_WAIT_V(8); PG8_WAIT_L(0); PG8_BAR; PG8_MMA(0, 0, At, B0); PG8_MMA(0, 1, At, B1); PG8_BAR; PG8_SCHED;
            PG8_LDA(At, 0, 1); PG8_STAGE(PG8_SB(0, 0), b2, voffB); PG8_STAGE(PG8_SB(0, 1), b2 + hstep, voffB); PG8_STAGE(PG8_SA(0, 0), a2, voffA);
            PG8_WAIT_V(8); PG8_WAIT_L(0); PG8_BAR; PG8_MMA(1, 0, At, B0); PG8_MMA(1, 1, At, B1); PG8_BAR; PG8_SCHED;
            PG8_LDB(B0, 1, 0); PG8_LDB(B1, 1, 1); PG8_SCHED; PG8_LDA(At, 1, 0); PG8_STAGE(PG8_SA(0, 1), a2 + hstep, voffA);
            PG8_WAIT_V(8); PG8_WAIT_L(0); PG8_BAR; PG8_MMA(0, 0, At, B0); PG8_MMA(0, 1, At, B1); PG8_BAR; PG8_SCHED;
            PG8_LDA(At, 1, 1); PG8_STAGE(PG8_SB(1, 0), b3, voffB); PG8_STAGE(PG8_SB(1, 1), b3 + hstep, voffB); PG8_STAGE(PG8_SA(1, 0), a3, voffA);
            PG8_WAIT_V(8); PG8_WAIT_L(0); PG8_BAR; PG8_MMA(1, 0, At, B0); PG8_MMA(1, 1, At, B1); PG8_BAR; PG8_SCHED;
            } else {
            PG8_LDB(B0, 0, 0); PG8_SCHED; PG8_LDA(At, 0, 0); PG8_STAGE(PG8_SA(1, 1), a1 + hstep, voffA);
            PG8_WAIT_L(8); PG8_BAR; PG8_WAIT_L(0); PG8_MMA(0, 0, At, B0); PG8_BAR; PG8_SCHED;
            PG8_LDB(B1, 0, 1); PG8_STAGE(PG8_SB(0, 0), b2, voffB);
            PG8_BAR; PG8_WAIT_L(0); PG8_MMA(0, 1, At, B1); PG8_BAR;
            PG8_LDA(At, 0, 1); PG8_STAGE(PG8_SA(0, 0), a2, voffA);
            PG8_BAR; PG8_WAIT_L(0); PG8_MMA(1, 0, At, B0); PG8_BAR; PG8_SCHED;
            PG8_STAGE(PG8_SB(0, 1), b2 + hstep, voffB);
            PG8_WAIT_V(6); PG8_BAR; PG8_MMA(1, 1, At, B1); PG8_BAR;
            PG8_LDB(B0, 1, 0); PG8_SCHED; PG8_LDA(At, 1, 0); PG8_STAGE(PG8_SA(0, 1), a2 + hstep, voffA);
            PG8_WAIT_L(8); PG8_BAR; PG8_WAIT_L(0); PG8_MMA(0, 0, At, B0); PG8_BAR; PG8_SCHED;
            PG8_LDB(B1, 1, 1); PG8_STAGE(PG8_SB(1, 0), b3, voffB);
            PG8_BAR; PG8_WAIT_L(0); PG8_MMA(0, 1, At, B1); PG8_BAR;
            PG8_LDA(At, 1, 1); PG8_STAGE(PG8_SA(1, 0), a3, voffA);
            PG8_BAR; PG8_WAIT_L(0); PG8_MMA(1, 0, At, B0); PG8_BAR; PG8_SCHED;
            PG8_STAGE(PG8_SB(1, 1), b3 + hstep, voffB);
            PG8_WAIT_V(6); PG8_BAR; PG8_MMA(1, 1, At, B1); PG8_BAR;
            }
        }
        if constexpr (ALIGN_EPI) { if (wr == 0) PG8_BAR; }
        if constexpr (!Epi::AFTER_DRAIN) { E(acc, cur, wr, wc, fr, fq); S.done(cur); }
        if (!has_next) break;
#pragma unroll
        for (int a = 0; a < 2; ++a)
#pragma unroll
            for (int b = 0; b < 2; ++b)
#pragma unroll
                for (int m = 0; m < 4; ++m)
#pragma unroll
                    for (int n = 0; n < 2; ++n) acc[a][b][m][n] = (f32x4){0.f, 0.f, 0.f, 0.f};
        cur = nxt; cA = nA; cB = nB; ++ui;
        if constexpr (ALIGN_EPI) { if (wr == 1) PG8_BAR; }
    }
    PG8_WAIT_V(0);
    if constexpr (!ALIGN_EPI) { if (wr == 0) PG8_BAR; }
    PG8_BAR;
    if constexpr (Epi::AFTER_DRAIN) { E.fused(acc, cur, wr, wc, fr, fq, lds, wid, lane); S.done(cur); }
#undef PG8_SA
#undef PG8_SB
#undef PG8_STAGE
#undef PG8_LDA
#undef PG8_LDB
#undef PG8_MMA
#undef PG8_WAIT_V
#undef PG8_WAIT_L
#undef PG8_BAR
#undef PG8_SCHED
}
}

#define LAS __attribute__((address_space(3)))
typedef unsigned short bf16;
typedef short bf16x8 __attribute__((ext_vector_type(8)));
typedef short s16x4 __attribute__((ext_vector_type(4)));
typedef float f32x4 __attribute__((ext_vector_type(4)));
typedef unsigned u32x4 __attribute__((ext_vector_type(4)));
typedef unsigned u32x2 __attribute__((ext_vector_type(2)));

#ifndef COOP
#define COOP 1
#endif
#ifndef REPK
#define REPK 0
#endif
#ifndef REPG1
#define REPG1 0
#endif
#ifndef REP2
#define REP2 0
#endif
#ifndef GDN_SPLIT
#define GDN_SPLIT 0
#endif

constexpr int MP = 32768, MS = 512, MT = MP + MS;
constexpr int SKS = 2064;
constexpr int NK = MP + 32 * SKS;
constexpr int NKM = MP + 65536;
constexpr int HLD = 2304;
constexpr int C_CKV = 384, C_KPE = 640, C_QKV = 672, C_B = 1440, C_A = 1444, C_Z = 1448, C_GA = 1704, C_GG = 1960;
constexpr int DFF = 2816;
constexpr float DN_ALPHA = 1.41421356237f;
constexpr float QSCALE = 0.10206207261596577f * 1.4426950408889634f;

constexpr size_t O_YP = 0, O_YS = 33554432, O_CKVP = 34078720, O_KPEP = 50855936, O_GDNP = 52953088, O_GCP = 53477376,
                 O_CVP = 53551104, O_CKVS = 53796864, O_KPES = 54059008, O_GDNS = 54091776, O_GCS = 55140352, O_CVS = 55287808;

constexpr size_t W_IN = 0, W_UQ = W_IN + 2304 * 1024, W_UK = W_UQ + 768 * 384, W_UVT = W_UK + 512 * 256, W_OUT = W_UVT + 512 * 256,
                 W_GU = W_OUT + 1024 * 1024, W_DN = W_GU + 5632 * 1024, W_LAYER = W_DN + 1024 * 2816;
constexpr size_t WS_W = 0, WS_ROPE = WS_W + 2 * W_LAYER * 2, WS_XB = WS_ROPE + 2064 * 16 * 8, WS_MIX = WS_XB + (size_t)MT * 1024 * 2,
                 WS_CQN = WS_MIX + (size_t)MT * 1024 * 2, WS_CKVB = WS_CQN + (size_t)MT * 384 * 2, WS_KPEB = WS_CKVB + (size_t)NK * 256 * 2,
                 WS_BIG = WS_KPEB + (size_t)NK * 32 * 2;
constexpr size_t GUNIT = 49408;
constexpr int NGU = 2176;
constexpr size_t WS_H = WS_BIG, WS_GSCR = WS_H + (size_t)MT * HLD * 2, BIG1 = (size_t)MT * HLD * 2 + (size_t)NGU * GUNIT;
constexpr size_t WS_Q = WS_BIG, WS_KN = WS_Q + (size_t)MT * 768 * 2, WS_VT = WS_KN + (size_t)NK * 512 * 2, BIG2 = (size_t)MT * 768 * 2 + 2 * (size_t)NK * 512 * 2;
constexpr size_t WS_F = WS_BIG, BIG3 = (size_t)MT * DFF * 2;
constexpr size_t BIGSZ = BIG1 > BIG2 ? (BIG1 > BIG3 ? BIG1 : BIG3) : (BIG2 > BIG3 ? BIG2 : BIG3);
constexpr size_t WS_BAR = WS_BIG + BIGSZ;
constexpr size_t WS_TOTAL = WS_BAR + 8192;
static_assert(WS_TOTAL <= 536870912ull, "workspace map exceeds 512 MiB");
static_assert(WS_XB % 256 == 0 && WS_BIG % 256 == 0 && WS_GSCR % 256 == 0 && WS_KN % 256 == 0 && WS_VT % 256 == 0, "alignment");

constexpr int LDS_BYTES = 139264;
constexpr int G1_GRP = 67584;

struct Params { const float* in[29]; float* out; unsigned char* ws; int lo, hi; };
template <int OFF> __device__ __forceinline__ unsigned long long karg_u64() {
    unsigned long long v; const unsigned long long kp = (unsigned long long)__builtin_amdgcn_kernarg_segment_ptr();
    asm volatile("s_load_dwordx2 %0, %1, %2\n\ts_waitcnt lgkmcnt(0)" : "=s"(v) : "s"(kp), "n"(OFF));
    return v;
}
#define GAS1 __attribute__((address_space(1)))
#define KIN(i) ((const float*)(const GAS1 float*)karg_u64<8 * (i)>())
#define KOUT() ((float*)(GAS1 float*)karg_u64<232>())
#define KWS() ((unsigned char*)(GAS1 unsigned char*)karg_u64<240>())
struct PP { unsigned char* ws; float* out; int tid, bid, G; };

typedef float f32x2_ __attribute__((ext_vector_type(2))); typedef __bf16 bf16x2_ __attribute__((ext_vector_type(2)));
__device__ __forceinline__ unsigned f2bf(float f) { const f32x2_ v = {f, 0.f}; const bf16x2_ b = __builtin_convertvector(v, bf16x2_); return __builtin_bit_cast(unsigned, b) & 0xffffu; }
__device__ __forceinline__ float bf2f(unsigned b) { return __builtin_bit_cast(float, b << 16); }
__device__ __forceinline__ unsigned pk2(float lo, float hi) { const f32x2_ v = {lo, hi}; return __builtin_bit_cast(unsigned, __builtin_convertvector(v, bf16x2_)); }
__device__ __forceinline__ float sigmoidf_(float x) { return __builtin_amdgcn_rcpf(1.0f + __expf(-x)); }
__device__ __forceinline__ float siluf_(float x) { return x * sigmoidf_(x); }

template <int CTRL> __device__ __forceinline__ float dpp_f(float v) { return __builtin_bit_cast(float, __builtin_amdgcn_update_dpp(0, __builtin_bit_cast(int, v), CTRL, 0xf, 0xf, false)); }
__device__ __forceinline__ float row16_sum(float v) { v += dpp_f<0xB1>(v); v += dpp_f<0x4E>(v); v += dpp_f<0x141>(v); v += dpp_f<0x140>(v); return v; }
__device__ __forceinline__ float xor16_get(float v) { return __builtin_bit_cast(float, __builtin_amdgcn_ds_swizzle(__builtin_bit_cast(int, v), 0x401F)); }
__device__ __forceinline__ float xor32_max(float v) { const unsigned u = __builtin_bit_cast(unsigned, v); auto r = __builtin_amdgcn_permlane32_swap(u, u, false, false); return fmaxf(__builtin_bit_cast(float, (unsigned)r[0]), __builtin_bit_cast(float, (unsigned)r[1])); }
__device__ __forceinline__ float xor32_sum(float v) { const unsigned u = __builtin_bit_cast(unsigned, v); auto r = __builtin_amdgcn_permlane32_swap(u, u, false, false); return __builtin_bit_cast(float, (unsigned)r[0]) + __builtin_bit_cast(float, (unsigned)r[1]); }
__device__ __forceinline__ float wave_sum(float v) {
    v = row16_sum(v); const int iv = __builtin_bit_cast(int, v);
    const float s0 = __builtin_bit_cast(float, __builtin_amdgcn_readlane(iv, 0)), s1 = __builtin_bit_cast(float, __builtin_amdgcn_readlane(iv, 16));
    const float s2 = __builtin_bit_cast(float, __builtin_amdgcn_readlane(iv, 32)), s3 = __builtin_bit_cast(float, __builtin_amdgcn_readlane(iv, 48));
    return (s0 + s1) + (s2 + s3);
}
#define LBAR() asm volatile("s_waitcnt lgkmcnt(0)\n\ts_barrier" ::: "memory")
__device__ __forceinline__ f32x4 mfma16(bf16x8 a, bf16x8 b, f32x4 c) { return __builtin_amdgcn_mfma_f32_16x16x32_bf16(a, b, c, 0, 0, 0); }

template <bool P> struct EpiT {
    static constexpr bool PERM = P, AFTER_DRAIN = false;
    int mode;
    bf16* O; size_t ldc;
    const float* xp; const float* xs; float* X;
    const float2* rope;
    __device__ __forceinline__ void operator()(const f32x4 (&acc)[2][2][4][2], const pg8::Unit& u, int wr, int wc, int fr, int fq) const {
        const int row0 = u.pm * 256 + wr * 64 + fr;
        if constexpr (P) {
            if (mode == 0) {
                const int col0 = u.pn * 256 + wc * 32 + 8 * fq;
#pragma unroll
                for (int ai = 0; ai < 2; ++ai)
#pragma unroll
                    for (int m = 0; m < 4; ++m) { bf16* rowp = O + (size_t)(row0 + ai * 128 + m * 16) * ldc + col0;
#pragma unroll
                        for (int bj = 0; bj < 2; ++bj) { const f32x4 v0 = acc[ai][bj][m][0], v1 = acc[ai][bj][m][1]; u32x4 w;
                            w.x = pk2(v0[0], v0[1]); w.y = pk2(v0[2], v0[3]); w.z = pk2(v1[0], v1[1]); w.w = pk2(v1[2], v1[3]);
                            *(u32x4*)(rowp + bj * 128) = w; } }
            } else {
                const int col0 = u.pn * 128 + wc * 32 + 8 * fq;
#pragma unroll
                for (int ai = 0; ai < 2; ++ai)
#pragma unroll
                    for (int m = 0; m < 4; ++m) { bf16* rowp = O + (size_t)(row0 + ai * 128 + m * 16) * ldc + col0;
                        float f[8];
#pragma unroll
                        for (int n = 0; n < 2; ++n)
#pragma unroll
                            for (int j = 0; j < 4; ++j) { const float g = acc[ai][0][m][n][j], up = acc[ai][1][m][n][j]; f[n * 4 + j] = siluf_(g) * up; }
                        u32x4 w; w.x = pk2(f[0], f[1]); w.y = pk2(f[2], f[3]); w.z = pk2(f[4], f[5]); w.w = pk2(f[6], f[7]);
                        *(u32x4*)rowp = w; }
            }
        } else {
            if (mode == 3) {
#pragma unroll
                for (int ai = 0; ai < 2; ++ai)
#pragma unroll
                    for (int m = 0; m < 4; ++m) { const int row = row0 + ai * 128 + m * 16;
                        const float* src = (row < MP) ? xp + (size_t)row * 1024 : xs + (size_t)(row - MP) * 1024;
                        float* dst = X + (size_t)row * 1024;
#pragma unroll
                        for (int bj = 0; bj < 2; ++bj)
#pragma unroll
                            for (int n = 0; n < 2; ++n) { const int col = u.pn * 256 + bj * 128 + wc * 32 + n * 16 + 4 * fq;
                                const f32x4 xi = *(const f32x4*)(src + col); f32x4 o = xi * DN_ALPHA + acc[ai][bj][m][n];
                                *(f32x4*)(dst + col) = o; }
                        __builtin_amdgcn_sched_barrier(0); }
            } else {
#pragma unroll
                for (int ai = 0; ai < 2; ++ai)
#pragma unroll
                    for (int m = 0; m < 4; ++m) { const int row = row0 + ai * 128 + m * 16;
                        const int pos = (row < MP) ? (row & 2047) : (2048 + ((row - MP) & 15));
                        bf16* rowp = O + (size_t)row * 768;
#pragma unroll
                        for (int bj = 0; bj < 2; ++bj) { const int g32 = u.pn * 256 + bj * 128 + wc * 32;
                            f32x4 a = acc[ai][bj][m][0], b = acc[ai][bj][m][1];
                            if ((g32 % 96) == 64) {
                                const float2* rp = rope + pos * 16 + 4 * fq;
#pragma unroll
                                for (int j = 0; j < 4; ++j) { const float2 cs = rp[j]; const float x1 = a[j], x2 = b[j]; a[j] = x1 * cs.x - x2 * cs.y; b[j] = x1 * cs.y + x2 * cs.x; }
                            }
                            a = a * QSCALE; b = b * QSCALE;
                            u32x2 w0, w1; w0.x = pk2(a[0], a[1]); w0.y = pk2(a[2], a[3]); w1.x = pk2(b[0], b[1]); w1.y = pk2(b[2], b[3]);
                            *(u32x2*)(rowp + g32 + 4 * fq) = w0; *(u32x2*)(rowp + g32 + 16 + 4 * fq) = w1; }
                        __builtin_amdgcn_sched_barrier(0); }
            }
        }
    }
};

__device__ __forceinline__ void prep_phase(const PP P, LAS unsigned char* lds, const int wl, const bool do_rest) {
    const int tid = P.tid, G = P.G;
    LAS float* tile = (LAS float*)lds;
    bf16* WB = (bf16*)(P.ws + WS_W);
    const int tx = tid & 63, ty = tid >> 6;
    for (int it = P.bid; it < 3080; it += G) {
        const int l = wl, r = it;
        const float* src; int ld, K, kt_n, tt; bf16* dst; int kind;
        if (r < 576)       { kind = 0; tt = r;        src = KIN(7) + (size_t)l * 1024 * 2216;  ld = 2216; K = 1024; kt_n = 16; dst = WB + l * W_LAYER + W_IN; }
        else if (r < 648)  { kind = 1; tt = r - 576;  src = KIN(9) + (size_t)l * 384 * 768;    ld = 768;  K = 384;  kt_n = 6;  dst = WB + l * W_LAYER + W_UQ; }
        else if (r < 680)  { kind = 1; tt = r - 648;  src = KIN(11) + (size_t)l * 256 * 512;   ld = 512;  K = 256;  kt_n = 4;  dst = WB + l * W_LAYER + W_UK; }
        else if (r < 712)  { kind = 1; tt = r - 680;  src = KIN(12) + (size_t)l * 256 * 512;   ld = 512;  K = 256;  kt_n = 4;  dst = WB + l * W_LAYER + W_UVT; }
        else if (r < 968)  { kind = 1; tt = r - 712;  src = KIN(21) + (size_t)l * 1024 * 1024; ld = 1024; K = 1024; kt_n = 16; dst = WB + l * W_LAYER + W_OUT; }
        else if (r < 2376) { kind = 2; tt = r - 968;  src = nullptr;                            ld = 2816; K = 1024; kt_n = 16; dst = WB + l * W_LAYER + W_GU; }
        else               { kind = 1; tt = r - 2376; src = KIN(26) + (size_t)l * 2816 * 1024; ld = 1024; K = 2816; kt_n = 44; dst = WB + l * W_LAYER + W_DN; }
        const int n0 = (tt / kt_n) * 64, k0 = (tt % kt_n) * 64;
        int col0 = n0; bool valid = true;
        if (kind == 0) valid = (n0 + tx) < 2216;
        if (kind == 2) { src = (((n0 >> 7) & 1) ? KIN(25) : KIN(24)) + (size_t)l * 1024 * 2816; col0 = (n0 >> 8) * 128 + (n0 & 127); }
#pragma unroll
        for (int kk = ty; kk < 64; kk += 8) tile[kk * 65 + tx] = valid ? src[(size_t)(k0 + kk) * ld + col0 + tx] : 0.f;
        __syncthreads();
#pragma unroll
        for (int nn = ty; nn < 64; nn += 8) dst[(size_t)(n0 + nn) * K + k0 + tx] = (bf16)f2bf(tile[tx * 65 + nn]);
        __syncthreads();
    }
    if (!do_rest) return;
    bf16* XB = (bf16*)(P.ws + WS_XB);
    for (int g = P.bid * 512 + tid; g < MT * 128; g += G * 512) {
        const int row = g >> 7, c8 = g & 127;
        const float* s = (row < MP) ? KIN(0) + (size_t)row * 1024 + c8 * 8 : KIN(1) + (size_t)(row - MP) * 1024 + c8 * 8;
        const f32x4 a = *(const f32x4*)s, b = *(const f32x4*)(s + 4);
        u32x4 w; w.x = pk2(a[0], a[1]); w.y = pk2(a[2], a[3]); w.z = pk2(b[0], b[1]); w.w = pk2(b[2], b[3]);
        *(u32x4*)(XB + (size_t)g * 8) = w;
    }
    float2* rope = (float2*)(P.ws + WS_ROPE);
    for (int idx = P.bid * 512 + tid; idx < 2064 * 16; idx += G * 512) {
        const int pos = idx >> 4, i = idx & 15;
        const float inv = __expf(-9.210340371976184f * (float)i / 16.0f);
        const float ang = (float)pos * inv;
        const float k = rintf(ang * 0.15915494309189535f);
        float rr = fmaf(-k, 6.2831854820251465f, ang); rr = fmaf(k, 1.7484555e-7f, rr);
        rope[idx] = make_float2(__cosf(rr), __sinf(rr));
    }
}

__device__ __forceinline__ void tok_phase(const PP P, int l) {
    const int tid = P.tid, lane = tid & 63, wave = tid >> 6, G = P.G;
    const bf16* H = (const bf16*)(P.ws + WS_H);
    bf16* CQN = (bf16*)(P.ws + WS_CQN); bf16* CKVB = (bf16*)(P.ws + WS_CKVB); bf16* KPEB = (bf16*)(P.ws + WS_KPEB);
    const float2* rope = (const float2*)(P.ws + WS_ROPE);
    const float* qn = KIN(8) + l * 384; const float* kvn = KIN(10) + l * 256;
    float* out = P.out;
    for (int row = P.bid * 8 + wave; row < MT; row += G * 8) {
        const bf16* hr = H + (size_t)row * HLD;
        const bool smp = row >= MP; int b, t, pos;
        if (!smp) { b = row >> 11; t = row & 2047; pos = t; } else { const int rr = row - MP; b = rr >> 4; t = rr & 15; pos = 2048 + t; }
        const size_t krow = smp ? (size_t)MP + 65536 + (size_t)b * 16 + t : (size_t)row;
        { float v[6]; float ss = 0.f;
#pragma unroll
          for (int i = 0; i < 3; ++i) { const unsigned w = *(const unsigned*)(hr + 128 * i + lane * 2); v[2 * i] = bf2f(w & 0xffffu); v[2 * i + 1] = bf2f(w >> 16); ss += v[2 * i] * v[2 * i] + v[2 * i + 1] * v[2 * i + 1]; }
          ss = wave_sum(ss); const float rinv = __builtin_amdgcn_rsqf(ss * (1.0f / 384.0f) + 1e-6f);
#pragma unroll
          for (int i = 0; i < 3; ++i) { const int col = 128 * i + lane * 2; *(unsigned*)(CQN + (size_t)row * 384 + col) = pk2(v[2 * i] * rinv * qn[col], v[2 * i + 1] * rinv * qn[col + 1]); } }
        { const u32x2 w = *(const u32x2*)(hr + C_CKV + lane * 4);
          float v0 = bf2f(w.x & 0xffffu), v1 = bf2f(w.x >> 16), v2 = bf2f(w.y & 0xffffu), v3 = bf2f(w.y >> 16);
          float ss = wave_sum(v0 * v0 + v1 * v1 + v2 * v2 + v3 * v3); const float rinv = __builtin_amdgcn_rsqf(ss * (1.0f / 256.0f) + 1e-6f);
          const f32x4 gn = *(const f32x4*)(kvn + lane * 4);
          f32x4 o; o[0] = v0 * rinv * gn[0]; o[1] = v1 * rinv * gn[1]; o[2] = v2 * rinv * gn[2]; o[3] = v3 * rinv * gn[3];
          float* op = smp ? out + O_CKVS + ((size_t)(l * 32 + b) * 16 + t) * 256 : out + O_CKVP + ((size_t)(l * 16 + b) * 2048 + t) * 256;
          *(f32x4*)(op + lane * 4) = o;
          u32x2 pw; pw.x = pk2(o[0], o[1]); pw.y = pk2(o[2], o[3]); *(u32x2*)(CKVB + krow * 256 + lane * 4) = pw; }
        if (lane < 16) { const float x1 = bf2f(hr[C_KPE + lane]), x2 = bf2f(hr[C_KPE + 16 + lane]); const float2 cs = rope[pos * 16 + lane];
          const float o1 = x1 * cs.x - x2 * cs.y, o2 = x1 * cs.y + x2 * cs.x;
          float* op = smp ? out + O_KPES + ((size_t)(l * 32 + b) * 16 + t) * 32 : out + O_KPEP + ((size_t)(l * 16 + b) * 2048 + t) * 32;
          op[lane] = o1; op[16 + lane] = o2; KPEB[krow * 32 + lane] = (bf16)f2bf(o1); KPEB[krow * 32 + 16 + lane] = (bf16)f2bf(o2); }
        { const int T = smp ? 16 : 2048;
          if (t >= T - 3) { const int j = t - (T - 3);
            float* op = smp ? out + O_GCS + ((size_t)(l * 32 + b) * 3 + j) * 768 : out + O_GCP + ((size_t)(l * 16 + b) * 3 + j) * 768;
#pragma unroll
            for (int i = 0; i < 12; ++i) op[lane + 64 * i] = bf2f(hr[C_QKV + lane + 64 * i]); } }
        if (smp || t >= 2018) {
            float* op = smp ? out + O_CVS + ((size_t)(l * 32 + b) * 30 + 14 + t) * 256 : out + O_CVP + ((size_t)(l * 16 + b) * 30 + (t - 2018)) * 256;
#pragma unroll
            for (int i = 0; i < 4; ++i) { const int ch = lane + 64 * i; op[ch] = bf2f(hr[C_GA + ch]) * sigmoidf_(bf2f(hr[C_GG + ch])); }
            if (smp && t == 0) {
                const float* sc = KIN(6) + ((size_t)(l * 32 + b) * 30 + 16) * 256; float* o2 = out + O_CVS + (size_t)(l * 32 + b) * 30 * 256;
                for (int e = lane; e < 14 * 256; e += 64) o2[e] = sc[e];
            }
        }
    }
}

__device__ __forceinline__ void cache_phase(const PP P, int l) {
    const int tid = P.tid, G = P.G;
    bf16* CKVB = (bf16*)(P.ws + WS_CKVB); bf16* KPEB = (bf16*)(P.ws + WS_KPEB);
    const float* cckv = KIN(2) + (size_t)l * 32 * 2048 * 256; const float* ckpe = KIN(3) + (size_t)l * 32 * 2048 * 32;
    for (int g = P.bid * 512 + tid; g < 65536 * 32; g += G * 512) {
        const int prow = g >> 5, c8 = g & 31, b = prow >> 11, s = prow & 2047;
        const float* sp = cckv + (size_t)prow * 256 + c8 * 8; const f32x4 a = *(const f32x4*)sp, c = *(const f32x4*)(sp + 4);
        u32x4 w; w.x = pk2(a[0], a[1]); w.y = pk2(a[2], a[3]); w.z = pk2(c[0], c[1]); w.w = pk2(c[2], c[3]);
        *(u32x4*)(CKVB + ((size_t)MP + (size_t)b * 2048 + s) * 256 + c8 * 8) = w;
    }
    for (int g = P.bid * 512 + tid; g < 65536 * 4; g += G * 512) {
        const int prow = g >> 2, c8 = g & 3, b = prow >> 11, s = prow & 2047;
        const float* sp = ckpe + (size_t)prow * 32 + c8 * 8; const f32x4 a = *(const f32x4*)sp, c = *(const f32x4*)(sp + 4);
        u32x4 w; w.x = pk2(a[0], a[1]); w.y = pk2(a[2], a[3]); w.z = pk2(c[0], c[1]); w.w = pk2(c[2], c[3]);
        *(u32x4*)(KPEB + ((size_t)MP + (size_t)b * 2048 + s) * 32 + c8 * 8) = w;
    }
}

__device__ __forceinline__ void conv_phase(const PP P, int l, LAS unsigned char* lds) {
    const int tid = P.tid, lane = tid & 63, wave = tid >> 6, G = P.G;
    const bf16* H = (const bf16*)(P.ws + WS_H); bf16* MIX = (bf16*)(P.ws + WS_MIX);
    LAS bf16* cs = (LAS bf16*)lds;
    LAS float* os = (LAS float*)(lds + 48128);
    const float* cw = KIN(17) + (size_t)l * 31 * 256; const float* cb = KIN(18) + l * 256;
    const float* lg = KIN(19) + l * 256; const float* lb = KIN(20) + l * 256; const float* sc = KIN(6);
    for (int u = P.bid; u < 544; u += G) {
        const bool smp = u < 32; int b, t0, ntok; size_t row0;
        if (!smp) { const int v = u - 32; b = v >> 5; t0 = (v & 31) * 64; ntok = 64; row0 = (size_t)b * 2048 + t0; } else { b = u; t0 = 0; ntok = 16; row0 = (size_t)MP + b * 16; }
        { const int ch2 = (tid & 127) * 2, rg = tid >> 7; const int nrow = 30 + ntok;
          const GAS1 bf16* hb = (const GAS1 bf16*)(H + ((long long)row0 - 30 + rg) * HLD + ch2);
          for (int k0 = 0; k0 < 24; k0 += 12) {
          unsigned ra[12], rgt[12];
#pragma unroll
          for (int k = 0; k < 12; ++k) { const int i = rg + 4 * (k0 + k), tt = t0 - 30 + i; ra[k] = 0u; rgt[k] = 0u;
              if (i < nrow && tt >= 0) { ra[k] = *(const GAS1 unsigned*)(hb + C_GA); rgt[k] = *(const GAS1 unsigned*)(hb + C_GG); }
              hb += 4 * HLD; asm volatile("" : "+v"(hb)); }
#pragma unroll
          for (int k = 0; k < 12; ++k) { const int i = rg + 4 * (k0 + k), tt = t0 - 30 + i;
              if (i < nrow) { float v0, v1;
                  if (tt >= 0 || !smp) { v0 = bf2f(ra[k] & 0xffffu) * sigmoidf_(bf2f(rgt[k] & 0xffffu)); v1 = bf2f(ra[k] >> 16) * sigmoidf_(bf2f(rgt[k] >> 16)); }
                  else { const float* sp = sc + ((size_t)(l * 32 + b) * 30 + (30 + tt)) * 256 + ch2; v0 = sp[0]; v1 = sp[1]; }
                  *(LAS unsigned*)(cs + i * 256 + ch2) = pk2(v0, v1); } } } }
        LBAR();
        { const int ch = tid & 255, gsel = tid >> 8; float w[31]; const GAS1 float* cwp = (const GAS1 float*)(cw + ch); asm volatile("" : "+v"(cwp));
#pragma unroll
          for (int j = 0; j < 31; ++j) w[j] = cwp[j * 256];
          const float bias = cb[ch];
          for (int g = gsel; g < (ntok >> 3); g += 2) { float win[38];
#pragma unroll
              for (int i = 0; i < 38; ++i) win[i] = bf2f(cs[(8 * g + i) * 256 + ch]);
#pragma unroll
              for (int t = 0; t < 8; ++t) { float acc = bias;
#pragma unroll
                  for (int j = 0; j < 31; ++j) acc += w[j] * win[t + j];
                  os[(8 * g + t) * 256 + ch] = acc; } } }
        LBAR();
        for (int t = wave; t < ntok; t += 8) {
            float v[4]; float sm = 0.f;
#pragma unroll
            for (int i = 0; i < 4; ++i) { v[i] = os[t * 256 + lane + 64 * i]; sm += v[i]; }
            const float mu = wave_sum(sm) * (1.0f / 256.0f); float q = 0.f;
#pragma unroll
            for (int i = 0; i < 4; ++i) { const float d = v[i] - mu; q += d * d; }
            const float rstd = __builtin_amdgcn_rsqf(wave_sum(q) * (1.0f / 256.0f) + 1e-5f);
#pragma unroll
            for (int i = 0; i < 4; ++i) { const int ch = lane + 64 * i; const float y = (v[i] - mu) * rstd * lg[ch] + lb[ch]; MIX[(row0 + t) * 1024 + 768 + ch] = (bf16)f2bf(siluf_(y)); }
        }
        LBAR();
    }
}

__device__ __forceinline__ void g1_phase(const PP P, int l, LAS unsigned char* lds) {
    const int tid = P.tid, grp = tid >> 8, gt = tid & 255, G = P.G;
    const bf16* H = (const bf16*)(P.ws + WS_H);
    LAS float* qs = (LAS float*)(lds + grp * G1_GRP); LAS float* ks = qs + 64 * 65; LAS float* vs = ks + 64 * 65; LAS float* As = vs + 64 * 65;
    LAS float* Gs = As + 64 * 64; LAS float* bs = Gs + 64; LAS float* gs = bs + 64;
    const float* gcw = KIN(13) + (size_t)l * 4 * 768;
    const int rounds = (NGU + 2 * G - 1) / (2 * G);
    for (int it = 0; it < rounds; ++it) {
        const int u = (it * G + P.bid) * 2 + grp; const bool act = u < NGU;
        int b, h, ch, L; bool smp; size_t seq0;
        if (u < 2048) { const int bh = u >> 5; ch = u & 31; b = bh >> 2; h = bh & 3; L = 64; smp = false; seq0 = (size_t)b * 2048; }
        else { const int bh = u - 2048; b = bh >> 2; h = bh & 3; L = 16; smp = true; ch = 0; seq0 = (size_t)MP + b * 16; }
        unsigned char* ub = P.ws + WS_GSCR + (size_t)(act ? u : 0) * GUNIT;
        bf16* Wd = (bf16*)ub; bf16* QKd = (bf16*)(ub + 8192); bf16* KdT = (bf16*)(ub + 16384); bf16* QG = (bf16*)(ub + 24576); float* Uv = (float*)(ub + 32768);
#ifdef PROBE_SOLVE
        for (int pass_ = 0; pass_ < 2; ++pass_) {
#endif
        if (act) {
            if (gt < 192) { const int part = gt >> 6, cc = gt & 63, qcol = part * 256 + h * 64 + cc;
                const float w0 = gcw[qcol], w1 = gcw[768 + qcol], w2 = gcw[2 * 768 + qcol], w3 = gcw[3 * 768 + qcol];
                LAS float* dst = (part == 0 ? qs : (part == 1 ? ks : vs)) + cc;
                const bf16* hp = H + (seq0 + (size_t)ch * 64) * HLD + C_QKV + qcol;
                float x0 = 0.f, x1 = 0.f, x2 = 0.f;
                if (ch > 0) { x0 = bf2f(*(hp - 3 * HLD)); x1 = bf2f(*(hp - 2 * HLD)); x2 = bf2f(*(hp - HLD)); }
                else if (smp) { const float* sp = KIN(5) + (size_t)(l * 32 + b) * 3 * 768 + qcol; x0 = sp[0]; x1 = sp[768]; x2 = sp[2 * 768]; }
                const GAS1 bf16* pr = (const GAS1 bf16*)hp;
                if (L == 64) {
                  for (int tb = 0; tb < 64; tb += 32) { float xv[32];
#pragma unroll
                    for (int i = 0; i < 32; ++i) { xv[i] = bf2f(*pr); pr += HLD; asm volatile("" : "+v"(pr)); }
#pragma unroll
                    for (int i = 0; i < 32; ++i) { const float y = w0 * x0 + w1 * x1 + w2 * x2 + w3 * xv[i]; dst[(tb + i) * 65] = siluf_(y); x0 = x1; x1 = x2; x2 = xv[i]; } }
                } else { float xv[16];
#pragma unroll
                    for (int i = 0; i < 16; ++i) { xv[i] = bf2f(*pr); pr += HLD; asm volatile("" : "+v"(pr)); }
#pragma unroll
                    for (int i = 0; i < 16; ++i) { const float y = w0 * x0 + w1 * x1 + w2 * x2 + w3 * xv[i]; dst[i * 65] = siluf_(y); x0 = x1; x1 = x2; x2 = xv[i]; } }
                for (int t = L; t < 64; ++t) dst[t * 65] = 0.f;
            }
        }
        LBAR();
        if (act) {
            { const int rowid = gt >> 1, t = rowid & 63, part = rowid >> 6, half = gt & 1; LAS float* base = (part == 0 ? qs : ks) + t * 65 + half * 32; float ss = 0.f;
#pragma unroll
              for (int i = 0; i < 32; ++i) ss += base[i] * base[i];
              ss += dpp_f<0xB1>(ss); const float rinv = __builtin_amdgcn_rsqf(ss + 1e-6f) * (part == 0 ? 0.125f : 1.0f);
#pragma unroll
              for (int i = 0; i < 32; ++i) base[i] *= rinv; }
            if (gt < 64) { const int t = gt; float beta = 0.f, g = 0.f;
                if (t < L) { const bf16* hr = H + (seq0 + (size_t)ch * 64 + t) * HLD; const float braw = bf2f(hr[C_B + h]), araw = bf2f(hr[C_A + h]);
                    beta = sigmoidf_(braw); const float x = araw + KIN(15)[l * 4 + h]; const float sp = x > 20.f ? x : __logf(1.0f + __expf(x)); g = -__expf(KIN(14)[l * 4 + h]) * sp; }
                bs[t] = beta; gs[t] = g; }
        }
        LBAR();
#ifdef PROBE_SOLVE
        if (pass_ == 0) {
#endif
        if (act && gt == 0) { float gg[64];
#pragma unroll
            for (int t = 0; t < 64; ++t) gg[t] = gs[t];
            float run = 0.f;
#pragma unroll
            for (int t = 0; t < 64; ++t) { run += gg[t]; Gs[t] = run; } }
        LBAR();
        if (act) {
            { const int mi = gt >> 6, ln = gt & 63, fr = ln & 15, fq = ln >> 4;
              bf16x8 ak[2], aq[2];
#pragma unroll
              for (int kk = 0; kk < 2; ++kk) { const LAS float* pk = ks + (16 * mi + fr) * 65 + 32 * kk + fq * 8; const LAS float* pq = qs + (16 * mi + fr) * 65 + 32 * kk + fq * 8;
                  u32x4 wk, wq; wk.x = pk2(pk[0], pk[1]); wk.y = pk2(pk[2], pk[3]); wk.z = pk2(pk[4], pk[5]); wk.w = pk2(pk[6], pk[7]);
                  wq.x = pk2(pq[0], pq[1]); wq.y = pk2(pq[2], pq[3]); wq.z = pk2(pq[4], pq[5]); wq.w = pk2(pq[6], pq[7]);
                  ak[kk] = __builtin_bit_cast(bf16x8, wk); aq[kk] = __builtin_bit_cast(bf16x8, wq); }
#pragma unroll
              for (int nj = 0; nj < 4; ++nj) { f32x4 ckk = {0.f, 0.f, 0.f, 0.f}, cqk = {0.f, 0.f, 0.f, 0.f};
                  if (nj <= mi && 16 * mi < L) {
#pragma unroll
                      for (int kk = 0; kk < 2; ++kk) { const LAS float* pb = ks + (16 * nj + fr) * 65 + 32 * kk + fq * 8;
                          u32x4 wb; wb.x = pk2(pb[0], pb[1]); wb.y = pk2(pb[2], pb[3]); wb.z = pk2(pb[4], pb[5]); wb.w = pk2(pb[6], pb[7]);
                          const bf16x8 bfr = __builtin_bit_cast(bf16x8, wb); ckk = mfma16(ak[kk], bfr, ckk); cqk = mfma16(aq[kk], bfr, cqk); } }
                  const int jc = 16 * nj + fr; const float gj = Gs[jc];
#pragma unroll
                  for (int j = 0; j < 4; ++j) { const int i = 16 * mi + fq * 4 + j; const float dec = (i >= jc) ? __expf(Gs[i] - gj) : 0.f;
                      As[i * 64 + jc] = (i > jc) ? bs[i] * ckk[j] * dec : 0.f; QKd[i * 64 + jc] = (bf16)f2bf(cqk[j] * dec); } } }
        }
        LBAR();
        if (act) {
            const float glast = Gs[63];
            for (int e = gt; e < 4096; e += 256) { const int hi = e >> 6, lo = e & 63;
                KdT[e] = (bf16)f2bf(ks[lo * 65 + hi] * __expf(glast - Gs[lo]));
                QG[e] = (bf16)f2bf(qs[hi * 65 + lo] * __expf(Gs[hi])); }
            if (gt == 0) *(float*)(ub + 49152) = __expf(glast);
        }
        LBAR();
#ifdef PROBE_SOLVE
        }
#endif
        if (act) {
            for (int e = gt; e < 8192; e += 256) { const int i = e >> 7, c = e & 127; LAS float* p = ((c < 64) ? ks : vs) + i * 65 + (c & 63);
                *p = *p * bs[i] * ((c < 64) ? __expf(Gs[i]) : 1.0f); }
        }
        LBAR();
#pragma unroll 1
        for (int R = 0; R < 4; ++R) {
            if (act && R > 0 && 16 * R < L) {
                const int wv = gt >> 6, ln = gt & 63, fr = ln & 15, fq = ln >> 4, nkk = (16 * R + 31) >> 5;
                bf16x8 af[2];
#pragma unroll
                for (int kk = 0; kk < 2; ++kk) { u32x4 w = {0u, 0u, 0u, 0u};
                    if (kk < nkk && 32 * kk + fq * 8 < 16 * R) { const LAS float* pa = As + (16 * R + fr) * 64 + 32 * kk + fq * 8; const f32x4 a0 = *(const LAS f32x4*)pa, a1 = *(const LAS f32x4*)(pa + 4);
                        w.x = pk2(a0[0], a0[1]); w.y = pk2(a0[2], a0[3]); w.z = pk2(a1[0], a1[1]); w.w = pk2(a1[2], a1[3]); }
                    af[kk] = __builtin_bit_cast(bf16x8, w); }
#pragma unroll
                for (int t = 0; t < 2; ++t) { const int nt = 2 * wv + t; LAS float* xb = ((nt < 4) ? ks : vs) + 16 * (nt & 3) + fr;
                    f32x4 acc = {0.f, 0.f, 0.f, 0.f};
#pragma unroll
                    for (int kk = 0; kk < 2; ++kk) if (kk < nkk) { const LAS float* pb = xb + (32 * kk + fq * 8) * 65;
                        u32x4 w; w.x = pk2(pb[0], pb[65]); w.y = pk2(pb[130], pb[195]); w.z = pk2(pb[260], pb[325]); w.w = pk2(pb[390], pb[455]);
                        acc = mfma16(af[kk], __builtin_bit_cast(bf16x8, w), acc); }
#pragma unroll
                    for (int j = 0; j < 4; ++j) xb[(16 * R + fq * 4 + j) * 65] -= acc[j]; }
            }
            LBAR();
            if (act && gt < 128) { const int c = gt; LAS float* col = ((c < 64) ? ks : vs) + (c & 63) + (16 * R) * 65; const LAS float* Dg = As + (16 * R) * 64 + 16 * R;
                float x[16];
                if (16 * R >= L) {
#pragma unroll
                    for (int a = 0; a < 16; ++a) x[a] = 0.f;
                } else {
#pragma unroll
                for (int a = 0; a < 16; ++a) { float v = col[a * 65];
                    f32x4 d[4];
#pragma unroll
                    for (int q4 = 0; q4 < 4; ++q4) if (4 * q4 < a) d[q4] = *(const LAS f32x4*)(Dg + a * 64 + 4 * q4);
#pragma unroll
                    for (int q = 0; q < a; ++q) v -= d[q >> 2][q & 3] * x[q];
                    x[a] = v; if ((a & 3) == 3) __builtin_amdgcn_sched_barrier(0); } }
#pragma unroll
                for (int a = 0; a < 16; ++a) { col[a * 65] = x[a];
                    if (c < 64) Wd[(16 * R + a) * 64 + c] = (bf16)f2bf(x[a]); else Uv[(16 * R + a) * 64 + (c - 64)] = x[a]; }
            }
            LBAR();
        }
#ifdef PROBE_SOLVE
        }
#endif
    }
}

__device__ __forceinline__ bf16x8 ldA2(const bf16* Mx, int row, int kk, int fq) {
    const bf16* p = Mx + row * 64 + 32 * kk + fq * 4; const s16x4 a = *(const s16x4*)p, b = *(const s16x4*)(p + 16);
    bf16x8 r; r[0] = a[0]; r[1] = a[1]; r[2] = a[2]; r[3] = a[3]; r[4] = b[0]; r[5] = b[1]; r[6] = b[2]; r[7] = b[3]; return r;
}
__device__ __forceinline__ void split8(const f32x4& lo4, const f32x4& hi4, bf16x8& h, bf16x8& lw) {
    u32x4 hw; hw.x = pk2(lo4[0], lo4[1]); hw.y = pk2(lo4[2], lo4[3]); hw.z = pk2(hi4[0], hi4[1]); hw.w = pk2(hi4[2], hi4[3]);
    h = __builtin_bit_cast(bf16x8, hw);
    if (GDN_SPLIT) {
        u32x4 lo; lo.x = pk2(lo4[0] - bf2f(hw.x & 0xffffu), lo4[1] - __builtin_bit_cast(float, hw.x & 0xffff0000u)); lo.y = pk2(lo4[2] - bf2f(hw.y & 0xffffu), lo4[3] - __builtin_bit_cast(float, hw.y & 0xffff0000u));
        lo.z = pk2(hi4[0] - bf2f(hw.z & 0xffffu), hi4[1] - __builtin_bit_cast(float, hw.z & 0xffff0000u)); lo.w = pk2(hi4[2] - bf2f(hw.w & 0xffffu), hi4[3] - __builtin_bit_cast(float, hw.w & 0xffff0000u));
        lw = __builtin_bit_cast(bf16x8, lo);
    } else lw = h;
}
constexpr int G2_MAT = 9216, G2_UV = 4 * G2_MAT, G2_Z = G2_UV + 64 * 272, G2_GAM = G2_Z + 9216, G2_BUF = G2_GAM + 16, G2_RED = 2 * G2_BUF;
static_assert(G2_RED + 2048 <= LDS_BYTES, "g2 lds");
__device__ __forceinline__ bf16x8 ldA2s(const LAS unsigned char* mat, int row, int kk, int fq) {
    const LAS unsigned char* p = mat + row * 144 + 64 * kk + fq * 8; const s16x4 a = *(const LAS s16x4*)p, b = *(const LAS s16x4*)(p + 32);
    bf16x8 r; r[0] = a[0]; r[1] = a[1]; r[2] = a[2]; r[3] = a[3]; r[4] = b[0]; r[5] = b[1]; r[6] = b[2]; r[7] = b[3]; return r;
}
__device__ __forceinline__ void g2_stage(LAS unsigned char* buf, const unsigned char* ub, const bf16* zsrc  , int ht, int nthr) {
    for (int c = ht; c < 2048; c += nthr) { const int mat = c >> 9, w = c & 511, row = w >> 3, seg = w & 7;
        *(LAS u32x4*)(buf + mat * G2_MAT + row * 144 + seg * 16) = *(const u32x4*)(ub + mat * 8192 + row * 128 + seg * 16); }
    for (int c = ht; c < 1024; c += nthr) { const int row = c >> 4, seg = c & 15;
        *(LAS u32x4*)(buf + G2_UV + row * 272 + seg * 16) = *(const u32x4*)(ub + 32768 + row * 256 + seg * 16); }
    for (int c = ht; c < 512; c += nthr) { const int row = c >> 3, seg = c & 7;
        *(LAS u32x4*)(buf + G2_Z + row * 144 + seg * 16) = *(const u32x4*)((const unsigned char*)(zsrc + (size_t)row * HLD) + seg * 16); }
    if (ht == 0) *(LAS float*)(buf + G2_GAM) = *(const float*)(ub + 49152);
}
__device__ __forceinline__ void g2_load(u32x4 (&r)[14], float& gam, const unsigned char* ub, const bf16* zsrc, int ht) {
    const unsigned go = 16u * ht, gz = (ht >> 3) * (HLD * 2) + (ht & 7) * 16;
#pragma unroll
    for (int i = 0; i < 8; ++i) r[i] = *(const u32x4*)(ub + i * 4096 + go);
#pragma unroll
    for (int i = 0; i < 4; ++i) r[8 + i] = *(const u32x4*)(ub + 32768 + i * 4096 + go);
#pragma unroll
    for (int i = 0; i < 2; ++i) r[12 + i] = *(const u32x4*)((const unsigned char*)zsrc + (size_t)i * 32 * HLD * 2 + gz);
    gam = *(const float*)(ub + 49152);
}
__device__ __forceinline__ void g2_store(LAS unsigned char* buf, const u32x4 (&r)[14], float gam, int ht) {
    LAS unsigned char* lm = buf + (ht >> 3) * 144 + (ht & 7) * 16; LAS unsigned char* lu = buf + G2_UV + (ht >> 4) * 272 + (ht & 15) * 16;
#pragma unroll
    for (int i = 0; i < 8; ++i) *(LAS u32x4*)(lm + (i >> 1) * G2_MAT + (i & 1) * 32 * 144) = r[i];
#pragma unroll
    for (int i = 0; i < 4; ++i) *(LAS u32x4*)(lu + i * 16 * 272) = r[8 + i];
#pragma unroll
    for (int i = 0; i < 2; ++i) *(LAS u32x4*)(lm + G2_Z + i * 32 * 144) = r[12 + i];
    if (ht == 0) *(LAS float*)(buf + G2_GAM) = gam;
}
#define G2_BAR() asm volatile("s_waitcnt lgkmcnt(0)\n\ts_barrier" ::: "memory")
__device__ __forceinline__ void g2_phase(const PP P, int l, LAS unsigned char* lds) {
    const int tid = P.tid, lane = tid & 63, wave = tid >> 6, fr = lane & 15, fq = lane >> 4, G = P.G;
    LAS float* red = (LAS float*)(lds + G2_RED);
    const bf16* H = (const bf16*)(P.ws + WS_H); bf16* MIX = (bf16*)(P.ws + WS_MIX);
    for (int u = P.bid; u < 192; u += G) {
        const bool smp = u >= 64; const int bh = smp ? u - 64 : u, b = bh >> 2, h = bh & 3, nch = smp ? 1 : 32, L = smp ? 16 : 64;
        const size_t seq0 = smp ? (size_t)MP + b * 16 : (size_t)b * 2048; const int gu0 = smp ? 2048 + bh : bh * 32;
        const bool act = wave < 4; const int dv = 16 * (wave & 3) + fr;
        const unsigned char* gs0 = P.ws + WS_GSCR + (size_t)gu0 * GUNIT; const bf16* z0 = H + seq0 * HLD + C_Z + h * 64;
        f32x4 S[4];
#pragma unroll
        for (int m = 0; m < 4; ++m)
#pragma unroll
            for (int j = 0; j < 4; ++j) S[m][j] = (smp && act) ? KIN(4)[(((size_t)(l * 32 + b) * 4 + h) * 64 + (16 * m + fq * 4 + j)) * 64 + dv] : 0.f;
        const float gnw = KIN(16)[l * 64 + dv];
        g2_stage(lds, gs0, z0, tid, 512);
        u32x4 hr_[14]; float hgam = 0.f;
#pragma unroll
        for (int i = 0; i < 14; ++i) hr_[i] = (u32x4){0u, 0u, 0u, 0u};
        if (!act && nch > 1) g2_load(hr_, hgam, gs0 + GUNIT, z0 + (size_t)64 * HLD, tid - 256);
        G2_BAR();
        for (int n = 0; n < nch; ++n) {
            LAS unsigned char* buf = lds + (n & 1) * G2_BUF;
            f32x4 O[4]; float zr[4][4];
            if (!act) {
                if (n + 1 < nch) g2_store(lds + ((n + 1) & 1) * G2_BUF, hr_, hgam, tid - 256);
                if (n + 2 < nch) g2_load(hr_, hgam, gs0 + (size_t)(n + 2) * GUNIT, z0 + (size_t)(n + 2) * 64 * HLD, tid - 256);
            } else {
                bf16x8 Sh[2], Sl[2]; split8(S[0], S[1], Sh[0], Sl[0]); split8(S[2], S[3], Sh[1], Sl[1]);
                f32x4 U[4];
#pragma unroll
                for (int mi = 0; mi < 4; ++mi) { f32x4 acc = {0.f, 0.f, 0.f, 0.f};
#pragma unroll
                    for (int kk = 0; kk < 2; ++kk) { const bf16x8 a = ldA2s(buf, 16 * mi + fr, kk, fq); acc = mfma16(a, Sh[kk], acc); if (GDN_SPLIT) acc = mfma16(a, Sl[kk], acc); }
#pragma unroll
                    for (int j = 0; j < 4; ++j) { const int i = 16 * mi + fq * 4 + j; U[mi][j] = *(const LAS float*)(buf + G2_UV + i * 272 + dv * 4) - acc[j];
                        zr[mi][j] = bf2f(*(const LAS bf16*)(buf + G2_Z + i * 144 + dv * 2)); } }
                bf16x8 Uh[2], Ul[2]; split8(U[0], U[1], Uh[0], Ul[0]); split8(U[2], U[3], Uh[1], Ul[1]);
#pragma unroll
                for (int mi = 0; mi < 4; ++mi) { f32x4 acc = {0.f, 0.f, 0.f, 0.f};
#pragma unroll
                    for (int kk = 0; kk < 2; ++kk) { const bf16x8 a = ldA2s(buf + 3 * G2_MAT, 16 * mi + fr, kk, fq); acc = mfma16(a, Sh[kk], acc); if (GDN_SPLIT) acc = mfma16(a, Sl[kk], acc);
                        const bf16x8 a2 = ldA2s(buf + G2_MAT, 16 * mi + fr, kk, fq); acc = mfma16(a2, Uh[kk], acc); if (GDN_SPLIT) acc = mfma16(a2, Ul[kk], acc); }
                    O[mi] = acc; }
                const float gamL = *(const LAS float*)(buf + G2_GAM);
#pragma unroll
                for (int m = 0; m < 4; ++m) { f32x4 acc = S[m] * gamL;
#pragma unroll
                    for (int kk = 0; kk < 2; ++kk) { const bf16x8 a = ldA2s(buf + 2 * G2_MAT, 16 * m + fr, kk, fq); acc = mfma16(a, Uh[kk], acc); if (GDN_SPLIT) acc = mfma16(a, Ul[kk], acc); }
                    S[m] = acc; }
#pragma unroll
                for (int mi = 0; mi < 4; ++mi)
#pragma unroll
                    for (int j = 0; j < 4; ++j) { const float s = row16_sum(O[mi][j] * O[mi][j]);
                        if (fr == 0) red[(n & 1) * 256 + wave * 64 + 16 * mi + fq * 4 + j] = s; }
            }
            G2_BAR();
            if (act) {
#pragma unroll
                for (int mi = 0; mi < 4; ++mi)
#pragma unroll
                    for (int j = 0; j < 4; ++j) { const int i = 16 * mi + fq * 4 + j; LAS float* rp = red + (n & 1) * 256 + i;
                        const float tot = rp[0] + rp[64] + rp[128] + rp[192]; const float rinv = __builtin_amdgcn_rsqf(tot * (1.0f / 64.0f) + 1e-6f);
                        if (i < L) { const size_t row = seq0 + (size_t)n * 64 + i;
                            MIX[row * 1024 + 512 + h * 64 + dv] = (bf16)f2bf(O[mi][j] * rinv * gnw * siluf_(zr[mi][j])); } }
            }
        }
        if (act) { float* so = smp ? P.out + O_GDNS + ((size_t)(l * 32 + b) * 4 + h) * 4096 : P.out + O_GDNP + ((size_t)(l * 16 + b) * 4 + h) * 4096;
#pragma unroll
            for (int m = 0; m < 4; ++m)
#pragma unroll
                for (int j = 0; j < 4; ++j) so[(16 * m + fq * 4 + j) * 64 + dv] = S[m][j]; }
        __syncthreads();
    }
}

constexpr int AT_KROW = 208, AT_VROW = 144, AT_V = 64 * AT_KROW, AT_STAGE = AT_V + 64 * AT_VROW, AT_COMB = 2 * AT_STAGE;
static_assert(AT_COMB + 8 * 64 * 18 * 4 <= LDS_BYTES, "attn lds");
__device__ __forceinline__ void attn_prompt_unit(const PP P, LAS unsigned char* lds, int b, int h, int qt) {
    const int tid = P.tid, lane = tid & 63, wave = tid >> 6, fr = lane & 15, fq = lane >> 4;
    const bf16* Q = (const bf16*)(P.ws + WS_XB); const bf16* KN = (const bf16*)(P.ws + WS_KN); const bf16* VT = (const bf16*)(P.ws + WS_VT);
    const bf16* KPEB = (const bf16*)(P.ws + WS_KPEB); bf16* MIX = (bf16*)(P.ws + WS_MIX);
    const int qrow0 = b * 2048 + 256 * qt + 32 * wave, keybase = b * 2048;
    const int nt_blk = 4 * qt + 4, nt_w = 4 * qt + (wave >> 1) + 1;
    bf16x8 Qb[2][3];
#pragma unroll
    for (int g = 0; g < 2; ++g)
#pragma unroll
        for (int ks = 0; ks < 3; ++ks) Qb[g][ks] = *(const bf16x8*)(Q + (size_t)(qrow0 + 16 * g + fr) * 768 + h * 96 + 32 * ks + fq * 8);
    float m[2] = {-INFINITY, -INFINITY}, lsum[2] = {0.f, 0.f}; f32x4 O[2][4];
#pragma unroll
    for (int g = 0; g < 2; ++g)
#pragma unroll
        for (int nt = 0; nt < 4; ++nt) O[g][nt] = (f32x4){0.f, 0.f, 0.f, 0.f};
    const int r8 = tid >> 3, s8 = tid & 7, r4 = (tid & 255) >> 2, s4 = tid & 3;
    const bf16* gk = KN + (size_t)(keybase + r8) * 512 + h * 64 + s8 * 8;
    const bf16* gp = KPEB + (size_t)(keybase + r4) * 32 + s4 * 8;
    const bf16* gv = VT + (size_t)(h * 64 + r8) * NK + keybase + s8 * 8;
    const int lk = r8 * AT_KROW + s8 * 16, lp = r4 * AT_KROW + 128 + s4 * 16, lv = AT_V + r8 * AT_VROW + s8 * 16;
    u32x4 rk = *(const u32x4*)gk, rv = *(const u32x4*)gv, rp = {0u, 0u, 0u, 0u}; if (tid < 256) rp = *(const u32x4*)gp;
    *(LAS u32x4*)(lds + lk) = rk; *(LAS u32x4*)(lds + lv) = rv; if (tid < 256) *(LAS u32x4*)(lds + lp) = rp;
    __syncthreads();
    for (int kt = 0; kt < nt_blk; ++kt) {
        const bool more = kt + 1 < nt_blk;
        if (more) { rk = *(const u32x4*)(gk + (size_t)(kt + 1) * 64 * 512); rv = *(const u32x4*)(gv + (kt + 1) * 64); if (tid < 256) rp = *(const u32x4*)(gp + (size_t)(kt + 1) * 64 * 32); }
        if (kt < nt_w) {
            const LAS unsigned char* kb = lds + (kt & 1) * AT_STAGE; const LAS unsigned char* vb = kb + AT_V;
            f32x4 s[2][4];
#pragma unroll
            for (int sb = 0; sb < 4; ++sb) { s[0][sb] = (f32x4){0.f, 0.f, 0.f, 0.f}; s[1][sb] = (f32x4){0.f, 0.f, 0.f, 0.f};
#pragma unroll
                for (int ks = 0; ks < 3; ++ks) { const bf16x8 kf = *(const LAS bf16x8*)(kb + (16 * sb + fr) * AT_KROW + ks * 64 + fq * 16);
                    s[0][sb] = mfma16(kf, Qb[0][ks], s[0][sb]); s[1][sb] = mfma16(kf, Qb[1][ks], s[1][sb]); } }
            bf16x8 Pb[2][2];
#pragma unroll
            for (int g = 0; g < 2; ++g) {
                float mx = -INFINITY;
#pragma unroll
                for (int sb = 0; sb < 4; ++sb) mx = fmaxf(mx, fmaxf(fmaxf(s[g][sb][0], s[g][sb][1]), fmaxf(s[g][sb][2], s[g][sb][3])));
                mx = fmaxf(mx, xor16_get(mx)); mx = xor32_max(mx);
                const float mnew = fmaxf(m[g], mx), alpha = __builtin_amdgcn_exp2f(m[g] - mnew); m[g] = mnew;
                float ps = 0.f; float p[4][4];
#pragma unroll
                for (int sb = 0; sb < 4; ++sb)
#pragma unroll
                    for (int j = 0; j < 4; ++j) { p[sb][j] = __builtin_amdgcn_exp2f(s[g][sb][j] - mnew); ps += p[sb][j]; }
                lsum[g] = lsum[g] * alpha + ps;
#pragma unroll
                for (int kk = 0; kk < 2; ++kk) { u32x4 pw; pw.x = pk2(p[2 * kk][0], p[2 * kk][1]); pw.y = pk2(p[2 * kk][2], p[2 * kk][3]); pw.z = pk2(p[2 * kk + 1][0], p[2 * kk + 1][1]); pw.w = pk2(p[2 * kk + 1][2], p[2 * kk + 1][3]);
                    Pb[g][kk] = __builtin_bit_cast(bf16x8, pw); }
#pragma unroll
                for (int nt = 0; nt < 4; ++nt) O[g][nt] = O[g][nt] * alpha;
            }
#pragma unroll
            for (int nt = 0; nt < 4; ++nt)
#pragma unroll
                for (int kk = 0; kk < 2; ++kk) { const LAS unsigned char* vp = vb + (16 * nt + fr) * AT_VROW + kk * 64 + fq * 8;
                    const s16x4 a = *(const LAS s16x4*)vp, c = *(const LAS s16x4*)(vp + 32);
                    bf16x8 vf; vf[0] = a[0]; vf[1] = a[1]; vf[2] = a[2]; vf[3] = a[3]; vf[4] = c[0]; vf[5] = c[1]; vf[6] = c[2]; vf[7] = c[3];
                    O[0][nt] = mfma16(vf, Pb[0][kk], O[0][nt]); O[1][nt] = mfma16(vf, Pb[1][kk], O[1][nt]); }
        }
        if (more) { LAS unsigned char* nb = lds + ((kt + 1) & 1) * AT_STAGE; *(LAS u32x4*)(nb + lk) = rk; *(LAS u32x4*)(nb + lv) = rv; if (tid < 256) *(LAS u32x4*)(nb + lp) = rp; }
        __syncthreads();
    }
#pragma unroll
    for (int g = 0; g < 2; ++g) { float lt = lsum[g]; lt += xor16_get(lt); lt = xor32_sum(lt); const float inv = __builtin_amdgcn_rcpf(lt);
#pragma unroll
        for (int nt = 0; nt < 4; ++nt) { u32x2 w; w.x = pk2(O[g][nt][0] * inv, O[g][nt][1] * inv); w.y = pk2(O[g][nt][2] * inv, O[g][nt][3] * inv);
            *(u32x2*)(MIX + (size_t)(qrow0 + 16 * g + fr) * 1024 + h * 64 + 16 * nt + fq * 4) = w; } }
}
__device__ __forceinline__ void attn_sample_unit(const PP P, LAS unsigned char* lds, int b, int h) {
    const int tid = P.tid, lane = tid & 63, wave = tid >> 6, fr = lane & 15, fq = lane >> 4;
    const bf16* Q = (const bf16*)(P.ws + WS_XB); const bf16* KN = (const bf16*)(P.ws + WS_KN); const bf16* VT = (const bf16*)(P.ws + WS_VT);
    const bf16* KPEB = (const bf16*)(P.ws + WS_KPEB); bf16* MIX = (bf16*)(P.ws + WS_MIX);
    const int qrow0 = MP + b * 16, keybase = MP, nkeys = SKS;
    const bf16* qp = Q + (size_t)(qrow0 + fr) * 768 + h * 96 + fq * 8;
    bf16x8 Qb[3];
#pragma unroll
    for (int ks = 0; ks < 3; ++ks) Qb[ks] = *(const bf16x8*)(qp + 32 * ks);
    float m = -INFINITY, lsum = 0.f; f32x4 O[4];
#pragma unroll
    for (int nt = 0; nt < 4; ++nt) O[nt] = (f32x4){0.f, 0.f, 0.f, 0.f};
    const int nblk = (nkeys + 31) >> 5, kb0 = (wave * nblk) >> 3, kb1 = ((wave + 1) * nblk) >> 3;
    for (int kb = kb0; kb < kb1; ++kb) {
        f32x4 s[2]; int kof[2];
#pragma unroll
        for (int sub = 0; sub < 2; ++sub) { const int key0 = kb * 32 + sub * 16; const bool valid = key0 < nkeys; kof[sub] = (valid && key0 >= 2048) ? 65536 + b * 16 + (key0 - 2048) : b * 2048 + (valid ? key0 : 0);
            const size_t kr = (size_t)keybase + kof[sub] + fr;
            const bf16x8 a0 = *(const bf16x8*)(KN + kr * 512 + h * 64 + fq * 8), a1 = *(const bf16x8*)(KN + kr * 512 + h * 64 + 32 + fq * 8), a2 = *(const bf16x8*)(KPEB + kr * 32 + fq * 8);
            f32x4 acc = {0.f, 0.f, 0.f, 0.f}; acc = mfma16(a0, Qb[0], acc); acc = mfma16(a1, Qb[1], acc); acc = mfma16(a2, Qb[2], acc);
            if (!valid) acc = (f32x4){-INFINITY, -INFINITY, -INFINITY, -INFINITY};
            s[sub] = acc; }
        float mx = fmaxf(fmaxf(fmaxf(s[0][0], s[0][1]), fmaxf(s[0][2], s[0][3])), fmaxf(fmaxf(s[1][0], s[1][1]), fmaxf(s[1][2], s[1][3])));
        mx = fmaxf(mx, xor16_get(mx)); mx = xor32_max(mx);
        const float mnew = fmaxf(m, mx); const float alpha = __builtin_amdgcn_exp2f(m - mnew); m = mnew;
        float p[8]; float ps = 0.f;
#pragma unroll
        for (int j = 0; j < 4; ++j) { p[j] = __builtin_amdgcn_exp2f(s[0][j] - mnew); p[4 + j] = __builtin_amdgcn_exp2f(s[1][j] - mnew); ps += p[j] + p[4 + j]; }
        lsum = lsum * alpha + ps;
        u32x4 pw; pw.x = pk2(p[0], p[1]); pw.y = pk2(p[2], p[3]); pw.z = pk2(p[4], p[5]); pw.w = pk2(p[6], p[7]);
        const bf16x8 Pb = __builtin_bit_cast(bf16x8, pw);
#pragma unroll
        for (int nt = 0; nt < 4; ++nt) { const bf16* vrow = VT + (size_t)(h * 64 + 16 * nt + fr) * NK + keybase + fq * 4;
            const s16x4 a = *(const s16x4*)(vrow + kof[0]), c = *(const s16x4*)(vrow + kof[1]);
            bf16x8 va; va[0] = a[0]; va[1] = a[1]; va[2] = a[2]; va[3] = a[3]; va[4] = c[0]; va[5] = c[1]; va[6] = c[2]; va[7] = c[3];
            O[nt] = mfma16(va, Pb, O[nt] * alpha); }
    }
    float lt = lsum; lt += xor16_get(lt); lt = xor32_sum(lt);
    LAS float* cb = (LAS float*)(lds + AT_COMB) + (wave * 64 + lane) * 18;
#pragma unroll
    for (int nt = 0; nt < 4; ++nt)
#pragma unroll
        for (int j = 0; j < 4; ++j) cb[nt * 4 + j] = O[nt][j];
    cb[16] = m; cb[17] = lt;
    __syncthreads();
    if (wave == 0) {
        float mm = -INFINITY;
#pragma unroll
        for (int w = 0; w < 8; ++w) mm = fmaxf(mm, ((LAS float*)(lds + AT_COMB))[(w * 64 + lane) * 18 + 16]);
        float L = 0.f; float acc[16];
#pragma unroll
        for (int i = 0; i < 16; ++i) acc[i] = 0.f;
#pragma unroll
        for (int w = 0; w < 8; ++w) { const LAS float* pp = (LAS float*)(lds + AT_COMB) + (w * 64 + lane) * 18; const float sc = __builtin_amdgcn_exp2f(pp[16] - mm); L += pp[17] * sc;
#pragma unroll
            for (int i = 0; i < 16; ++i) acc[i] += pp[i] * sc; }
        const float inv = __builtin_amdgcn_rcpf(L);
#pragma unroll
        for (int nt = 0; nt < 4; ++nt) { u32x2 w; w.x = pk2(acc[nt * 4] * inv, acc[nt * 4 + 1] * inv); w.y = pk2(acc[nt * 4 + 2] * inv, acc[nt * 4 + 3] * inv);
            *(u32x2*)(MIX + (size_t)(qrow0 + fr) * 1024 + h * 64 + 16 * nt + fq * 4) = w; }
    }
    __syncthreads();
}
__device__ __forceinline__ void attn_phase(const PP P, LAS unsigned char* lds) {
    const int G = P.G;
    for (int u = P.bid; u < 256 + 1024; u += G) {
        if (u < 256) { attn_sample_unit(P, lds, u >> 3, u & 7); }
        else { const int v = u - 256, bh = v & 127, half = (v >> 7) & 1, k = v >> 8;
            const int qt = (k == 0) ? 7 - half : (k == 1) ? half : (k == 2) ? 5 - half : 2 + half;
            attn_prompt_unit(P, lds, bh >> 3, bh & 7, qt); }
    }
}

__device__ __forceinline__ void ln_phase(const PP P, const float* g, const float* bta) {
    const int tid = P.tid, lane = tid & 63, wave = tid >> 6, G = P.G;
    float* X = P.out; bf16* XB = (bf16*)(P.ws + WS_XB);
    for (int row = P.bid * 8 + wave; row < MT; row += G * 8) {
        float* p = X + (size_t)row * 1024; f32x4 v[4]; float s = 0.f;
#pragma unroll
        for (int i = 0; i < 4; ++i) { v[i] = *(const f32x4*)(p + 256 * i + lane * 4); s += (v[i][0] + v[i][1]) + (v[i][2] + v[i][3]); }
        const float mu = wave_sum(s) * (1.0f / 1024.0f); float q = 0.f;
#pragma unroll
        for (int i = 0; i < 4; ++i) { const f32x4 d = v[i] - mu; q += (d[0] * d[0] + d[1] * d[1]) + (d[2] * d[2] + d[3] * d[3]); }
        const float rstd = __builtin_amdgcn_rsqf(wave_sum(q) * (1.0f / 1024.0f) + 1e-5f);
#pragma unroll
        for (int i = 0; i < 4; ++i) { const int col = 256 * i + lane * 4; const f32x4 gg = *(const f32x4*)(g + col), bb = *(const f32x4*)(bta + col);
            const f32x4 y = (v[i] - mu) * rstd * gg + bb; *(f32x4*)(p + col) = y;
            u32x2 w; w.x = pk2(y[0], y[1]); w.y = pk2(y[2], y[3]); *(u32x2*)(XB + (size_t)row * 1024 + col) = w; }
    }
}

__device__ __forceinline__ void sample_gemm_res(const PP P, LAS unsigned char* lds, const bf16* A  , const bf16* Bt, int K, const float* xin  , float* Xs  ) {
    const int tid = P.tid, lane = tid & 63, wave = tid >> 6, fr = lane & 15, fq = lane >> 4;
    LAS float* part = (LAS float*)lds;
    for (int t = P.bid; t < 256; t += P.G) {
        const int r0 = (t >> 4) * 32, c0 = (t & 15) * 64, kw = K >> 3, kb = wave * kw;
        f32x4 acc[2][4];
#pragma unroll
        for (int a = 0; a < 2; ++a)
#pragma unroll
            for (int n = 0; n < 4; ++n) acc[a][n] = (f32x4){0.f, 0.f, 0.f, 0.f};
        const bf16* ap = A + (size_t)(r0 + fr) * K + kb + fq * 8; const bf16* bp = Bt + (size_t)(c0 + fr) * K + kb + fq * 8;
#pragma unroll 2
        for (int k0 = 0; k0 < kw; k0 += 32) {
            bf16x8 af[2], bf_[4];
#pragma unroll
            for (int a = 0; a < 2; ++a) af[a] = *(const bf16x8*)(ap + (size_t)(16 * a) * K + k0);
#pragma unroll
            for (int n = 0; n < 4; ++n) bf_[n] = *(const bf16x8*)(bp + (size_t)(16 * n) * K + k0);
#pragma unroll
            for (int a = 0; a < 2; ++a)
#pragma unroll
                for (int n = 0; n < 4; ++n) acc[a][n] = mfma16(af[a], bf_[n], acc[a][n]);
        }
        LAS float* mp = part + (wave * 64 + lane) * 33;
#pragma unroll
        for (int a = 0; a < 2; ++a)
#pragma unroll
            for (int n = 0; n < 4; ++n)
#pragma unroll
                for (int j = 0; j < 4; ++j) mp[(a * 4 + n) * 4 + j] = acc[a][n][j];
        __syncthreads();
        { const int grp = wave;
          float sum[4] = {0.f, 0.f, 0.f, 0.f};
#pragma unroll
          for (int w = 0; w < 8; ++w)
#pragma unroll
              for (int j = 0; j < 4; ++j) sum[j] += part[(w * 64 + lane) * 33 + 4 * grp + j];
          const int a = grp >> 2, n = grp & 3, col = c0 + 16 * n + fr;
#pragma unroll
          for (int j = 0; j < 4; ++j) { const int row = r0 + 16 * a + fq * 4 + j; Xs[(size_t)row * 1024 + col] = DN_ALPHA * xin[(size_t)row * 1024 + col] + sum[j]; } }
        __syncthreads();
    }
}

#define GB_LD(p) __hip_atomic_load((p), __ATOMIC_RELAXED, __HIP_MEMORY_SCOPE_AGENT)
#define GB_ADD(p) __hip_atomic_fetch_add((p), 1u, __ATOMIC_RELAXED, __HIP_MEMORY_SCOPE_AGENT)
#define GB_ST(p, v) __hip_atomic_store((p), (v), __ATOMIC_RELAXED, __HIP_MEMORY_SCOPE_AGENT)
__device__ __forceinline__ void fast_grid_bar(unsigned* bar, unsigned k  , int tid, int bid, int G) {
    asm volatile("s_waitcnt vmcnt(0)" ::: "memory");
    __syncthreads();
    if (tid == 0) {
        const unsigned ng = (G < 8) ? (unsigned)G : 8u, g = (unsigned)bid % ng, gsize = ((unsigned)G - g + ng - 1u) / ng;
        unsigned* sub = bar + 64 * g; unsigned* gen = bar + 64 * (8 + g); unsigned* top = bar + 64 * 16; unsigned* topgen = bar + 64 * 17;
        __builtin_amdgcn_fence(__ATOMIC_RELEASE, "agent");
        asm volatile("s_waitcnt vmcnt(0)" ::: "memory");
        const unsigned old = GB_ADD(sub); unsigned sp = 0;
        if (old + 1u == k * gsize) { const unsigned o2 = GB_ADD(top); if (o2 + 1u == k * ng) GB_ST(topgen, k); }
        while (GB_LD(topgen) < k) { __builtin_amdgcn_s_sleep(1); if (++sp > (1u << 24)) break; }
        __builtin_amdgcn_fence(__ATOMIC_ACQUIRE, "agent");
        asm volatile("s_waitcnt vmcnt(0)" ::: "memory");
    }
    __syncthreads();
}

__global__ void __launch_bounds__(512) mega(Params P) {
    extern __shared__ __attribute__((aligned(16))) unsigned char lds_raw[];
    LAS unsigned char* lds = (LAS unsigned char*)lds_raw;
    cg::grid_group grid = cg::this_grid();
    const int lo_ = P.lo, hi_ = P.hi; const int wave_s = __builtin_amdgcn_readfirstlane((int)(threadIdx.x >> 6));
    for (int step = lo_; step < hi_; ++step) {
        PP pp; pp.ws = KWS(); pp.out = KOUT(); unsigned char* ws = pp.ws;
        { int t_, b_ = blockIdx.x, g_ = gridDim.x; asm volatile("v_mbcnt_lo_u32_b32 %0, -1, 0\n\tv_mbcnt_hi_u32_b32 %0, -1, %0\n\tv_lshl_add_u32 %0, %3, 6, %0" : "=&v"(t_), "+s"(b_), "+s"(g_) : "s"(wave_s)); pp.tid = t_; pp.bid = b_; pp.G = g_; }
        int l = 0, kind = 0;
        if (REPK == 0) { if (step > 0) { l = (step - 1) / 10; kind = 1 + (step - 1) % 10; } }
        else if (step > 0) { l = (step - 1) / 11; const int kidx = (step - 1) % 11; kind = (kidx < REPK) ? kidx + 1 : kidx; if (kind == 6 && l == 1 && kidx == REPK) kind = 11; }
        const bf16* WB = (const bf16*)(ws + WS_W) + (size_t)l * W_LAYER;
        int nj = 0;
        PP pp2 = pp; const bool split = pp.G > 64; if (split) { pp2.bid = pp.bid - 64; pp2.G = pp.G - 64; }
        const bool shadow = !split || pp.bid >= 64;
        switch (kind) {
            case 0: prep_phase(pp, lds, 0, true); break;
            case 2: tok_phase(pp, l); g1_phase(pp, l, lds); break;
            case 3: g2_phase(pp, l, lds);
                     if (shadow) { conv_phase(pp2, l, lds); cache_phase(pp2, l); if (l == 0) prep_phase(pp2, lds, 1, false); nj = 1; }
                     break;
            case 5: attn_phase(pp, lds); break;
            case 7: ln_phase(pp, KIN(22) + l * 1024, KIN(23) + l * 1024); break;
            case 10: ln_phase(pp, KIN(27) + l * 1024, KIN(28) + l * 1024); break;
            case 4: nj = 3; break;
            case 11: break;
            default: nj = 1; break;
        }
        if (kind == 6 || kind == 9) {
            const float* xs_ = (kind == 6 && l == 0) ? KIN(1) : pp.out + (size_t)MP * 1024;
            if (kind == 6) sample_gemm_res(pp, lds, (const bf16*)(ws + WS_MIX) + (size_t)MP * 1024, WB + W_OUT, 1024, xs_, pp.out + (size_t)MP * 1024);
            else           sample_gemm_res(pp, lds, (const bf16*)(ws + WS_F) + (size_t)MP * DFF, WB + W_DN, DFF, xs_, pp.out + (size_t)MP * 1024);
        }
        for (int j = 0; j < nj; ++j) {
            pg8::Gemm g; bool perm; int mode; bf16* O = nullptr; size_t ldc = 0;
            if (kind == 1)      { g = pg8::Gemm{(const bf16*)(ws + WS_XB), WB + W_IN, MT, HLD, 1024}; perm = true; mode = 0; O = (bf16*)(ws + WS_H); ldc = HLD; }
            else if (kind == 3) { g = pg8::Gemm{(const bf16*)(ws + WS_CQN), WB + W_UQ, MT, 768, 384}; perm = false; mode = 2; O = (bf16*)(ws + WS_XB); ldc = 768; }
            else if (kind == 4 && j == 2 && pp.bid < 4) { g = pg8::Gemm{(const bf16*)(ws + WS_CKVB) + (size_t)NKM * 256, WB + W_UK, 512, 512, 256}; perm = true; mode = 0; O = (bf16*)(ws + WS_KN) + (size_t)NKM * 512; ldc = 512; }
            else if (kind == 4 && j == 2) { g = pg8::Gemm{WB + W_UVT, (const bf16*)(ws + WS_CKVB) + (size_t)NKM * 256, 512, 512, 256}; perm = true; mode = 0; O = (bf16*)(ws + WS_VT) + NKM; ldc = NK; }
            else if (kind == 4 && j == 0) { g = pg8::Gemm{(const bf16*)(ws + WS_CKVB), WB + W_UK, NKM, 512, 256}; perm = true; mode = 0; O = (bf16*)(ws + WS_KN); ldc = 512; }
            else if (kind == 4)           { g = pg8::Gemm{WB + W_UVT, (const bf16*)(ws + WS_CKVB), 512, NKM, 256}; perm = true; mode = 0; O = (bf16*)(ws + WS_VT); ldc = NK; }
            else if (kind == 6) { g = pg8::Gemm{(const bf16*)(ws + WS_MIX), WB + W_OUT, MP, 1024, 1024}; perm = false; mode = 3; }
            else if (kind == 8) { g = pg8::Gemm{(const bf16*)(ws + WS_XB), WB + W_GU, MT, 5632, 1024}; perm = true; mode = 1; O = (bf16*)(ws + WS_F); ldc = DFF; }
            else                { g = pg8::Gemm{(const bf16*)(ws + WS_F), WB + W_DN, MP, 1024, DFF}; perm = false; mode = 3; }
            const float* xp = pp.out; const float* xs = pp.out + (size_t)MP * 1024; if (kind == 6 && l == 0) { xp = KIN(0); xs = KIN(1); }
            pg8::StaticOrder S; if (kind == 3) S.init(g.M, g.N, pp2.G, pp2.bid); else if (kind == 4 && j == 2) S.init(g.M, g.N, pp.G, (pp.bid < 4) ? pp.bid : ((pp.bid - 4 + pp.G) % pp.G)); else S.init(g.M, g.N, pp.G, pp.bid);
            if (perm) { EpiT<true> E{mode, O, ldc, xp, xs, pp.out, (const float2*)(ws + WS_ROPE)}; pg8::gemm_phase<EpiT<true>, pg8::StaticOrder, true, true>(lds, g, S, E, pp.tid); }
            else      { EpiT<false> E{mode, O, ldc, xp, xs, pp.out, (const float2*)(ws + WS_ROPE)}; pg8::gemm_phase<EpiT<false>, pg8::StaticOrder, true, true>(lds, g, S, E, pp.tid); }
            __syncthreads();
        }
        if (step + 1 < hi_) {
            if (step == lo_) grid.sync();
            else fast_grid_bar((unsigned*)(ws + WS_BAR), (unsigned)(step - lo_), pp.tid, pp.bid, pp.G);
        }
    }
}

extern "C" void kernel_launch(void* const* d_in, const int* in_sizes, int n_in, void* d_out, int out_size, void* d_ws, size_t ws_size, hipStream_t stream) {
    static int grid_blocks = 0;
    if (!grid_blocks) {
        if (hipFuncSetAttribute((const void*)mega, hipFuncAttributeMaxDynamicSharedMemorySize, LDS_BYTES) != hipSuccess) { fprintf(stderr, "kernel_launch: hipFuncSetAttribute failed\n"); grid_blocks = -1; }
        else { int dev = 0, cus = 0, per_cu = 0; hipGetDevice(&dev); hipDeviceGetAttribute(&cus, hipDeviceAttributeMultiprocessorCount, dev);
            hipOccupancyMaxActiveBlocksPerMultiprocessor(&per_cu, mega, 512, LDS_BYTES);
            if (per_cu < 1) { fprintf(stderr, "kernel_launch: occupancy query says %d\n", per_cu); per_cu = 1; }
            grid_blocks = cus; }
    }
    if (grid_blocks <= 0) return;
    if (ws_size < WS_TOTAL || n_in < 29) { fprintf(stderr, "kernel_launch: workspace too small (%zu < %zu) or n_in %d\n", ws_size, (size_t)WS_TOTAL, n_in); return; }
    Params p{};
    for (int i = 0; i < 29; ++i) p.in[i] = (const float*)d_in[i];
    p.out = (float*)d_out; p.ws = (unsigned char*)d_ws;
#if COOP
    p.lo = 0; p.hi = (REPK == 0) ? 21 : 23; void* args[] = {&p};
    hipMemsetAsync((unsigned char*)d_ws + WS_BAR, 0, 8192, stream);
    hipError_t e = hipLaunchCooperativeKernel((const void*)mega, dim3(grid_blocks), dim3(512), args, LDS_BYTES, stream);
    if (e != hipSuccess) fprintf(stderr, "cooperative launch failed: %s (grid %d)\n", hipGetErrorString(e), grid_blocks);
#else
    for (int s = 0; s < 21; ++s) { p.lo = s; p.hi = s + 1; hipLaunchKernelGGL(mega, dim3(grid_blocks), dim3(512), LDS_BYTES, stream, p); }
#endif
}
```
